# Optimizing an MI355X kernel written in HIP

```python
import jax, jax.numpy as jnp
from jax import lax
import numpy as np

D_MODEL = 1024
BATCH = 4
SEQ = 4096
DEPTH = 2
DEC_BATCH = 16
DEC_SEQ = 16
PAST_LEN = 4096

CHUNK = 64
N_META = 16
A_HEADS = 8
A_HEAD_DIM = 64
A_WIDTH = A_HEADS * A_HEAD_DIM
A_DECAY_LORA = 64
A_AAA_LORA = 64
A_GATE_LORA = 128
A_COLS = 3 * A_WIDTH + A_DECAY_LORA + A_AAA_LORA + A_GATE_LORA
B_HEADS = 4
B_HEAD_DIM = 128
B_WIDTH = B_HEADS * B_HEAD_DIM
B_CONV = 4
B_COLS = 4 * B_WIDTH + 2 * B_HEADS
D_MIX = A_WIDTH + B_WIDTH
D_IN = A_COLS + B_COLS
D_FF = 2816
FFN_CONV = 3
RMS_EPS = 1e-6
GN_EPS = 64e-5

kernel_name = "hymba_rwkv7_mlstm_convffn_stream_step"


def rmsnorm(x, g):
    xf = x.astype(jnp.float32)
    y = xf * lax.rsqrt(jnp.mean(xf * xf, axis=-1, keepdims=True) + RMS_EPS)
    return (y * g.astype(jnp.float32)).astype(x.dtype)


def causal_dwconv(x, buf, w, b):
    K = w.shape[0]
    T = x.shape[1]
    xp = jnp.concatenate([buf.astype(x.dtype), x], axis=1)
    y = sum(w[j] * xp[:, j:j + T] for j in range(K)) + b
    return y, xp[:, T:]


def rwkv7_mix(p, shift_prev, S0, mu, w0, w2, a0, a2, g2, k_k, k_a, r_k, ln_w, ln_b):
    Bn, T, _ = p.shape
    prev = jnp.concatenate([shift_prev[:, None].astype(p.dtype), p[:, :-1]], axis=1)
    pm = (p + (prev - p) * mu).astype(jnp.float32)
    i1, i2, i3 = A_WIDTH, 2 * A_WIDTH, 3 * A_WIDTH
    i4, i5 = i3 + A_DECAY_LORA, i3 + A_DECAY_LORA + A_AAA_LORA
    r, k, v = pm[..., :i1], pm[..., i1:i2], pm[..., i2:i3]
    wl, al, gl = pm[..., i3:i4], pm[..., i4:i5], pm[..., i5:]
    w = -jax.nn.softplus(-(w0 + jnp.tanh(wl) @ w2)) - 0.5
    decay = jnp.exp(-jnp.exp(w))
    a = jax.nn.sigmoid(a0 + al @ a2)
    g = jax.nn.sigmoid(gl) @ g2
    hd = lambda t: t.reshape(Bn, T, A_HEADS, A_HEAD_DIM)
    r, k, v, decay, a = hd(r), hd(k), hd(v), hd(decay), hd(a)
    kk = k * k_k.reshape(A_HEADS, A_HEAD_DIM)
    kk = kk * lax.rsqrt(jnp.sum(kk * kk, axis=-1, keepdims=True) + 1e-12)
    k = k * (1.0 + (a - 1.0) * k_a.reshape(A_HEADS, A_HEAD_DIM))

    def step(S, inp):
        r_t, k_t, v_t, w_t, kk_t, a_t = inp
        sa = jnp.einsum('bhvk,bhk->bhv', S, -kk_t)
        S = (S * w_t[:, :, None, :] + sa[..., None] * (kk_t * a_t)[:, :, None, :]
             + v_t[..., None] * k_t[:, :, None, :])
        return S, jnp.einsum('bhvk,bhk->bhv', S, r_t)

    xs = tuple(jnp.moveaxis(t, 1, 0) for t in (r, k, v, decay, kk, a))
    S_new, y = lax.scan(step, S0.astype(jnp.float32), xs)
    y = jnp.moveaxis(y, 0, 1)
    mean = jnp.mean(y, axis=-1, keepdims=True)
    var = jnp.mean(jnp.square(y - mean), axis=-1, keepdims=True)
    y = ((y - mean) * lax.rsqrt(var + GN_EPS)).reshape(Bn, T, A_WIDTH) * ln_w + ln_b
    bonus = jnp.sum(r * k * r_k.reshape(A_HEADS, A_HEAD_DIM), axis=-1, keepdims=True) * v
    y = (y + bonus.reshape(Bn, T, A_WIDTH)) * g
    return y, p[:, -1], S_new


def mlstm_block(state, blk):
    C, n, m = state
    q, k, v, li, lf = blk
    L = q.shape[2]
    b = jnp.cumsum(lf, axis=-1)
    causal = jnp.tril(jnp.ones((L, L), dtype=bool))
    Dm = jnp.where(causal, b[..., :, None] - b[..., None, :] + li[..., None, :], -jnp.inf)
    inter = b + m[..., None]
    mt = jnp.maximum(inter, jnp.max(Dm, axis=-1))
    wi = jnp.exp(Dm - mt[..., None])
    wo = jnp.exp(inter - mt)
    s = jnp.einsum('bhtd,bhjd->bhtj', q, k) * wi
    num = wo[..., None] * jnp.einsum('bhtd,bhde->bhte', q, C) + jnp.einsum('bhtj,bhje->bhte', s, v)
    den = wo * jnp.einsum('bhtd,bhd->bht', q, n) + jnp.sum(s, axis=-1)
    h = num / jnp.maximum(jnp.abs(den), jnp.exp(-mt))[..., None]
    m_new = mt[..., -1]
    ws = jnp.exp(b[..., -1:] - b + li - m_new[..., None])
    dec = jnp.exp(b[..., -1] + m - m_new)
    C_new = dec[..., None, None] * C + jnp.einsum('bhj,bhjd,bhje->bhde', ws, k, v)
    n_new = dec[..., None] * n + jnp.einsum('bhj,bhjd->bhd', ws, k)
    return (C_new, n_new, m_new), h


def mlstm_seq(state, q, k, v, li, lf, lead):
    Bn, H, T, d = q.shape
    state, h0 = mlstm_block(state, (q[:, :, :lead], k[:, :, :lead], v[:, :, :lead], li[:, :, :lead], lf[:, :, :lead]))
    rest = T - lead
    if rest == 0:
        return state, h0
    nb = rest // CHUNK

    def blocks(t):
        t = t[:, :, lead:]
        t = t.reshape(t.shape[:2] + (nb, CHUNK) + t.shape[3:])
        return jnp.moveaxis(t, 2, 0)

    state, hs = lax.scan(mlstm_block, state, (blocks(q), blocks(k), blocks(v), blocks(li), blocks(lf)))
    hs = jnp.moveaxis(hs, 0, 2).reshape(Bn, H, rest, d)
    return state, jnp.concatenate([h0, hs], axis=2)


def mlstm_mix(p, conv_buf, C0, n0, m0, conv_w, conv_b, i_bias, f_bias, hn_w, lead):
    Bn, T, _ = p.shape
    qk, conv_new = causal_dwconv(p[..., :2 * B_WIDTH], conv_buf, conv_w, conv_b)
    qk = jax.nn.silu(qk.astype(jnp.float32))
    pf = p.astype(jnp.float32)
    v = pf[..., 2 * B_WIDTH:3 * B_WIDTH]
    o = pf[..., 3 * B_WIDTH:4 * B_WIDTH]
    gates = pf[..., 4 * B_WIDTH:]
    li = gates[..., :B_HEADS] + i_bias
    lf = jax.nn.log_sigmoid(gates[..., B_HEADS:] + f_bias)
    hd = lambda t: jnp.moveaxis(t.reshape(Bn, T, B_HEADS, B_HEAD_DIM), 2, 1)
    q = hd(qk[..., :B_WIDTH])
    k = hd(qk[..., B_WIDTH:]) * (B_HEAD_DIM ** -0.5)
    v = hd(v)
    li, lf = jnp.moveaxis(li, 2, 1), jnp.moveaxis(lf, 2, 1)
    (C, n, m), h = mlstm_seq((C0.astype(jnp.float32), n0.astype(jnp.float32), m0.astype(jnp.float32)),
                             q, k, v, li, lf, lead)
    h = jnp.moveaxis(h, 1, 2)
    h = h * lax.rsqrt(jnp.mean(h * h, axis=-1, keepdims=True) + RMS_EPS)
    h = h.reshape(Bn, T, B_WIDTH) * hn_w * jax.nn.sigmoid(o)
    return h, conv_new, C, n, m


def layer(x, st, w, lead):
    shift0, S0, bconv0, C0, n0, m0, fconv0 = st
    (norm_mix, w_in, a_mu, a_w0, a_w2, a_a0, a_a2, a_g2, a_k_k, a_k_a, a_r_k, a_ln_w, a_ln_b,
     b_conv_w, b_conv_b, b_i_bias, b_f_bias, b_hn_w, w_out, norm_ffn, w_up, ffn_conv_w, ffn_conv_b, w_down) = w
    h = rmsnorm(x, norm_mix)
    p = h @ w_in
    ya, shift1, S1 = rwkv7_mix(p[..., :A_COLS], shift0, S0, a_mu, a_w0, a_w2, a_a0, a_a2, a_g2,
                               a_k_k, a_k_a, a_r_k, a_ln_w, a_ln_b)
    yb, bconv1, C1, n1, m1 = mlstm_mix(p[..., A_COLS:], bconv0, C0, n0, m0, b_conv_w, b_conv_b,
                                       b_i_bias, b_f_bias, b_hn_w, lead)
    x = x + jnp.concatenate([ya, yb], axis=-1).astype(x.dtype) @ w_out
    h2 = rmsnorm(x, norm_ffn)
    ug = h2 @ w_up
    u, fconv1 = causal_dwconv(ug[..., :D_FF], fconv0, ffn_conv_w, ffn_conv_b)
    x = x + (jax.nn.silu(u) * ug[..., D_FF:]) @ w_down
    return x, (shift1, S1, bconv1, C1, n1, m1, fconv1)


def zero_states(b, dtype):
    f32 = jnp.float32
    return (jnp.zeros((b, A_COLS), dtype), jnp.zeros((b, A_HEADS, A_HEAD_DIM, A_HEAD_DIM), f32),
            jnp.zeros((b, B_CONV - 1, 2 * B_WIDTH), dtype), jnp.zeros((b, B_HEADS, B_HEAD_DIM, B_HEAD_DIM), f32),
            jnp.zeros((b, B_HEADS, B_HEAD_DIM), f32), jnp.zeros((b, B_HEADS), f32),
            jnp.zeros((b, FFN_CONV - 1, D_FF), dtype))


def trunk(x, states, layer_weights, lead):
    outs = []
    for l in range(DEPTH):
        st = zero_states(x.shape[0], x.dtype) if states is None else tuple(s[l] for s in states)
        x, new_st = layer(x, st, tuple(t[l] for t in layer_weights), lead)
        outs.append(new_st)
    return x, tuple(jnp.stack([o[i] for o in outs]) for i in range(7))


def setup_inputs(seed: int = 0) -> dict:
    key = jax.random.key(seed)
    ks = iter(jax.random.split(key, 40))
    nrm = lambda shape, s=1.0: s * jax.random.normal(next(ks), shape, jnp.float32)
    uni = lambda shape, lo, hi: jax.random.uniform(next(ks), shape, jnp.float32, lo, hi)
    L = DEPTH
    return {
        "x_prompt": nrm((BATCH, SEQ, D_MODEL)),
        "x_sample": nrm((DEC_BATCH, DEC_SEQ, D_MODEL)),
        "state_rwkv_shift": nrm((L, DEC_BATCH, A_COLS)),
        "state_rwkv_wkv": nrm((L, DEC_BATCH, A_HEADS, A_HEAD_DIM, A_HEAD_DIM), 0.3),
        "state_mlstm_conv": nrm((L, DEC_BATCH, B_CONV - 1, 2 * B_WIDTH)),
        "state_mlstm_C": nrm((L, DEC_BATCH, B_HEADS, B_HEAD_DIM, B_HEAD_DIM), 0.1),
        "state_mlstm_n": nrm((L, DEC_BATCH, B_HEADS, B_HEAD_DIM), 0.3),
        "state_mlstm_m": nrm((L, DEC_BATCH, B_HEADS), 1.0),
        "state_ffn_conv": nrm((L, DEC_BATCH, FFN_CONV - 1, D_FF)),
        "meta_tokens": nrm((N_META, D_MODEL)),
        "norm_mix": 1.0 + nrm((L, D_MODEL), 0.02),
        "w_in": nrm((L, D_MODEL, D_IN), D_MODEL ** -0.5),
        "a_mu": uni((L, A_COLS), 0.0, 1.0),
        "a_w0": uni((L, A_WIDTH), -6.0, -1.0),
        "a_w2": nrm((L, A_DECAY_LORA, A_WIDTH), 0.1),
        "a_a0": nrm((L, A_WIDTH), 0.5),
        "a_a2": nrm((L, A_AAA_LORA, A_WIDTH), A_AAA_LORA ** -0.5),
        "a_g2": nrm((L, A_GATE_LORA, A_WIDTH), A_GATE_LORA ** -0.5),
        "a_k_k": 0.85 + nrm((L, A_WIDTH), 0.05),
        "a_k_a": 1.0 + nrm((L, A_WIDTH), 0.05),
        "a_r_k": nrm((L, A_WIDTH), 0.1),
        "a_ln_w": 1.0 + nrm((L, A_WIDTH), 0.02),
        "a_ln_b": nrm((L, A_WIDTH), 0.02),
        "b_conv_w": nrm((L, B_CONV, 2 * B_WIDTH), B_CONV ** -0.5),
        "b_conv_b": nrm((L, 2 * B_WIDTH), 0.02),
        "b_i_bias": nrm((L, B_HEADS), 0.1),
        "b_f_bias": 3.0 + nrm((L, B_HEADS), 0.5),
        "b_hn_w": 1.0 + nrm((L, B_WIDTH), 0.02),
        "w_out": nrm((L, D_MIX, D_MODEL), D_MIX ** -0.5),
        "norm_ffn": 1.0 + nrm((L, D_MODEL), 0.02),
        "w_up": nrm((L, D_MODEL, 2 * D_FF), D_MODEL ** -0.5),
        "ffn_conv_w": nrm((L, FFN_CONV, D_FF), FFN_CONV ** -0.5),
        "ffn_conv_b": nrm((L, D_FF), 0.02),
        "w_down": nrm((L, D_FF, D_MODEL), D_FF ** -0.5),
        "norm_final": 1.0 + nrm((D_MODEL,), 0.02),
    }


def reference(x_prompt, x_sample, state_rwkv_shift, state_rwkv_wkv, state_mlstm_conv, state_mlstm_C,
              state_mlstm_n, state_mlstm_m, state_ffn_conv, meta_tokens, norm_mix, w_in, a_mu, a_w0, a_w2,
              a_a0, a_a2, a_g2, a_k_k, a_k_a, a_r_k, a_ln_w, a_ln_b, b_conv_w, b_conv_b, b_i_bias, b_f_bias,
              b_hn_w, w_out, norm_ffn, w_up, ffn_conv_w, ffn_conv_b, w_down, norm_final):
    layer_weights = (norm_mix, w_in, a_mu, a_w0, a_w2, a_a0, a_a2, a_g2, a_k_k, a_k_a, a_r_k, a_ln_w, a_ln_b,
                     b_conv_w, b_conv_b, b_i_bias, b_f_bias, b_hn_w, w_out, norm_ffn, w_up, ffn_conv_w,
                     ffn_conv_b, w_down)
    meta = jnp.broadcast_to(meta_tokens[None].astype(x_prompt.dtype), (x_prompt.shape[0], N_META, D_MODEL))
    xp = jnp.concatenate([meta, x_prompt], axis=1)
    hp, (p_rwkv_shift, p_rwkv_wkv, p_mlstm_conv, p_mlstm_C, p_mlstm_n, p_mlstm_m, p_ffn_conv) = trunk(
        xp, None, layer_weights, N_META)
    y_prompt = rmsnorm(hp, norm_final)[:, N_META:]
    states = (state_rwkv_shift, state_rwkv_wkv, state_mlstm_conv, state_mlstm_C, state_mlstm_n,
              state_mlstm_m, state_ffn_conv)
    hs, (s_rwkv_shift, s_rwkv_wkv, s_mlstm_conv, s_mlstm_C, s_mlstm_n, s_mlstm_m, s_ffn_conv) = trunk(
        x_sample, states, layer_weights, x_sample.shape[1])
    y_sample = rmsnorm(hs, norm_final)
    return (y_prompt, y_sample,
            p_rwkv_shift, p_rwkv_wkv, p_mlstm_conv, p_mlstm_C, p_mlstm_n, p_mlstm_m, p_ffn_conv,
            s_rwkv_shift, s_rwkv_wkv, s_mlstm_conv, s_mlstm_C, s_mlstm_n, s_mlstm_m, s_ffn_conv)
```

```cpp
#define PROBE_SYNC 0
#define PROBE_MIXA 0
#define PROBE_MIXC 0
#define PROBE_GEMM 0
#define PROBE_ML 0
#define PROBE_PRO 0
#define PROBE_OUT 0
#define PROBE_DOWN 0
#define PROBE_FIX 0
#define PROBE_P1 0
#define PROBE_P3 0
#define PROBE_SCAN 0
#include <hip/hip_runtime.h>
#include <hip/hip_cooperative_groups.h>
#include <cstdio>
#include <cstdint>
namespace cg = cooperative_groups;

#define LAS __attribute__((address_space(3)))
#define GAS __attribute__((address_space(1)))
typedef unsigned short bf16_t;
typedef short bf16x8 __attribute__((ext_vector_type(8)));
typedef float f32x4 __attribute__((ext_vector_type(4)));
typedef unsigned u32x4 __attribute__((ext_vector_type(4)));
typedef unsigned u32x2 __attribute__((ext_vector_type(2)));

constexpr int DM = 1024, NB = 4, SEQ = 4096, NMETA = 16, TP = 4112, DEPTH = 2, SBN = 16, STN = 16;
constexpr int AH = 8, AD = 64, AW = 512, ACOLS = 1792, BH = 4, BD = 128, BCOLS = 2056, DIN = 3848, DFF = 2816, HFF = 1408;
constexpr int R_MAIN = 16384, R_SAMP = 16384, R_META = 16640, R_TOT = 16704, MPAD = 16896;
constexpr int PLD = 3856;
constexpr int NINP = 4096;
constexpr float RMS_EPS = 1e-6f, GN_EPS = 64e-5f;

constexpr size_t O_YP = 0, O_YS = O_YP + (size_t)NB * SEQ * DM, O_PSHIFT = O_YS + (size_t)SBN * STN * DM;
constexpr size_t O_PWKV = O_PSHIFT + (size_t)DEPTH * NB * ACOLS, O_PCONV = O_PWKV + (size_t)DEPTH * NB * AH * AD * AD;
constexpr size_t O_PC = O_PCONV + (size_t)DEPTH * NB * 3 * 1024, O_PN = O_PC + (size_t)DEPTH * NB * BH * BD * BD;
constexpr size_t O_PM = O_PN + (size_t)DEPTH * NB * BH * BD, O_PF = O_PM + (size_t)DEPTH * NB * BH;
constexpr size_t O_SSHIFT = O_PF + (size_t)DEPTH * NB * 2 * DFF;
constexpr size_t O_SWKV = O_SSHIFT + (size_t)DEPTH * SBN * ACOLS, O_SCONV = O_SWKV + (size_t)DEPTH * SBN * AH * AD * AD;
constexpr size_t O_SC = O_SCONV + (size_t)DEPTH * SBN * 3 * 1024, O_SN = O_SC + (size_t)DEPTH * SBN * BH * BD * BD;
constexpr size_t O_SM = O_SN + (size_t)DEPTH * SBN * BH * BD, O_SF = O_SM + (size_t)DEPTH * SBN * BH;
constexpr size_t O_END = O_SF + (size_t)DEPTH * SBN * 2 * DFF;
static_assert(O_END == 21412000, "output size");

constexpr size_t WS_TAB = 32768;
constexpr size_t WS_SS = 65536;
constexpr size_t WS_XMETA = WS_SS + 4 * (size_t)MPAD * 16 + 256;
constexpr size_t WS_LORA = (WS_XMETA + 255) / 256 * 256;
constexpr size_t WS_ZROW = WS_LORA + (size_t)DEPTH * AH * 16384 * 2;
constexpr size_t WS_SHIFTB = WS_ZROW + 8192;
constexpr size_t WS_CONVB = (WS_SHIFTB + (size_t)DEPTH * SBN * ACOLS * 2 + 255) / 256 * 256;
constexpr size_t WS_WIN = (WS_CONVB + (size_t)DEPTH * SBN * 3 * 1024 * 2 + 255) / 256 * 256;
constexpr size_t WS_WOUT = WS_WIN + 2 * (size_t)NINP * DM * 2;
constexpr size_t WS_WUP = WS_WOUT + 2 * (size_t)DM * DM * 2;
constexpr size_t WS_WDN = WS_WUP + 2 * (size_t)2 * DFF * DM * 2;
constexpr size_t WS_XB0 = WS_WDN + 2 * (size_t)2 * DM * HFF * 2;
constexpr size_t WS_BIG = WS_XB0 + (size_t)MPAD * DM * 2;
constexpr size_t WS_AUX = WS_BIG + (size_t)MPAD * PLD * 2;
constexpr size_t WS_XB1 = WS_AUX;
constexpr size_t WS_END = WS_AUX + (size_t)2208 * 16384 + (size_t)8 * 1024 * 1024;
static_assert(WS_END <= 268435456, "workspace");
constexpr size_t WS_SLAB_OUT = WS_AUX + (size_t)MPAD * DM * 2;
static_assert(WS_SLAB_OUT + (size_t)8 * 4 * 65536 * 4 <= 268435456, "slab_out");
constexpr size_t WS_BONUS = WS_AUX + (((size_t)2208 * 16384 + (size_t)208 * 33536 + 255) / 256) * 256;
static_assert(WS_BONUS + (size_t)2208 * 64 * 4 <= WS_END, "bonus scalars fit in AUX");

struct Params {
  const float* in[35];
  float* out;
  unsigned char* ws;
  int ph_lo, ph_hi;
};

typedef const GAS float* gcf_t;
struct Ctx { GAS float* out; GAS unsigned char* ws; const gcf_t GAS* in; int wv; int bid; int nblk; int pad_; };

__device__ __forceinline__ int opaque_tid(int wv) { unsigned z = 0u; asm volatile("" : "+v"(z)); int t = (wv << 6) | (int)__builtin_amdgcn_mbcnt_hi(~0u, __builtin_amdgcn_mbcnt_lo(~0u, z)); asm volatile("" : "+v"(t)); return t; }
__device__ __forceinline__ Ctx opaque_ctx(Ctx c) { asm volatile("" : "+s"(c.out), "+s"(c.ws), "+s"(c.in), "+s"(c.wv), "+s"(c.bid), "+s"(c.nblk)); return c; }

typedef float f32x2_t __attribute__((ext_vector_type(2)));
typedef __bf16 bf16x2_t __attribute__((ext_vector_type(2)));
__device__ __forceinline__ unsigned pk2(float lo, float hi) { const f32x2_t v = {lo, hi}; const bf16x2_t b = __builtin_convertvector(v, bf16x2_t); return __builtin_bit_cast(unsigned, b); }
__device__ __forceinline__ unsigned f2bf(float f) { return pk2(f, 0.f) & 0xffffu; }
__device__ __forceinline__ float bf2f(unsigned b) { return __builtin_bit_cast(float, b << 16); }
__device__ __forceinline__ float bflo(unsigned w) { return __builtin_bit_cast(float, w << 16); }
__device__ __forceinline__ float bfhi(unsigned w) { return __builtin_bit_cast(float, w & 0xffff0000u); }
__device__ __forceinline__ float wave_sum(float v) {
#pragma unroll
  for (int o = 1; o < 64; o <<= 1) v += __shfl_xor(v, o);
  return v;
}
__device__ __forceinline__ float sigmoidf_(float x) { return __builtin_amdgcn_rcpf(1.f + __expf(-x)); }
__device__ __forceinline__ float siluf_(float x) { return x * __builtin_amdgcn_rcpf(1.f + __expf(-x)); }
__device__ __forceinline__ float softplusf_(float x) { return fmaxf(x, 0.f) + __logf(1.f + __expf(-fabsf(x))); }
__device__ __forceinline__ void load8(const GAS bf16_t* p, float* o) {
  const u32x4 w = *(const GAS u32x4*)p;
  o[0] = bflo(w.x); o[1] = bfhi(w.x); o[2] = bflo(w.y); o[3] = bfhi(w.y); o[4] = bflo(w.z); o[5] = bfhi(w.z); o[6] = bflo(w.w); o[7] = bfhi(w.w);
}
__device__ __forceinline__ float row_rstd(const GAS float* ss4, int row) { const f32x4 p = *(const GAS f32x4*)(ss4 + (size_t)row * 4); return rsqrtf((((p[0] + p[1]) + p[2]) + p[3]) * (1.f / DM) + RMS_EPS); }
__device__ __forceinline__ GAS float* xrow_ptr(GAS float* out, GAS float* xmeta, int r) { return r < R_META ? out + (size_t)r * DM : xmeta + (size_t)(r - R_META) * DM; }

namespace pg8 {
constexpr int BM = 256, BK = 64, HALF = 128, HTB = HALF * BK * 2, STAGE_BYTES = 8 * HTB, NXCD = 8, WGM = 8;
__host__ __device__ __forceinline__ int lds_byte(int r, int c) { const int st = (r >> 4) * 2 + (c >> 5), rr = r & 15, cc = c & 31, ob = rr * 64 + cc * 2; return st * 1024 + (ob ^ (((ob >> 9) & 1) << 5)); }
__host__ __device__ __forceinline__ void stage_rc(int b, int& R, int& C) { const int st = b / 1024, sb = b % 1024, swz = sb ^ (((sb >> 9) & 1) << 5); R = (st >> 1) * 16 + swz / 64; C = (st & 1) * 32 + (swz % 64) / 2; }
__host__ __device__ __forceinline__ int perm32(int rho) { const int n = rho >> 4, i = rho & 15; return 8 * (i >> 2) + 4 * n + (i & 3); }
struct Unit { int pm, pn, kofs, nt, slice; };
struct Gemm { const bf16_t* A; const bf16_t* Bt; int M, N, K, lda; };
struct StaticOrder {
  int nM, nN, nwg, G, c, ntf;
  __device__ void init(int M, int N, int K, int G_, int c_) { nM = M / BM; nN = N / BM; nwg = nM * nN; G = G_; c = c_; ntf = K / BK; }
  __device__ bool next(int i, Unit& u) const {
    const long L = (long)i * G + c; if (L >= nwg) return false;
    int wgid = (int)L; { const int q = nwg / NXCD, r = nwg % NXCD, xcd = wgid % NXCD, off = wgid / NXCD; wgid = (xcd < r ? xcd * (q + 1) : r * (q + 1) + (xcd - r) * q) + off; }
    const int nig = WGM * nN, gid = wgid / nig, fm = gid * WGM, gsz = (nM - fm) < WGM ? (nM - fm) : WGM;
    u.pm = fm + ((wgid % nig) % gsz); u.pn = (wgid % nig) / gsz; u.kofs = 0; u.nt = ntf; u.slice = 0; return true;
  }
  __device__ __forceinline__ void a_ready(const Unit&) const {}
};
struct WaitOrder : StaticOrder {
  unsigned* flag; unsigned need; int wv;
  __device__ __forceinline__ void a_ready(const Unit& u) const {
    if (u.pm < 64) return;
    if (wv == 0) {
      unsigned sp = 0;
      while ((unsigned)__builtin_amdgcn_readfirstlane(__hip_atomic_load(flag, __ATOMIC_RELAXED, __HIP_MEMORY_SCOPE_AGENT)) < need) { __builtin_amdgcn_s_sleep(2); if (++sp > (1u << 22)) break; }
      __builtin_amdgcn_fence(__ATOMIC_ACQUIRE, "agent");
      asm volatile("s_waitcnt vmcnt(0)" ::: "memory");
    }
    asm volatile("" ::: "memory"); __builtin_amdgcn_s_barrier(); asm volatile("" ::: "memory");
  }
};
struct TailOrder : StaticOrder {
  int nsl;
  __device__ bool next(int i, Unit& u) const {
    if (i == 0) return StaticOrder::next(0, u);
    if (i == 1 && c < 8 * nsl) {
      const int tile = c & 7, sl = c >> 3;
      const int st = (ntf == 16) ? 4 * sl : (sl < 2 ? 12 * sl : 24 + 10 * (sl - 2)), n = (ntf == 16) ? 4 : (sl < 2 ? 12 : 10);
      u.pm = 64 + (tile >> 2); u.pn = tile & 3; u.kofs = st * BK * 2; u.nt = n; u.slice = 1 + sl; return true;
    }
    return false;
  }
};
__device__ __forceinline__ unsigned cvt_pk_bf16(float lo, float hi) { unsigned r; asm volatile("v_cvt_pk_bf16_f32 %0, %1, %2" : "=v"(r) : "v"(lo), "v"(hi)); return r; }

template <class Epi, class Sched, bool ALIGN_EPI = true>
__device__ __forceinline__ void gemm_phase(LAS unsigned char* lds, const Gemm g, const Sched& S, const Epi& E, int wv) {
  const int tid = opaque_tid(wv), wid = __builtin_amdgcn_readfirstlane(tid >> 6), lane = tid & 63, wr = wid >> 2, wc = wid & 3, fr = lane & 15, fq = lane >> 4;
  const int K = g.K, lda = g.lda;
  unsigned voffA[2], voffB[2];
#pragma unroll
  for (int i = 0; i < 2; ++i) { int R, C; stage_rc(tid * 16 + i * 8192, R, C); const int Rb = Epi::PERM ? ((R & ~31) + perm32(R & 31)) : R;
    voffA[i] = (unsigned)(R * lda + C) * 2u; voffB[i] = (unsigned)(Rb * K + C) * 2u; }
  const size_t kstep = (size_t)(BK * 2);
  const size_t hstepA = (size_t)HALF * lda * 2, hstepB = (size_t)HALF * K * 2;
  const size_t tstepA = 2 * hstepA, tstepB = 2 * hstepB;
  const unsigned ldsw = (unsigned)wid * 1024u;
  const int aoff = lds_byte(wr * 64 + fr, fq * 8), boff = lds_byte(wc * 32 + fr, fq * 8);
#define PG8_SA(b, h) (((b) * 2 + (h)) * HTB)
#define PG8_SB(b, h) ((4 + (b) * 2 + (h)) * HTB)
#define PG8_STAGE(bufoff, gbase, voff) do { _Pragma("unroll") for (int _i = 0; _i < 2; ++_i) \
    __builtin_amdgcn_global_load_lds((const unsigned*)((const char*)(gbase) + (voff)[_i]), (LAS unsigned*)(lds + (bufoff) + ldsw + _i * 8192), 16, 0, 0); } while (0)
#define PG8_LDA(dst, b, h) do { _Pragma("unroll") for (int m = 0; m < 4; ++m) _Pragma("unroll") for (int k = 0; k < 2; ++k) dst[m][k] = *(const LAS bf16x8*)(lds + PG8_SA(b, h) + aoff + m * 2048 + k * 1024); } while (0)
#define PG8_LDB(dst, b, h) do { _Pragma("unroll") for (int n = 0; n < 2; ++n) _Pragma("unroll") for (int k = 0; k < 2; ++k) dst[n][k] = *(const LAS bf16x8*)(lds + PG8_SB(b, h) + boff + n * 2048 + k * 1024); } while (0)
#define PG8_MMA(ai, bj, At, Bt) do { __builtin_amdgcn_s_setprio(1); _Pragma("unroll") for (int m = 0; m < 4; ++m) _Pragma("unroll") for (int n = 0; n < 2; ++n) _Pragma("unroll") for (int k = 0; k < 2; ++k) \
    acc[ai][bj][m][n] = __builtin_amdgcn_mfma_f32_16x16x32_bf16(Bt[n][k], At[m][k], acc[ai][bj][m][n], 0, 0, 0); __builtin_amdgcn_s_setprio(0); } while (0)
#define PG8_WAIT_V(n) asm volatile("s_waitcnt vmcnt(" #n ")" ::: "memory")
#define PG8_WAIT_L(n) asm volatile("s_waitcnt lgkmcnt(" #n ")" ::: "memory")
#define PG8_BAR __builtin_amdgcn_s_barrier()
#define PG8_SCHED __builtin_amdgcn_sched_barrier(0)
  Unit cur, nxt; int ui = 0;
  if (!S.next(0, cur)) return;
  f32x4 acc[2][2][4][2];
#pragma unroll
  for (int a = 0; a < 2; ++a)
#pragma unroll
    for (int b = 0; b < 2; ++b)
#pragma unroll
      for (int m = 0; m < 4; ++m)
#pragma unroll
        for (int n = 0; n < 2; ++n) acc[a][b][m][n] = (f32x4){0.f, 0.f, 0.f, 0.f};
  bf16x8 At[4][2], B0[2][2], B1[2][2];
  const char* cA = (const char*)g.A + (size_t)cur.pm * tstepA + cur.kofs; const char* cB = (const char*)g.Bt + (size_t)cur.pn * tstepB + cur.kofs;
  S.a_ready(cur);
  PG8_STAGE(PG8_SB(0, 0), cB, voffB); PG8_STAGE(PG8_SB(0, 1), cB + hstepB, voffB); PG8_STAGE(PG8_SA(0, 0), cA, voffA); PG8_STAGE(PG8_SA(0, 1), cA + hstepA, voffA);
  if (wr == 1) PG8_BAR;
  PG8_WAIT_V(2); PG8_BAR;
  PG8_STAGE(PG8_SB(1, 0), cB + kstep, voffB); PG8_STAGE(PG8_SA(1, 0), cA + kstep, voffA); PG8_STAGE(PG8_SB(1, 1), cB + hstepB + kstep, voffB);
  PG8_WAIT_V(6); PG8_BAR;
  for (;;) {
    const bool has_next = S.next(ui + 1, nxt);
    const char* nA = has_next ? (const char*)g.A + (size_t)nxt.pm * tstepA + nxt.kofs : cA; const char* nB = has_next ? (const char*)g.Bt + (size_t)nxt.pn * tstepB + nxt.kofs : cB;
    const int nt = cur.nt;
    for (int t = 0; t < nt; t += 2) {
      const bool last = (t == nt - 2);
      if (last && has_next) S.a_ready(nxt);
      const char* a1 = cA + (size_t)(t + 1) * kstep;
      const char* a2 = last ? nA : cA + (size_t)(t + 2) * kstep; const char* b2 = last ? nB : cB + (size_t)(t + 2) * kstep;
      const char* a3 = a2 + kstep; const char* b3 = b2 + kstep;
      PG8_LDB(B0, 0, 0); PG8_LDB(B1, 0, 1); PG8_SCHED; PG8_LDA(At, 0, 0); PG8_STAGE(PG8_SA(1, 1), a1 + hstepA, voffA);
      PG8_WAIT_V(8); PG8_WAIT_L(0); PG8_BAR; PG8_MMA(0, 0, At, B0); PG8_MMA(0, 1, At, B1); PG8_BAR; PG8_SCHED;
      PG8_LDA(At, 0, 1); PG8_STAGE(PG8_SB(0, 0), b2, voffB); PG8_STAGE(PG8_SB(0, 1), b2 + hstepB, voffB); PG8_STAGE(PG8_SA(0, 0), a2, voffA);
      PG8_WAIT_V(8); PG8_WAIT_L(0); PG8_BAR; PG8_MMA(1, 0, At, B0); PG8_MMA(1, 1, At, B1); PG8_BAR; PG8_SCHED;
      PG8_LDB(B0, 1, 0); PG8_LDB(B1, 1, 1); PG8_SCHED; PG8_LDA(At, 1, 0); PG8_STAGE(PG8_SA(0, 1), a2 + hstepA, voffA);
      PG8_WAIT_V(8); PG8_WAIT_L(0); PG8_BAR; PG8_MMA(0, 0, At, B0); PG8_MMA(0, 1, At, B1); PG8_BAR; PG8_SCHED;
      PG8_LDA(At, 1, 1); PG8_STAGE(PG8_SB(1, 0), b3, voffB); PG8_STAGE(PG8_SB(1, 1), b3 + hstepB, voffB); PG8_STAGE(PG8_SA(1, 0), a3, voffA);
      PG8_WAIT_V(8); PG8_WAIT_L(0); PG8_BAR; PG8_MMA(1, 0, At, B0); PG8_MMA(1, 1, At, B1); PG8_BAR; PG8_SCHED;
    }
    if constexpr (ALIGN_EPI) { if (wr == 0) PG8_BAR; }
    E(acc, cur, wr, wc, fr, fq);
    if (!has_next) break;
#pragma unroll
    for (int a = 0; a < 2; ++a)
#pragma unroll
      for (int b = 0; b < 2; ++b)
#pragma unroll
        for (int m = 0; m < 4; ++m)
#pragma unroll
          for (int n = 0; n < 2; ++n) acc[a][b][m][n] = (f32x4){0.f, 0.f, 0.f, 0.f};
    cur = nxt; cA = nA; cB = nB; ++ui;
    if constexpr (ALIGN_EPI) { if (wr == 1) PG8_BAR; }
  }
  PG8_WAIT_V(0);
  if constexpr (!ALIGN_EPI) { if (wr == 0) PG8_BAR; }
  PG8_BAR;
#undef PG8_SA
#undef PG8_SB
#undef PG8_STAGE
#undef PG8_LDA
#undef PG8_LDB
#undef PG8_MMA
#undef PG8_WAIT_V
#undef PG8_WAIT_L
#undef PG8_BAR
#undef PG8_SCHED
}

struct EpiScaleBf16 {
  static constexpr bool PERM = true;
  GAS bf16_t* O; int ldo; int ncols; const GAS float* ss;
  __device__ __forceinline__ void operator()(const f32x4 (&acc)[2][2][4][2], const Unit& u, int wr, int wc, int fr, int fq) const {
    const int row0 = u.pm * BM + wr * 64 + fr, col0 = u.pn * BM + wc * 32 + 8 * fq;
#pragma unroll
    for (int ai = 0; ai < 2; ++ai)
#pragma unroll
      for (int m = 0; m < 4; ++m) {
        const int row = row0 + ai * HALF + m * 16;
        const float rs = row_rstd(ss, row);
        GAS bf16_t* rowp = O + (size_t)row * ldo + col0;
#pragma unroll
        for (int bj = 0; bj < 2; ++bj) {
          if (col0 + bj * HALF < ncols) {
            const f32x4 v0 = acc[ai][bj][m][0] * rs, v1 = acc[ai][bj][m][1] * rs;
            u32x4 w; w.x = cvt_pk_bf16(v0[0], v0[1]); w.y = cvt_pk_bf16(v0[2], v0[3]); w.z = cvt_pk_bf16(v1[0], v1[1]); w.w = cvt_pk_bf16(v1[2], v1[3]);
            *(GAS u32x4*)(rowp + bj * HALF) = w;
          }
        }
      }
  }
};
struct EpiRes {
  static constexpr bool PERM = true;
  const GAS bf16_t* Xin; GAS bf16_t* Xout; GAS float* ssn; int write_ss; GAS float* slab; int nsl; LAS float* red;
  __device__ __forceinline__ void operator()(const f32x4 (&acc)[2][2][4][2], const Unit& u, int wr, int wc, int fr, int fq) const {
    if (write_ss < 0) return;
    if (u.slice) {
      GAS float* sb = slab + ((size_t)(((u.pm - 64) * 4 + u.pn) * nsl + (u.slice - 1)) * 256 + wr * 64 + fr) * 256 + wc * 32 + 8 * fq;
#pragma unroll
      for (int ai = 0; ai < 2; ++ai)
#pragma unroll
        for (int m = 0; m < 4; ++m)
#pragma unroll
          for (int bj = 0; bj < 2; ++bj)
#pragma unroll
            for (int n = 0; n < 2; ++n) *(GAS f32x4*)(sb + (size_t)(ai * HALF + m * 16) * 256 + bj * HALF + n * 4) = acc[ai][bj][m][n];
      return;
    }
    const int row0 = u.pm * BM + wr * 64 + fr, col0 = u.pn * BM + wc * 32 + 8 * fq;
#pragma unroll
    for (int ai = 0; ai < 2; ++ai)
#pragma unroll
      for (int m = 0; m < 4; ++m) {
        const int row = row0 + ai * HALF + m * 16;
        const size_t ro = (size_t)row * DM + col0;
        float sq = 0.f;
#pragma unroll
        for (int bj = 0; bj < 2; ++bj) {
          const u32x4 xi = *(const GAS u32x4*)(Xin + ro + bj * HALF);
          const f32x4 x0 = (f32x4){__builtin_bit_cast(float, xi.x << 16), __builtin_bit_cast(float, xi.x & 0xffff0000u), __builtin_bit_cast(float, xi.y << 16), __builtin_bit_cast(float, xi.y & 0xffff0000u)} + acc[ai][bj][m][0];
          const f32x4 x1 = (f32x4){__builtin_bit_cast(float, xi.z << 16), __builtin_bit_cast(float, xi.z & 0xffff0000u), __builtin_bit_cast(float, xi.w << 16), __builtin_bit_cast(float, xi.w & 0xffff0000u)} + acc[ai][bj][m][1];
          u32x4 w; w.x = cvt_pk_bf16(x0[0], x0[1]); w.y = cvt_pk_bf16(x0[2], x0[3]); w.z = cvt_pk_bf16(x1[0], x1[1]); w.w = cvt_pk_bf16(x1[2], x1[3]);
          *(GAS u32x4*)(Xout + ro + bj * HALF) = w;
          sq += x0[0] * x0[0] + x0[1] * x0[1] + x0[2] * x0[2] + x0[3] * x0[3] + x1[0] * x1[0] + x1[1] * x1[1] + x1[2] * x1[2] + x1[3] * x1[3];
        }
        if (write_ss) {
          sq += __shfl_xor(sq, 16); sq += __shfl_xor(sq, 32);
          if (fq == 0) red[(ai * HALF + wr * 64 + m * 16 + fr) * 4 + wc] = sq;
        }
      }
    if (write_ss) {
      asm volatile("s_waitcnt lgkmcnt(0)" ::: "memory"); __builtin_amdgcn_s_barrier(); asm volatile("" ::: "memory");
      const int t2 = wr * 256 + wc * 64 + fq * 16 + fr;
      if (t2 < 256) { const f32x4 q = *(const LAS f32x4*)(red + t2 * 4); ssn[(size_t)(u.pm * BM + t2) * 4 + u.pn] = ((q[0] + q[1]) + q[2]) + q[3]; }
    }
  }
};
constexpr size_t FS_G = (size_t)MPAD * DFF;
constexpr size_t FS_UH = FS_G, FS_UD = FS_UH + (size_t)256 * 2 * DFF, FS_GD = FS_UD + (size_t)256 * 2 * DFF, FS_US = FS_GD + (size_t)256 * 2 * DFF, FS_GS = FS_US + (size_t)512 * DFF;
static_assert((FS_GS + (size_t)512 * DFF) * 2 <= (size_t)MPAD * PLD * 2, "FFN side buffers fit in BIG");
__device__ __forceinline__ float dpp_prev(float prv, float cur, int sh) {
  const int pr = __builtin_bit_cast(int, prv), cu = __builtin_bit_cast(int, cur);
  int r;
  if (sh == 1) { const int o = __builtin_amdgcn_update_dpp(0, pr, 0x121, 0xf, 0xf, false); r = __builtin_amdgcn_update_dpp(o, cu, 0x111, 0xf, 0xf, false); }
  else { const int o = __builtin_amdgcn_update_dpp(0, pr, 0x122, 0xf, 0xf, false); r = __builtin_amdgcn_update_dpp(o, cu, 0x112, 0xf, 0xf, false); }
  return __builtin_bit_cast(float, r);
}
struct EpiUpConv {
  static constexpr bool PERM = true;
  GAS bf16_t* G; const GAS float* ss; const GAS float* cw; const GAS float* cb;
  __device__ __forceinline__ void operator()(const f32x4 (&acc)[2][2][4][2], const Unit& u, int wr, int wc, int fr, int fq) const {
    const int row0 = u.pm * BM + wr * 64 + fr, ff0 = u.pn * 128 + wc * 32 + 8 * fq;
    const bool spec = u.pm >= 64;
    f32x4 w0[2], w1[2], w2[2], bb[2];
#pragma unroll
    for (int n = 0; n < 2; ++n) { w0[n] = *(const GAS f32x4*)(cw + ff0 + 4 * n); w1[n] = *(const GAS f32x4*)(cw + DFF + ff0 + 4 * n); w2[n] = *(const GAS f32x4*)(cw + 2 * DFF + ff0 + 4 * n); bb[n] = *(const GAS f32x4*)(cb + ff0 + 4 * n); }
#pragma unroll
    for (int ai = 0; ai < 2; ++ai) {
      f32x4 prv[2] = {(f32x4){0.f, 0.f, 0.f, 0.f}, (f32x4){0.f, 0.f, 0.f, 0.f}};
      const int stripe = u.pm * 4 + ai * 2 + wr;
#pragma unroll
      for (int m = 0; m < 4; ++m) {
        const int row = row0 + ai * HALF + m * 16;
        const float rs = row_rstd(ss, row);
        f32x4 cur[2], gt[2], o[2];
#pragma unroll
        for (int n = 0; n < 2; ++n) {
          cur[n] = acc[ai][0][m][n] * rs; gt[n] = acc[ai][1][m][n] * rs;
#pragma unroll
          for (int uu = 0; uu < 4; ++uu) {
            const float p1 = dpp_prev(prv[n][uu], cur[n][uu], 1), p2 = dpp_prev(prv[n][uu], cur[n][uu], 2);
            const float val = w0[n][uu] * p2 + w1[n][uu] * p1 + w2[n][uu] * cur[n][uu] + bb[n][uu];
            o[n][uu] = val * __builtin_amdgcn_rcpf(1.f + __expf(-val)) * gt[n][uu];
          }
          prv[n] = cur[n];
        }
        u32x4 w; w.x = cvt_pk_bf16(o[0][0], o[0][1]); w.y = cvt_pk_bf16(o[0][2], o[0][3]); w.z = cvt_pk_bf16(o[1][0], o[1][1]); w.w = cvt_pk_bf16(o[1][2], o[1][3]);
        *(GAS u32x4*)(G + (size_t)row * DFF + ff0) = w;
        const bool needu = spec || (m == 0 && fr < 2) || (m == 3 && fr >= 14);
        if (needu) {
          u32x4 wu; wu.x = cvt_pk_bf16(cur[0][0], cur[0][1]); wu.y = cvt_pk_bf16(cur[0][2], cur[0][3]); wu.z = cvt_pk_bf16(cur[1][0], cur[1][1]); wu.w = cvt_pk_bf16(cur[1][2], cur[1][3]);
          u32x4 wg; wg.x = cvt_pk_bf16(gt[0][0], gt[0][1]); wg.y = cvt_pk_bf16(gt[0][2], gt[0][3]); wg.z = cvt_pk_bf16(gt[1][0], gt[1][1]); wg.w = cvt_pk_bf16(gt[1][2], gt[1][3]);
          if (spec) { *(GAS u32x4*)(G + FS_US + (size_t)(row - R_SAMP) * DFF + ff0) = wu; *(GAS u32x4*)(G + FS_GS + (size_t)(row - R_SAMP) * DFF + ff0) = wg; }
          else if (m == 0) { *(GAS u32x4*)(G + FS_UD + ((size_t)stripe * 2 + fr) * DFF + ff0) = wu; *(GAS u32x4*)(G + FS_GD + ((size_t)stripe * 2 + fr) * DFF + ff0) = wg; }
          else *(GAS u32x4*)(G + FS_UH + ((size_t)stripe * 2 + (fr - 14)) * DFF + ff0) = wu;
        }
      }
    }
  }
};
}


#define XB_TMO      128
#define XB_XCNT(j)  (256  + 64 * (j))
#define XB_XSUB(j)  (1280 + 64 * (j))
#define XB_XGEN(j)  (2304 + 64 * (j))
#define XB_TOP      3328
#define XB_TOPGEN   3392
#define XCD_BAR_WORDS 3456
#define XB_SPIN_CAP (1u << 20)
__device__ __forceinline__ unsigned xb_ld(unsigned* p)              { return __hip_atomic_load(p, __ATOMIC_RELAXED, __HIP_MEMORY_SCOPE_AGENT); }
__device__ __forceinline__ unsigned xb_add(unsigned* p, unsigned v) { return __hip_atomic_fetch_add(p, v, __ATOMIC_RELAXED, __HIP_MEMORY_SCOPE_AGENT); }
__device__ __forceinline__ unsigned xb_xcc_id() { return (unsigned)__builtin_amdgcn_s_getreg((3 << 11) | 20) & 0xFu; }
#define XB_SPIN(cond, bar) do { unsigned _sp = 0; while (cond) { __builtin_amdgcn_s_sleep(1); \
    if ((++_sp & 255u) == 0u) { if (xb_ld(&(bar)[XB_TMO])) break; if (_sp > XB_SPIN_CAP) { atomicAdd(&(bar)[XB_TMO], 1u); break; } } } } while (0)
__device__ __forceinline__ void xcd_barrier_complete(unsigned* bar, unsigned x, unsigned& nloc, unsigned& nx) {
  const unsigned G = gridDim.x * gridDim.y * gridDim.z;
  unsigned sum, cnt, mine, sp = 0u;
  for (;;) {
    sum = 0u; cnt = 0u; mine = 0u;
#pragma unroll
    for (unsigned j = 0; j < 16; ++j) { const unsigned c = xb_ld(&bar[XB_XCNT(j)]); sum += c; cnt += (c > 0u) ? 1u : 0u; mine = (j == x) ? c : mine; }
    if (sum == G) break;
    __builtin_amdgcn_s_sleep(1);
    if ((++sp & 255u) == 0u) { if (xb_ld(&bar[XB_TMO])) break; if (sp > XB_SPIN_CAP) { atomicAdd(&bar[XB_TMO], 1u); break; } }
  }
  nloc = mine > 0u ? mine : 1u; nx = cnt > 0u ? cnt : 1u;
}
__device__ __forceinline__ void xcd_barrier(unsigned* bar, volatile LAS unsigned* st, bool tid0) {
  asm volatile("s_waitcnt vmcnt(0)" ::: "memory");
  __syncthreads();
  if (tid0) {
    __builtin_amdgcn_s_waitcnt(0);
    const unsigned x = xb_xcc_id();
    unsigned nloc = st[0], nx = st[1];
    if (nloc == 0u) { xcd_barrier_complete(bar, x, nloc, nx); st[0] = nloc; st[1] = nx; }
    const unsigned old = xb_add(&bar[XB_XSUB(x)], 1u);
    const unsigned gen = old / nloc;
    if (old + 1u == (gen + 1u) * nloc) {
      __builtin_amdgcn_fence(__ATOMIC_RELEASE, "agent");
      asm volatile("s_waitcnt vmcnt(0)" ::: "memory");
      const unsigned og = xb_add(&bar[XB_TOP], 1u);
      const unsigned tg = og / nx;
      if (og + 1u == (tg + 1u) * nx) xb_add(&bar[XB_TOPGEN], 1u);
      else XB_SPIN(xb_ld(&bar[XB_TOPGEN]) == tg, bar);
      __builtin_amdgcn_fence(__ATOMIC_ACQUIRE, "agent");
      xb_add(&bar[XB_XGEN(x)], 1u);
      asm volatile("s_waitcnt vmcnt(0)" ::: "memory");
    } else {
      XB_SPIN(xb_ld(&bar[XB_XGEN(x)]) == gen, bar);
      __builtin_amdgcn_fence(__ATOMIC_ACQUIRE, "agent");
      asm volatile("s_waitcnt vmcnt(0)" ::: "memory");
    }
  }
  __syncthreads();
}

__device__ __forceinline__ void transpose_item(const GAS float* W, int N, int k0, int n0, int nvalid, const GAS float* scale, GAS bf16_t* WT, int ldt, int dst_row0, int dst_k0, LAS float* scr, int lane) {
  {
    const int n4 = 4 * (lane & 7);
    f32x4 v[8];
#pragma unroll
    for (int i = 0; i < 8; ++i) {
      const int kk = (lane >> 3) + 8 * i;
      v[i] = (n0 + n4 < nvalid) ? *(const GAS f32x4*)(W + (size_t)(k0 + kk) * N + n0 + n4) : (f32x4){0.f, 0.f, 0.f, 0.f};
    }
#pragma unroll
    for (int i = 0; i < 8; ++i) {
      const int kk = (lane >> 3) + 8 * i;
      const float sc = scale ? scale[k0 + kk] : 1.f;
      scr[kk * 33 + n4] = v[i][0] * sc; scr[kk * 33 + n4 + 1] = v[i][1] * sc; scr[kk * 33 + n4 + 2] = v[i][2] * sc; scr[kk * 33 + n4 + 3] = v[i][3] * sc;
    }
  }
  asm volatile("s_waitcnt lgkmcnt(0)" ::: "memory");
  const int c = lane & 7;
#pragma unroll
  for (int j = 0; j < 4; ++j) {
    const int n = (lane >> 3) + 8 * j; const LAS float* s = scr + (8 * c) * 33 + n;
    u32x4 o; o.x = pk2(s[0 * 33], s[1 * 33]); o.y = pk2(s[2 * 33], s[3 * 33]); o.z = pk2(s[4 * 33], s[5 * 33]); o.w = pk2(s[6 * 33], s[7 * 33]);
    *(GAS u32x4*)(WT + (size_t)(dst_row0 + n) * ldt + dst_k0 + 8 * c) = o;
  }
  asm volatile("s_waitcnt lgkmcnt(0)" ::: "memory");
}

constexpr int WI_IN = 16 * 128, WI_OUT = 16 * 32, WI_UP = 16 * 176, WI_DN = 44 * 32, WI_L = WI_IN + WI_OUT + WI_UP + WI_DN;
__device__ __forceinline__ void convert_weights(const GAS float* w_in, const GAS float* nmix, const GAS float* w_out, const GAS float* w_up, const GAS float* nffn, const GAS float* w_dn,
                                                GAS unsigned char* ws, int l, int r_lo, int r_hi, int widx, int nw, LAS float* scr, int lane) {
  for (int r0 = r_lo + widx; r0 < r_hi; r0 += nw) {
    int r = r0;
    if (r < WI_IN) {
      const int kb = r / 128, nb = r % 128;
      transpose_item(w_in + (size_t)l * DM * DIN, DIN, kb * 64, nb * 32, DIN, nmix + l * DM, (GAS bf16_t*)(ws + WS_WIN) + (size_t)l * NINP * DM, DM, nb * 32, kb * 64, scr, lane);
      continue; }
    r -= WI_IN;
    if (r < WI_OUT) {
      const int kb = r / 32, nb = r % 32;
      transpose_item(w_out + (size_t)l * DM * DM, DM, kb * 64, nb * 32, DM, nullptr, (GAS bf16_t*)(ws + WS_WOUT) + (size_t)l * DM * DM, DM, nb * 32, kb * 64, scr, lane);
      continue; }
    r -= WI_OUT;
    if (r < WI_UP) {
      const int kb = r / 176, nb = r % 176;
      const int drow = nb * 32, pn = drow >> 8, j = drow & 255;
      const int src = (j < 128) ? (128 * pn + j) : (DFF + 128 * pn + (j - 128));
      transpose_item(w_up + (size_t)l * DM * 2 * DFF, 2 * DFF, kb * 64, src, 2 * DFF, nffn + l * DM, (GAS bf16_t*)(ws + WS_WUP) + (size_t)l * 2 * DFF * DM, DM, drow, kb * 64, scr, lane);
      continue; }
    r -= WI_UP;
    {
      const int kb = r / 32, nb = r % 32;
      transpose_item(w_dn + (size_t)l * DFF * DM, DM, kb * 64, nb * 32, DM, nullptr, (GAS bf16_t*)(ws + WS_WDN) + (size_t)l * DM * DFF, DFF, nb * 32, kb * 64, scr, lane);
    }
  }
}

__device__ __forceinline__ void phase_prologue(const Params& p, LAS unsigned char* lds) {
  const int tid = threadIdx.x, lane = tid & 63, wave = tid >> 6;
  const int gw = blockIdx.x * 8 + wave, NGW = gridDim.x * 8;
  LAS float* scr = (LAS float*)(lds + wave * 16384);
  unsigned char* ws = p.ws;
  convert_weights((const GAS float*)p.in[11], (const GAS float*)p.in[10], (const GAS float*)p.in[28], (const GAS float*)p.in[30], (const GAS float*)p.in[29], (const GAS float*)p.in[33], (GAS unsigned char*)ws, 0, 0, WI_IN + WI_OUT + WI_UP, gw, NGW, scr, lane);
  {
    bf16_t* lo = (bf16_t*)(ws + WS_LORA);
    for (int idx = blockIdx.x * 512 + tid; idx < DEPTH * AH * 16384; idx += gridDim.x * 512) {
      const int l = idx / (AH * 16384), h = (idx / 16384) % AH, e = idx % 16384;
      float v;
      if (e < 4096) v = p.in[14][((size_t)l * 64 + (e & 63)) * AW + h * 64 + (e >> 6)];
      else if (e < 8192) v = p.in[16][((size_t)l * 64 + (e & 63)) * AW + h * 64 + ((e - 4096) >> 6)];
      else v = p.in[17][((size_t)l * 128 + ((e - 8192) & 127)) * AW + h * 64 + ((e - 8192) >> 7)];
      lo[idx] = (bf16_t)f2bf(v);
    }
  }
  {
    bf16_t* zr = (bf16_t*)(ws + WS_ZROW); bf16_t* shb = (bf16_t*)(ws + WS_SHIFTB);
    for (int idx = blockIdx.x * 512 + tid; idx < 4096 + DEPTH * SBN * ACOLS; idx += gridDim.x * 512) {
      if (idx < 4096) zr[idx] = 0; else shb[idx - 4096] = (bf16_t)f2bf(p.in[2][idx - 4096]);
    }
    bf16_t* cvb = (bf16_t*)(ws + WS_CONVB);
    for (int idx = blockIdx.x * 512 + tid; idx < DEPTH * SBN * 3 * 1024; idx += gridDim.x * 512) cvb[idx] = (bf16_t)f2bf(p.in[4][idx]);
  }
  float* ss = (float*)(ws + WS_SS);
  bf16_t* Xb0 = (bf16_t*)(ws + WS_XB0);
  for (int r = gw; r < MPAD; r += NGW) {
    const float* src = nullptr;
    if (r < R_SAMP) src = p.in[0] + (size_t)r * DM;
    else if (r < R_META) src = p.in[1] + (size_t)(r - R_SAMP) * DM;
    else if (r < R_TOT) src = p.in[9] + (size_t)((r - R_META) & 15) * DM;
    float s = 0.f;
#pragma unroll
    for (int j = 0; j < 4; ++j) {
      f32x4 v = src ? *(const GAS f32x4*)((const GAS float*)src + 256 * j + 4 * lane) : (f32x4){0.f, 0.f, 0.f, 0.f};
      u32x2 w; w.x = pk2(v[0], v[1]); w.y = pk2(v[2], v[3]);
      *(GAS u32x2*)((GAS bf16_t*)Xb0 + (size_t)r * DM + 256 * j + 4 * lane) = w;
      s += v[0] * v[0] + v[1] * v[1] + v[2] * v[2] + v[3] * v[3];
    }
    s = wave_sum(s);
    if (lane == 0) *(GAS f32x4*)((GAS float*)ss + (size_t)r * 4) = (f32x4){s, 0.f, 0.f, 0.f};
  }
}

constexpr int RW_NPROMPT = NB * AH * 65, RW_NITEMS = RW_NPROMPT + SBN * AH;
constexpr int LDB = 72;
constexpr int ARRB = 64 * LDB * 2;
constexpr int LDF = 68;
constexpr int LDT = 65;
constexpr int L_R1 = 0;
constexpr int L_R2 = L_R1 + 8 * ARRB;
constexpr int L_R3 = L_R2 + 4 * ARRB;
constexpr int L_R4 = L_R3 + 2 * 64 * LDF * 4;
constexpr int L_R5 = L_R4 + ARRB;
constexpr int L_RWEND = L_R5 + (8 * 64 + 64 + 64) * 4;
static_assert(2 * 64 * LDT * 4 <= 2 * 64 * LDF * 4, "Tf + Zf fit in R3");
static_assert(L_RWEND <= 163840, "rwkv LDS");

__device__ __forceinline__ void rw_decode(int item, int& seq, int& h, int& chunk) {
  if (item < RW_NPROMPT) { chunk = item % 65; const int sh = item / 65; h = sh & 7; seq = sh >> 3; }
  else { const int r = item - RW_NPROMPT; chunk = 0; h = r & 7; seq = NB + (r >> 3); }
}
__device__ __forceinline__ int rw_row(int seq, int chunk, int t) {
  if (seq < NB) return chunk == 0 ? (R_META + 16 * seq + t) : (SEQ * seq + 64 * (chunk - 1) + t);
  return R_SAMP + 16 * (seq - NB) + t;
}
__device__ __forceinline__ bf16x8 ldfrag(const LAS bf16_t* p) { return *(const LAS bf16x8*)p; }
__device__ __forceinline__ bf16x8 ldfrag(const GAS bf16_t* p) { return *(const GAS bf16x8*)p; }
template <int K, class PX, class PY>
__device__ __forceinline__ f32x4 mma_nt(PX X, int ldx, PY Y, int ldy, int lane, f32x4 acc) {
  const int r = lane & 15, q = lane >> 4;
#pragma unroll
  for (int s = 0; s < K / 32; ++s) {
    const bf16x8 xb = ldfrag(X + r * ldx + 32 * s + 8 * q);
    const bf16x8 ya = ldfrag(Y + r * ldy + 32 * s + 8 * q);
    acc = __builtin_amdgcn_mfma_f32_16x16x32_bf16(ya, xb, acc, 0, 0, 0);
  }
  return acc;
}
template <int K, bool SWX, bool SWY, class PX, class PY>
__device__ __forceinline__ f32x4 mma_sw(PX X, int ldx, int xt, PY Y, int ldy, int yt, int lane, f32x4 acc) {
  const int r = lane & 15, q = lane >> 4;
  const int sx = SWX ? ((2 * xt + (r >> 3)) & 7) : 0, sy = SWY ? ((2 * yt + (r >> 3)) & 7) : 0;
#pragma unroll
  for (int s = 0; s < K / 32; ++s) {
    const bf16x8 xb = ldfrag(X + r * ldx + 8 * ((4 * s + q) ^ sx));
    const bf16x8 ya = ldfrag(Y + r * ldy + 8 * ((4 * s + q) ^ sy));
    acc = __builtin_amdgcn_mfma_f32_16x16x32_bf16(ya, xb, acc, 0, 0, 0);
  }
  return acc;
}
__device__ __forceinline__ u32x2 pack4(f32x4 v) { u32x2 w; w.x = pk2(v[0], v[1]); w.y = pk2(v[2], v[3]); return w; }

__device__ __forceinline__ const GAS bf16_t* rw_prev_row(const Ctx p, int l, int seq, int chunk, int t) {
  const GAS bf16_t* P = (const GAS bf16_t*)(p.ws + WS_BIG);
  if (t > 0) return P + (size_t)rw_row(seq, chunk, t - 1) * PLD;
  if (seq >= NB) return (const GAS bf16_t*)(p.ws + WS_SHIFTB) + ((size_t)l * SBN + (seq - NB)) * ACOLS;
  if (chunk == 0) return (const GAS bf16_t*)(p.ws + WS_ZROW);
  return P + (size_t)(chunk == 1 ? (R_META + 16 * seq + 15) : (rw_row(seq, chunk, 0) - 1)) * PLD;
}
__device__ __forceinline__ GAS bf16_t* rw_trec(GAS unsigned char* ws, int l, int item) {
  const int lo = 1 - l;
  if (item < 1408) return (GAS bf16_t*)(ws + WS_WUP + (size_t)lo * 2 * DFF * DM * 2) + (size_t)item * 4096;
  if (item < 2112) return (GAS bf16_t*)(ws + WS_WDN + (size_t)lo * DM * DFF * 2) + (size_t)(item - 1408) * 4096;
  return (GAS bf16_t*)(ws + WS_WOUT + (size_t)lo * DM * DM * 2) + (size_t)(item - 2112) * 4096;
}
static_assert(DEPTH == 2 && RW_NITEMS == 2208, "T record placement");
constexpr int RW_LC = 62;
constexpr int RW_NLITE = 1984;
static_assert((size_t)MPAD * DM * 2 + (size_t)RW_NLITE * 16384 <= (size_t)NB * SEQ * DM * 4, "Qh / Yhat records fit behind MIX in d_out");
__device__ __forceinline__ GAS bf16_t* rw_qrec(const Ctx p, int l, int seq, int h, int chunk) {
  if (seq < NB && chunk < RW_LC) return (GAS bf16_t*)p.out + (size_t)MPAD * DM + (size_t)((seq * 8 + h) * RW_LC + chunk) * 8192;
  const int hidx = seq < NB ? (seq * 8 + h) * 3 + (chunk - RW_LC) : NB * 8 * 3 + (seq - NB) * 8 + h;
  return (GAS bf16_t*)(p.ws + WS_WUP + (size_t)(1 - l) * 2 * DFF * DM * 2) + (size_t)hidx * 8192;
}
struct RwPref { u32x4 lc[4], lp[4], rc[3], rp[3]; };
template <int LIST>
__device__ __forceinline__ void rw_item_ids(int h, int k, int& seq, int& chunk, int& item) {
  if (LIST == 0) {
    if (k < NB * 65) { seq = k / 65; chunk = k - seq * 65; } else { seq = NB + (k - NB * 65); chunk = 0; }
  } else if (LIST == 1) {
    if (k < NB * 3) { seq = k / 3; chunk = RW_LC + (k - seq * 3); } else { seq = NB + (k - NB * 3); chunk = 0; }
  } else { seq = k / RW_LC; chunk = k - seq * RW_LC; }
  item = seq < NB ? (seq * 8 + h) * 65 + chunk : RW_NPROMPT + (seq - NB) * 8 + h;
}
template <int MODE, int LIST>
__device__ __forceinline__ void rw_prefetch(const Ctx p, int l, int h, int k, int tid, RwPref& pf) {
  int seq, chunk, item; rw_item_ids<LIST>(h, k, seq, chunk, item);
  const int ntok = (chunk == 0) ? 16 : 64;
  const GAS bf16_t* P = (const GAS bf16_t*)(p.ws + WS_BIG);
  const u32x4 z = (u32x4){0u, 0u, 0u, 0u};
  const int grp = MODE == 1 ? (tid & 31) : (tid & 15), colL = 1536 + 8 * grp;
#pragma unroll
  for (int u = 0; u < (MODE == 1 ? 4 : 2); ++u) {
    const int t = MODE == 1 ? ((tid >> 5) + 16 * u) : ((tid >> 4) + 32 * u);
    if (t < ntok) { pf.lc[u] = *(const u32x4*)(P + (size_t)rw_row(seq, chunk, t) * PLD + colL); pf.lp[u] = *(const u32x4*)(rw_prev_row(p, l, seq, chunk, t) + colL); }
    else { pf.lc[u] = z; pf.lp[u] = z; }
  }
  const int t2 = tid >> 3, hc0 = h * 64 + 8 * (tid & 7);
  if (t2 < ntok) {
    const GAS bf16_t* rb = P + (size_t)rw_row(seq, chunk, t2) * PLD; const GAS bf16_t* pb = rw_prev_row(p, l, seq, chunk, t2);
#pragma unroll
    for (int part = 0; part < 3; ++part) { pf.rc[part] = *(const u32x4*)(rb + part * 512 + hc0); pf.rp[part] = *(const u32x4*)(pb + part * 512 + hc0); }
  } else {
#pragma unroll
    for (int part = 0; part < 3; ++part) { pf.rc[part] = z; pf.rp[part] = z; }
  }
}
__device__ __forceinline__ void unpack8(const u32x4 w, float* o) { o[0] = bflo(w.x); o[1] = bfhi(w.x); o[2] = bflo(w.y); o[3] = bfhi(w.y); o[4] = bflo(w.z); o[5] = bfhi(w.z); o[6] = bflo(w.w); o[7] = bfhi(w.w); }

constexpr int L_PRM = L_RWEND;
static_assert(L_PRM + 640 * 4 <= 163824, "rwkv params LDS");

template <int MODE>
__device__ __forceinline__ void rwkv_phase(const Ctx p, int l, LAS unsigned char* lds, int rep) {
  const int tid0 = opaque_tid(p.wv);
  const int h = p.bid & 7, slot = p.bid >> 3, nslot = p.nblk >> 3;
  constexpr int LIST = MODE;
  constexpr int NK = MODE == 0 ? NB * 65 + SBN : NB * 3 + SBN;
  LAS bf16_t* A_row = (LAS bf16_t*)(lds + L_R1);            LAS bf16_t* B_row = A_row + 64 * LDB;  LAS bf16_t* K_row = B_row + 64 * LDB;  LAS bf16_t* R_row = K_row + 64 * LDB;
  LAS bf16_t* AT = R_row + 64 * LDB;  LAS bf16_t* VT = AT + 64 * LDB;  LAS bf16_t* BCT = VT + 64 * LDB;  LAS bf16_t* KCT = BCT + 64 * LDB;
  LAS bf16_t* WT = A_row; LAS bf16_t* X1T = B_row; LAS bf16_t* UT = K_row;
  LAS bf16_t* XW = (LAS bf16_t*)(lds + L_R2); LAS bf16_t* XA = XW + 64 * LDB; LAS bf16_t* XG = XA + 64 * LDB;
  LAS bf16_t* Aak = (LAS bf16_t*)(lds + L_R2); LAS bf16_t* Arb = Aak + 64 * LDB; LAS bf16_t* Ark = Arb + 64 * LDB; LAS bf16_t* Tb = Ark + 64 * LDB;
  LAS float* F0 = (LAS float*)(lds + L_R3); LAS float* F1 = F0 + 64 * LDF;
  LAS float* Tf = (LAS float*)(lds + L_R3); LAS float* Zf = Tf + 64 * LDT;
  LAS bf16_t* Gb = (LAS bf16_t*)(lds + L_R4);
  LAS float* segsum = (LAS float*)(lds + L_R5); LAS float* cumC = segsum + 512; LAS float* bonS = cumC + 64;
  LAS float* prm = (LAS float*)(lds + L_PRM);
  constexpr int LDG = 136;
  const GAS bf16_t* P = (const GAS bf16_t*)(p.ws + WS_BIG);

  if (tid0 < 192) prm[tid0] = p.in[12][(size_t)l * ACOLS + (tid0 >> 6) * 512 + h * 64 + (tid0 & 63)];
  else if (tid0 < 256) {
    const int c = tid0 - 192, hc = l * AW + h * 64 + c;
    prm[192 + c] = p.in[13][hc]; prm[256 + c] = p.in[15][hc]; prm[320 + c] = p.in[18][hc]; prm[384 + c] = p.in[19][hc]; prm[448 + c] = p.in[20][hc];
    prm[512 + c] = p.in[21][hc]; prm[576 + c] = p.in[22][hc];
  }
  float muL[8];
  { const GAS float* mu = p.in[12] + (size_t)l * ACOLS + 1536 + 8 * (MODE == 1 ? (tid0 & 31) : (tid0 & 15));
#pragma unroll
    for (int i = 0; i < 8; ++i) muL[i] = mu[i]; }
  const GAS bf16_t* w2T = (const GAS bf16_t*)(p.ws + WS_LORA) + ((size_t)l * AH + h) * 16384;
  const GAS bf16_t* a2T = w2T + 4096; const GAS bf16_t* g2T = w2T + 8192;

  const bool bal = (MODE == 0) && (nslot == 32);
  int xk = -1;
  if (bal && slot < 26 && (p.bid % 13) >= 9) { int rank = 0; for (int s2 = 0; s2 < slot; ++s2) rank += ((h + 8 * s2) % 13) >= 9 ? 1 : 0; if (rank < 8) xk = 256 + rank; }
  const int nmine = bal ? (slot < 26 ? (xk >= 0 ? 9 : 8) : 10) : (MODE == 1 ? (NK - (nslot - 1 - slot) + nslot - 1) / nslot : (NK - slot + nslot - 1) / nslot);
#define RW_KTH(j) (MODE == 1 ? (nslot - 1 - slot) + (j) * nslot : bal ? ((j) < 8 ? (j) * 32 + slot : (slot < 26 ? xk : 264 + ((j) - 8) * 6 + (slot - 26))) : (slot + (j) * nslot))
  const int lane_h = tid0 & 63, fr = lane_h & 15, fq = lane_h >> 4, jt0_ = ((tid0 >> 6) & 1) * 2;
    bf16x8 fw[2][2], fa[2][2], fg[2][4];
#pragma unroll
    for (int jj = 0; jj < 2; ++jj) {
#pragma unroll
      for (int s = 0; s < 2; ++s) { fw[jj][s] = *(const bf16x8*)(w2T + (16 * (jt0_ + jj) + fr) * 64 + 32 * s + 8 * fq); fa[jj][s] = *(const bf16x8*)(a2T + (16 * (jt0_ + jj) + fr) * 64 + 32 * s + 8 * fq); }
      if (MODE == 1) {
#pragma unroll
        for (int s = 0; s < 4; ++s) fg[jj][s] = *(const bf16x8*)(g2T + (16 * (jt0_ + jj) + fr) * 128 + 32 * s + 8 * fq);
      }
    }
  RwPref pf;
  int jj = 0;
  if (jj < nmine * rep) rw_prefetch<MODE, LIST>(p, l, h, RW_KTH(jj % nmine), tid0, pf);
  __syncthreads();
#pragma unroll 1
  for (; jj < nmine * rep; ++jj) {
    const int k = RW_KTH(jj % nmine);
    int tid = tid0; asm volatile("" : "+v"(tid));
    const int lane = tid & 63, wave = tid >> 6, fr = lane & 15, fq = lane >> 4, t = tid >> 3, cg = tid & 7, c0 = 8 * cg, hc0 = h * 64 + c0;
    int seq, chunk, item; rw_item_ids<LIST>(h, k, seq, chunk, item);
    const bool samp = seq >= NB; const int sb = seq - NB;
    const int ntok = (chunk == 0) ? 16 : 64;
    const int it_ = wave >> 1, jt0_ = (wave & 1) * 2;
    const bool sto = (MODE == 0);
    {
      const int grp = MODE == 1 ? (tid & 31) : (tid & 15);
#pragma unroll
      for (int u = 0; u < (MODE == 1 ? 4 : 2); ++u) {
        const int tt = MODE == 1 ? ((tid >> 5) + 16 * u) : ((tid >> 4) + 32 * u);
        float cur[8], prv[8], o[8];
        unpack8(pf.lc[u], cur); unpack8(pf.lp[u], prv);
        const bool valid = tt < ntok;
#pragma unroll
        for (int i = 0; i < 8; ++i) {
          const float pm = cur[i] + (prv[i] - cur[i]) * muL[i];
          const float sg = __builtin_amdgcn_rcpf(1.f + __expf(grp < 8 ? -2.f * pm : -pm));
          o[i] = grp < 8 ? 2.f * sg - 1.f : (grp < 16 ? pm : sg);
          if (!valid) o[i] = 0.f;
        }
        u32x4 w; w.x = pk2(o[0], o[1]); w.y = pk2(o[2], o[3]); w.z = pk2(o[4], o[5]); w.w = pk2(o[6], o[7]);
        if (grp < 8) *(LAS u32x4*)(XW + tt * LDB + 8 * grp) = w;
        else if (grp < 16) *(LAS u32x4*)(XA + tt * LDB + 8 * (grp - 8)) = w;
        else if (MODE == 1) *(LAS u32x4*)(XG + tt * LDG + 8 * (grp - 16)) = w;
      }
    }
    __syncthreads();
    {
#pragma unroll
      for (int jj = 0; jj < 2; ++jj) {
        const int jt = jt0_ + jj;
        f32x4 aw = (f32x4){0.f, 0.f, 0.f, 0.f}, aa = aw;
#pragma unroll
        for (int s = 0; s < 2; ++s) {
          aw = __builtin_amdgcn_mfma_f32_16x16x32_bf16(fw[jj][s], ldfrag(XW + (16 * it_ + fr) * LDB + 32 * s + 8 * fq), aw, 0, 0, 0);
          aa = __builtin_amdgcn_mfma_f32_16x16x32_bf16(fa[jj][s], ldfrag(XA + (16 * it_ + fr) * LDB + 32 * s + 8 * fq), aa, 0, 0, 0);
        }
        *(LAS f32x4*)(F0 + (16 * it_ + fr) * LDF + 16 * jt + 4 * fq) = aw;
        *(LAS f32x4*)(F1 + (16 * it_ + fr) * LDF + 16 * jt + 4 * fq) = aa;
        if (MODE == 1) {
          f32x4 ag = (f32x4){0.f, 0.f, 0.f, 0.f};
#pragma unroll
          for (int s = 0; s < 4; ++s) ag = __builtin_amdgcn_mfma_f32_16x16x32_bf16(fg[jj][s], ldfrag(XG + (16 * it_ + fr) * LDG + 32 * s + 8 * fq), ag, 0, 0, 0);
          *(LAS u32x2*)(Gb + (16 * it_ + fr) * LDB + 16 * jt + 4 * fq) = pack4(ag);
        }
      }
    }
    __syncthreads();
    float rr[8], kb[8], k2[8], vv[8], lw[8], nk[8];
    {
      const bool valid = t < ntok;
      float kraw[8];
#pragma unroll
      for (int part = 0; part < 3; ++part) {
        float cur[8], prv[8];
        unpack8(pf.rc[part], cur); unpack8(pf.rp[part], prv);
#pragma unroll
        for (int i = 0; i < 8; ++i) { const float pm = cur[i] + (prv[i] - cur[i]) * prm[part * 64 + c0 + i]; if (part == 0) rr[i] = pm; else if (part == 1) kraw[i] = pm; else vv[i] = pm; }
      }
      const f32x4 dw0 = *(const LAS f32x4*)(F0 + t * LDF + c0), dw1 = *(const LAS f32x4*)(F0 + t * LDF + c0 + 4);
      const f32x4 da0 = *(const LAS f32x4*)(F1 + t * LDF + c0), da1 = *(const LAS f32x4*)(F1 + t * LDF + c0 + 4);
      float nrm = 0.f, bon = 0.f, av[8];
#pragma unroll
      for (int i = 0; i < 8; ++i) {
        const float dwv = i < 4 ? dw0[i & 3] : dw1[i & 3], dav = i < 4 ? da0[i & 3] : da1[i & 3];
        const float wl = -softplusf_(-(prm[192 + c0 + i] + dwv)) - 0.5f;
        lw[i] = valid ? -__expf(wl) : 0.f;
        av[i] = sigmoidf_(prm[256 + c0 + i] + dav);
        nk[i] = kraw[i] * prm[320 + c0 + i];
        nrm += nk[i] * nk[i];
        k2[i] = kraw[i] * (1.f + (av[i] - 1.f) * prm[384 + c0 + i]);
        bon += rr[i] * k2[i] * prm[448 + c0 + i];
      }
      nrm += __shfl_xor(nrm, 1); nrm += __shfl_xor(nrm, 2); nrm += __shfl_xor(nrm, 4);
      bon += __shfl_xor(bon, 1); bon += __shfl_xor(bon, 2); bon += __shfl_xor(bon, 4);
      const float rn = rsqrtf(nrm + 1e-12f);
#pragma unroll
      for (int i = 0; i < 8; ++i) { nk[i] *= rn; kb[i] = nk[i] * av[i]; }
      if (MODE == 1 && cg == 0) bonS[t] = bon;
      if (MODE == 0 && cg == 0) ((GAS float*)(p.ws + WS_BONUS))[(size_t)item * 64 + t] = bon;
      *(LAS f32x4*)(F0 + t * LDF + c0) = (f32x4){lw[0], lw[1], lw[2], lw[3]};
      *(LAS f32x4*)(F0 + t * LDF + c0 + 4) = (f32x4){lw[4], lw[5], lw[6], lw[7]};
    }
    __syncthreads();
    {
      const int c = tid & 63, seg = tid >> 6;
      float s = 0.f;
#pragma unroll
      for (int i = 0; i < 8; ++i) { s += F0[(8 * seg + i) * LDF + c]; F0[(8 * seg + i) * LDF + c] = s; }
      segsum[seg * 64 + c] = s;
      __syncthreads();
      float off = 0.f;
      for (int s2 = 0; s2 < seg; ++s2) off += segsum[s2 * 64 + c];
#pragma unroll
      for (int i = 0; i < 8; ++i) F0[(8 * seg + i) * LDF + c] += off;
      if (seg == 7) cumC[c] = s + off;
    }
    __syncthreads();
    {
      const f32x4 cu0 = *(const LAS f32x4*)(F0 + t * LDF + c0), cu1 = *(const LAS f32x4*)(F0 + t * LDF + c0 + 4);
      float oa[8], ob[8], ok[8], orr[8], obc[8], okc[8];
#pragma unroll
      for (int i = 0; i < 8; ++i) {
        const float cu = i < 4 ? cu0[i & 3] : cu1[i & 3], cc = cumC[c0 + i];
        const float ec = __expf(cu), em1 = __expf(cu - lw[i]), ei = __expf(-cu), eC = __expf(cc - cu);
        oa[i] = -nk[i] * em1; ob[i] = kb[i] * ei; ok[i] = k2[i] * ei; orr[i] = rr[i] * ec; obc[i] = kb[i] * eC; okc[i] = k2[i] * eC;
      }
      u32x4 w;
      w.x = pk2(oa[0], oa[1]); w.y = pk2(oa[2], oa[3]); w.z = pk2(oa[4], oa[5]); w.w = pk2(oa[6], oa[7]); *(LAS u32x4*)(A_row + t * LDB + c0) = w;
      w.x = pk2(ob[0], ob[1]); w.y = pk2(ob[2], ob[3]); w.z = pk2(ob[4], ob[5]); w.w = pk2(ob[6], ob[7]); *(LAS u32x4*)(B_row + t * LDB + c0) = w;
      w.x = pk2(ok[0], ok[1]); w.y = pk2(ok[2], ok[3]); w.z = pk2(ok[4], ok[5]); w.w = pk2(ok[6], ok[7]); *(LAS u32x4*)(K_row + t * LDB + c0) = w;
      if (MODE == 1 || sto) { w.x = pk2(orr[0], orr[1]); w.y = pk2(orr[2], orr[3]); w.z = pk2(orr[4], orr[5]); w.w = pk2(orr[6], orr[7]); *(LAS u32x4*)(R_row + t * LDB + c0) = w; }
#pragma unroll
      for (int i = 0; i < 8; ++i) {
        const int so = (c0 + i) * LDB + (((t >> 3) ^ cg) << 3) + (t & 7);
        AT[so] = (bf16_t)f2bf(oa[i]); VT[so] = (bf16_t)f2bf(vv[i]);
        BCT[so] = (bf16_t)f2bf(obc[i]); KCT[so] = (bf16_t)f2bf(okc[i]);
      }
    }
    if (jj + 1 < nmine * rep) { int tidp = tid; asm volatile("" : "+v"(tidp)); rw_prefetch<MODE, LIST>(p, l, h, RW_KTH((jj + 1) % nmine), tidp, pf); }
    GAS bf16_t* MTg = (GAS bf16_t*)(p.ws + WS_AUX) + (size_t)item * 8192;
    u32x4 trec = (u32x4){0u, 0u, 0u, 0u};
    if (MODE == 1) trec = *(const GAS u32x4*)(rw_trec(p.ws, l, item) + t * 64 + c0);
    GAS bf16_t* Ng = MTg + 4096;
    __syncthreads();
    {
      const int it = wave >> 1, jt0 = (wave & 1) * 2;
#pragma unroll
      for (int jj = 0; jj < 2; ++jj) {
        const int jt = jt0 + jj, i = 16 * it + fr, j0 = 16 * jt + 4 * fq;
        f32x4 z = (f32x4){0.f, 0.f, 0.f, 0.f};
        f32x4 ab = z, ak = z;
        if (jt <= it) {
          if (MODE == 0) ab = mma_nt<64>(A_row + 16 * it * LDB, LDB, B_row + 16 * jt * LDB, LDB, lane, ab);
          ak = mma_nt<64>(A_row + 16 * it * LDB, LDB, K_row + 16 * jt * LDB, LDB, lane, ak);
        }
#pragma unroll
        for (int u = 0; u < 4; ++u) { if (j0 + u >= i) { ab[u] = 0.f; ak[u] = 0.f; } if (MODE == 0) Tf[i * LDT + j0 + u] = ab[u]; }
        *(LAS u32x2*)(Aak + i * LDB + j0) = pack4(ak);
        if (MODE == 1 || sto) {
          f32x4 rb = z, rk = z;
          if (jt <= it) {
            rb = mma_nt<64>(R_row + 16 * it * LDB, LDB, B_row + 16 * jt * LDB, LDB, lane, rb);
            rk = mma_nt<64>(R_row + 16 * it * LDB, LDB, K_row + 16 * jt * LDB, LDB, lane, rk);
          }
#pragma unroll
          for (int u = 0; u < 4; ++u) if (j0 + u > i) { rb[u] = 0.f; rk[u] = 0.f; }
          *(LAS u32x2*)(Arb + i * LDB + j0) = pack4(rb);
          *(LAS u32x2*)(Ark + i * LDB + j0) = pack4(rk);
        }
      }
    }
    if (MODE == 1) *(LAS u32x4*)(Tb + t * LDB + c0) = trec;
    __syncthreads();
    if (MODE == 0) {
    if (tid < 64) {
      const int b = tid >> 4, j = tid & 15; const LAS float* Ab = Tf + (16 * b) * LDT + 16 * b;
      float x[16];
#pragma unroll
      for (int i = 0; i < 16; ++i) {
        float s = (i == j) ? 1.f : 0.f;
#pragma unroll
        for (int m = 0; m < i; ++m) s += Ab[i * LDT + m] * x[m];
        x[i] = (i < j) ? 0.f : s;
      }
#pragma unroll
      for (int i = 0; i < 16; ++i) Tf[(16 * b + i) * LDT + 16 * b + j] = x[i];
    }
    __syncthreads();
    if (wave < 2) {
      const int r0 = 32 * wave + 16, cb = 32 * wave, lm = lane & 15, lk = lane >> 4;
      f32x4 z = (f32x4){0.f, 0.f, 0.f, 0.f};
#pragma unroll
      for (int ks = 0; ks < 4; ++ks) z = __builtin_amdgcn_mfma_f32_16x16x4f32(Tf[(r0 + lm) * LDT + cb + 4 * ks + lk], Tf[(cb + 4 * ks + lk) * LDT + cb + lm], z, 0, 0, 0);
#pragma unroll
      for (int r = 0; r < 4; ++r) Zf[(r0 + 4 * lk + r) * LDT + cb + lm] = z[r];
      asm volatile("s_waitcnt lgkmcnt(0)" ::: "memory");
      f32x4 o = (f32x4){0.f, 0.f, 0.f, 0.f};
#pragma unroll
      for (int ks = 0; ks < 4; ++ks) o = __builtin_amdgcn_mfma_f32_16x16x4f32(Tf[(r0 + lm) * LDT + r0 + 4 * ks + lk], Zf[(r0 + 4 * ks + lk) * LDT + cb + lm], o, 0, 0, 0);
#pragma unroll
      for (int r = 0; r < 4; ++r) Tf[(r0 + 4 * lk + r) * LDT + cb + lm] = o[r];
    }
    __syncthreads();
    if (wave < 4) {
      const int ti = wave >> 1, tj = wave & 1, lm = lane & 15, lk = lane >> 4;
      f32x4 z = (f32x4){0.f, 0.f, 0.f, 0.f};
#pragma unroll
      for (int ks = 0; ks < 8; ++ks) z = __builtin_amdgcn_mfma_f32_16x16x4f32(Tf[(32 + 16 * ti + lm) * LDT + 4 * ks + lk], Tf[(4 * ks + lk) * LDT + 16 * tj + lm], z, 0, 0, 0);
#pragma unroll
      for (int r = 0; r < 4; ++r) Zf[(32 + 16 * ti + 4 * lk + r) * LDT + 16 * tj + lm] = z[r];
    } else {
      const int w4 = tid - 256;
#pragma unroll
      for (int q = 0; q < 2; ++q) {
        const int idx = w4 + 256 * q;
        if (idx < 384) {
          const int row = idx < 256 ? (idx >> 3) : 32 + ((idx - 256) >> 2), ch = idx < 256 ? (idx & 7) : 4 + ((idx - 256) & 3);
          float o[8];
#pragma unroll
          for (int i = 0; i < 8; ++i) o[i] = Tf[row * LDT + 8 * ch + i];
          u32x4 w; w.x = pk2(o[0], o[1]); w.y = pk2(o[2], o[3]); w.z = pk2(o[4], o[5]); w.w = pk2(o[6], o[7]);
          *(LAS u32x4*)(Tb + row * LDB + 8 * ch) = w;
        }
      }
    }
    __syncthreads();
    if (wave < 4) {
      const int ti = wave >> 1, tj = wave & 1, lm = lane & 15, lk = lane >> 4;
      f32x4 o = (f32x4){0.f, 0.f, 0.f, 0.f};
#pragma unroll
      for (int ks = 0; ks < 8; ++ks) o = __builtin_amdgcn_mfma_f32_16x16x4f32(Tf[(32 + 16 * ti + lm) * LDT + 32 + 4 * ks + lk], Zf[(32 + 4 * ks + lk) * LDT + 16 * tj + lm], o, 0, 0, 0);
#pragma unroll
      for (int r = 0; r < 4; ++r) Tb[(32 + 16 * ti + 4 * lk + r) * LDB + 16 * tj + lm] = (bf16_t)f2bf(o[r]);
    }
    __syncthreads();
    }
    bf16x8 s0f[4][2];
    if (MODE == 1 && wave < 4) {
#pragma unroll
      for (int jt = 0; jt < 4; ++jt)
#pragma unroll
        for (int s = 0; s < 2; ++s) s0f[jt][s] = *(const bf16x8*)(Ng + (16 * jt + fr) * 64 + 32 * s + 8 * fq);
    }
    {
      const int it = wave >> 1, jt0 = (wave & 1) * 2;
#pragma unroll
      for (int jj = 0; jj < 2; ++jj) {
        const int jt = jt0 + jj, i = 16 * it + fr, j0 = 16 * jt + 4 * fq;
        f32x4 z = (f32x4){0.f, 0.f, 0.f, 0.f};
        const f32x4 wt = mma_sw<64, true, false>(AT + 16 * it * LDB, LDB, it, Tb + 16 * jt * LDB, LDB, jt, lane, z);
        const f32x4 x1 = mma_sw<64, true, false>(VT + 16 * it * LDB, LDB, it, Aak + 16 * jt * LDB, LDB, jt, lane, z);
        *(LAS u32x2*)(WT + i * LDB + j0) = pack4(wt);
        *(LAS u32x2*)(X1T + i * LDB + j0) = pack4(x1);
      }
    }
    __syncthreads();
    {
      const int it = wave >> 1, jt0 = (wave & 1) * 2;
#pragma unroll
      for (int jj = 0; jj < 2; ++jj) {
        const int jt = jt0 + jj, i = 16 * it + fr, j0 = 16 * jt + 4 * fq;
        const f32x4 ut = mma_nt<64>(X1T + 16 * it * LDB, LDB, Tb + 16 * jt * LDB, LDB, lane, (f32x4){0.f, 0.f, 0.f, 0.f});
        *(LAS u32x2*)(UT + i * LDB + j0) = pack4(ut);
      }
    }
    __syncthreads();
    if (MODE == 0) {
      const int it = wave >> 1, jt0 = (wave & 1) * 2;
      u32x2 recp[4][2];
#pragma unroll
      for (int a_ = 0; a_ < 4; ++a_) { recp[a_][0] = (u32x2){0u, 0u}; recp[a_][1] = (u32x2){0u, 0u}; }
#pragma unroll
      for (int jj = 0; jj < 2; ++jj) {
        const int jt = jt0 + jj, i = 16 * it + fr, j0 = 16 * jt + 4 * fq;
        f32x4 z = (f32x4){0.f, 0.f, 0.f, 0.f};
        f32x4 mt = mma_sw<64, true, false>(BCT + 16 * it * LDB, LDB, it, WT + 16 * jt * LDB, LDB, jt, lane, z);
#pragma unroll
        for (int u = 0; u < 4; ++u) if (j0 + u == i) mt[u] += __expf(cumC[i]);
        recp[0][jj] = pack4(mt);
        f32x4 nn = mma_sw<64, false, true>(UT + 16 * it * LDB, LDB, it, BCT + 16 * jt * LDB, LDB, jt, lane, z);
        nn = mma_sw<64, true, true>(VT + 16 * it * LDB, LDB, it, KCT + 16 * jt * LDB, LDB, jt, lane, nn);
        recp[1][jj] = pack4(nn);
        if (sto) {
          f32x4 qh = mma_nt<64>(Arb + 16 * it * LDB, LDB, WT + 16 * jt * LDB, LDB, lane, z);
          const u32x2 rv = *(const LAS u32x2*)(R_row + i * LDB + j0);
          qh[0] += bflo(rv.x); qh[1] += bfhi(rv.x); qh[2] += bflo(rv.y); qh[3] += bfhi(rv.y);
          recp[2][jj] = pack4(qh);
          f32x4 yh = mma_nt<64>(Arb + 16 * it * LDB, LDB, UT + 16 * jt * LDB, LDB, lane, z);
          yh = mma_sw<64, false, true>(Ark + 16 * it * LDB, LDB, it, VT + 16 * jt * LDB, LDB, jt, lane, yh);
          recp[3][jj] = pack4(yh);
        }
      }
      {
        const int ro = (16 * it + fr) * 64 + 32 * (jt0 >> 1) + 8 * fq;
        GAS bf16_t* Qg = rw_qrec(p, l, seq, h, chunk);
        u32x4 w;
        w.x = recp[0][0].x; w.y = recp[0][0].y; w.z = recp[0][1].x; w.w = recp[0][1].y; *(GAS u32x4*)(MTg + ro) = w;
        w.x = recp[1][0].x; w.y = recp[1][0].y; w.z = recp[1][1].x; w.w = recp[1][1].y; *(GAS u32x4*)(Ng + ro) = w;
        if (sto) {
          w.x = recp[2][0].x; w.y = recp[2][0].y; w.z = recp[2][1].x; w.w = recp[2][1].y; *(GAS u32x4*)(Qg + ro) = w;
          w.x = recp[3][0].x; w.y = recp[3][0].y; w.z = recp[3][1].x; w.w = recp[3][1].y; *(GAS u32x4*)(Qg + 4096 + ro) = w;
        }
      }
      const bool lastc = samp ? true : (chunk == 64);
      if (h == 0 && lastc) {
        const int lastrow = samp ? (R_SAMP + 16 * sb + 15) : (SEQ * seq + SEQ - 1);
        GAS float* sh = p.out + (samp ? O_SSHIFT : O_PSHIFT) + ((size_t)l * (samp ? SBN : NB) + (samp ? sb : seq)) * ACOLS;
        for (int e = tid; e < ACOLS; e += 512) sh[e] = bf2f(P[(size_t)lastrow * PLD + e]);
      }
    } else {
      {
        const int it = wave >> 1, jt0 = (wave & 1) * 2;
#pragma unroll
        for (int jj = 0; jj < 2; ++jj) {
          const int jt = jt0 + jj, i = 16 * it + fr, j0 = 16 * jt + 4 * fq;
          f32x4 qh = mma_nt<64>(Arb + 16 * it * LDB, LDB, WT + 16 * jt * LDB, LDB, lane, (f32x4){0.f, 0.f, 0.f, 0.f});
          const u32x2 rv = *(const LAS u32x2*)(R_row + i * LDB + j0);
          qh[0] += bflo(rv.x); qh[1] += bfhi(rv.x); qh[2] += bflo(rv.y); qh[3] += bfhi(rv.y);
          *(LAS u32x2*)(R_row + i * LDB + j0) = pack4(qh);
        }
      }
      __syncthreads();
      LAS float* OUTf = F0;
      if (wave < 4) {
        const int it = wave, i = 16 * it + fr;
        f32x4 y[4];
        float s1 = 0.f, s2 = 0.f;
#pragma unroll
        for (int jt = 0; jt < 4; ++jt) {
          f32x4 a = (f32x4){0.f, 0.f, 0.f, 0.f};
#pragma unroll
          for (int s = 0; s < 2; ++s) a = __builtin_amdgcn_mfma_f32_16x16x32_bf16(s0f[jt][s], ldfrag(R_row + (16 * it + fr) * LDB + 32 * s + 8 * fq), a, 0, 0, 0);
          a = mma_nt<64>(Arb + 16 * it * LDB, LDB, UT + 16 * jt * LDB, LDB, lane, a);
          a = mma_sw<64, false, true>(Ark + 16 * it * LDB, LDB, it, VT + 16 * jt * LDB, LDB, jt, lane, a);
          y[jt] = a;
          s1 += a[0] + a[1] + a[2] + a[3];
        }
        s1 += __shfl_xor(s1, 16); s1 += __shfl_xor(s1, 32);
        const float mean = s1 * (1.f / 64.f);
#pragma unroll
        for (int jt = 0; jt < 4; ++jt) { y[jt] = y[jt] - mean; s2 += y[jt][0] * y[jt][0] + y[jt][1] * y[jt][1] + y[jt][2] * y[jt][2] + y[jt][3] * y[jt][3]; }
        s2 += __shfl_xor(s2, 16); s2 += __shfl_xor(s2, 32);
        const float rs = rsqrtf(s2 * (1.f / 64.f) + GN_EPS);
#pragma unroll
        for (int jt = 0; jt < 4; ++jt) *(LAS f32x4*)(OUTf + i * LDF + 16 * jt + 4 * fq) = y[jt] * rs;
      }
      __syncthreads();
      if (t < ntok) {
        const f32x4 y0 = *(const LAS f32x4*)(OUTf + t * LDF + c0), y1 = *(const LAS f32x4*)(OUTf + t * LDF + c0 + 4);
        const u32x4 gw = *(const LAS u32x4*)(Gb + t * LDB + c0);
        const float g[8] = {bflo(gw.x), bfhi(gw.x), bflo(gw.y), bfhi(gw.y), bflo(gw.z), bfhi(gw.z), bflo(gw.w), bfhi(gw.w)};
        const float bon = bonS[t];
        float o[8];
#pragma unroll
        for (int i = 0; i < 8; ++i) {
          const float yn = i < 4 ? y0[i & 3] : y1[i & 3];
          o[i] = (yn * prm[512 + c0 + i] + prm[576 + c0 + i] + bon * vv[i]) * g[i];
        }
        u32x4 w; w.x = pk2(o[0], o[1]); w.y = pk2(o[2], o[3]); w.z = pk2(o[4], o[5]); w.w = pk2(o[6], o[7]);
        *(GAS u32x4*)((GAS bf16_t*)p.out + (size_t)rw_row(seq, chunk, t) * DM + hc0) = w;
      }
    }
    __syncthreads();
  }
}

__device__ __forceinline__ void rwkv_phase_lite(const Ctx p, int l, LAS unsigned char* lds) {
  const int tid0 = opaque_tid(p.wv);
  const int h = p.bid & 7, slot = p.bid >> 3, nslot = p.nblk >> 3;
  constexpr int NK = NB * 65 + SBN;
  constexpr int LDG = 136;
  LAS bf16_t* XG = (LAS bf16_t*)(lds + L_R2) + 128 * LDB;
  LAS float* OUTl = (LAS float*)(lds + L_R3);
  LAS bf16_t* Gb = (LAS bf16_t*)(lds + L_R4);
  LAS float* prm = (LAS float*)(lds + L_PRM);
  if (tid0 < 64) prm[128 + tid0] = p.in[12][(size_t)l * ACOLS + 2 * 512 + h * 64 + tid0];
  else if (tid0 < 128) { const int c = tid0 - 64, hc = l * AW + h * 64 + c; prm[512 + c] = p.in[21][hc]; prm[576 + c] = p.in[22][hc]; }
  float muL[8];
  { const GAS float* mu = p.in[12] + (size_t)l * ACOLS + 1536 + 128 + 8 * (tid0 & 15);
#pragma unroll
    for (int i = 0; i < 8; ++i) muL[i] = mu[i]; }
  const GAS bf16_t* g2T = (const GAS bf16_t*)(p.ws + WS_LORA) + ((size_t)l * AH + h) * 16384 + 8192;
  const GAS bf16_t* P = (const GAS bf16_t*)(p.ws + WS_BIG);
  const GAS float* bonG = (const GAS float*)(p.ws + WS_BONUS);
  const int nmine = (NK - slot + nslot - 1) / nslot;
  u32x4 glc[2], glp[2], vc, vp; float bonp;
#define LITE_PREFETCH(kk, tidx) do { int seq_, chunk_, item_; rw_item_ids<0>(h, (kk), seq_, chunk_, item_); const int ntok_ = (chunk_ == 0) ? 16 : 64; const u32x4 z_ = (u32x4){0u, 0u, 0u, 0u}; \
    _Pragma("unroll") for (int u = 0; u < 2; ++u) { const int t_ = ((tidx) >> 4) + 32 * u; \
      if (t_ < ntok_) { glc[u] = *(const GAS u32x4*)(P + (size_t)rw_row(seq_, chunk_, t_) * PLD + 1536 + 128 + 8 * ((tidx) & 15)); glp[u] = *(const GAS u32x4*)(rw_prev_row(p, l, seq_, chunk_, t_) + 1536 + 128 + 8 * ((tidx) & 15)); } \
      else { glc[u] = z_; glp[u] = z_; } } \
    { const int t2_ = (tidx) >> 3, hc0_ = h * 64 + 8 * ((tidx) & 7); \
      if (t2_ < ntok_) { vc = *(const GAS u32x4*)(P + (size_t)rw_row(seq_, chunk_, t2_) * PLD + 1024 + hc0_); vp = *(const GAS u32x4*)(rw_prev_row(p, l, seq_, chunk_, t2_) + 1024 + hc0_); } else { vc = z_; vp = z_; } \
      bonp = bonG[(size_t)item_ * 64 + t2_]; } } while (0)
  glc[0] = glc[1] = glp[0] = glp[1] = vc = vp = (u32x4){0u, 0u, 0u, 0u}; bonp = 0.f;
  if (nmine > 0) LITE_PREFETCH(slot, tid0);
  bf16x8 fg2[2][4];
  { const int lane0 = tid0 & 63, wave0 = tid0 >> 6, fr0 = lane0 & 15, fq0 = lane0 >> 4, jt00 = (wave0 & 1) * 2;
#pragma unroll
    for (int jj = 0; jj < 2; ++jj)
#pragma unroll
      for (int s2 = 0; s2 < 4; ++s2) fg2[jj][s2] = *(const GAS bf16x8*)(g2T + (16 * (jt00 + jj) + fr0) * 128 + 32 * s2 + 8 * fq0);
  }
  __syncthreads();
#pragma unroll 1
  for (int jj = 0; jj < nmine; ++jj) {
    const int k = slot + jj * nslot;
    int tid = tid0; asm volatile("" : "+v"(tid));
    const int lane = tid & 63, wave = tid >> 6, fr = lane & 15, fq = lane >> 4, t = tid >> 3, c0 = 8 * (tid & 7), hc0 = h * 64 + c0;
    int seq, chunk, item; rw_item_ids<0>(h, k, seq, chunk, item);
    const int ntok = (chunk == 0) ? 16 : 64;
    const int it_ = wave >> 1, jt0_ = (wave & 1) * 2;
    const GAS bf16_t* Qg = rw_qrec(p, l, seq, h, chunk); const GAS bf16_t* Yg = Qg + 4096;
    const GAS bf16_t* S0g = (const GAS bf16_t*)(p.ws + WS_AUX) + (size_t)item * 8192 + 4096;
    bf16x8 s0l[4][2], qhl[2]; u32x2 yhl[4];
    if (wave < 4) {
#pragma unroll
      for (int jt = 0; jt < 4; ++jt)
#pragma unroll
        for (int s2 = 0; s2 < 2; ++s2) s0l[jt][s2] = *(const GAS bf16x8*)(S0g + (16 * jt + fr) * 64 + 32 * s2 + 8 * fq);
#pragma unroll
      for (int s2 = 0; s2 < 2; ++s2) qhl[s2] = *(const GAS bf16x8*)(Qg + (16 * wave + fr) * 64 + 32 * s2 + 8 * fq);
#pragma unroll
      for (int s2 = 0; s2 < 2; ++s2) { const u32x4 d = *(const GAS u32x4*)(Yg + (size_t)(16 * wave + fr) * 64 + 32 * s2 + 8 * fq); yhl[2 * s2].x = d.x; yhl[2 * s2].y = d.y; yhl[2 * s2 + 1].x = d.z; yhl[2 * s2 + 1].y = d.w; }
    }
#pragma unroll
    for (int u = 0; u < 2; ++u) {
      const int tt = (tid >> 4) + 32 * u;
      float cur[8], prv[8], o[8];
      unpack8(glc[u], cur); unpack8(glp[u], prv);
#pragma unroll
      for (int i = 0; i < 8; ++i) { const float pm = cur[i] + (prv[i] - cur[i]) * muL[i]; o[i] = (tt < ntok) ? sigmoidf_(pm) : 0.f; }
      u32x4 w; w.x = pk2(o[0], o[1]); w.y = pk2(o[2], o[3]); w.z = pk2(o[4], o[5]); w.w = pk2(o[6], o[7]);
      *(LAS u32x4*)(XG + tt * LDG + 8 * (tid & 15)) = w;
    }
    float vv2[8]; const float bon2 = bonp;
    {
      float cur[8], prv[8];
      unpack8(vc, cur); unpack8(vp, prv);
#pragma unroll
      for (int i = 0; i < 8; ++i) vv2[i] = cur[i] + (prv[i] - cur[i]) * prm[128 + c0 + i];
    }
    __syncthreads();
    if (jj + 1 < nmine) { int tidp = tid; asm volatile("" : "+v"(tidp)); LITE_PREFETCH(slot + (jj + 1) * nslot, tidp); }
#pragma unroll
    for (int j2 = 0; j2 < 2; ++j2) {
      const int jt = jt0_ + j2;
      f32x4 ag = (f32x4){0.f, 0.f, 0.f, 0.f};
#pragma unroll
      for (int s2 = 0; s2 < 4; ++s2) ag = __builtin_amdgcn_mfma_f32_16x16x32_bf16(fg2[j2][s2], ldfrag(XG + (16 * it_ + fr) * LDG + 32 * s2 + 8 * fq), ag, 0, 0, 0);
      *(LAS u32x2*)(Gb + (16 * it_ + fr) * LDB + 16 * jt + 4 * fq) = pack4(ag);
    }
    if (wave < 4) {
      const int i = 16 * wave + fr;
      f32x4 y[4];
      float s1 = 0.f, s2v = 0.f;
#pragma unroll
      for (int jt = 0; jt < 4; ++jt) {
        const u32x2 yh = yhl[jt];
        f32x4 a = (f32x4){bflo(yh.x), bfhi(yh.x), bflo(yh.y), bfhi(yh.y)};
#pragma unroll
        for (int s2 = 0; s2 < 2; ++s2) a = __builtin_amdgcn_mfma_f32_16x16x32_bf16(s0l[jt][s2], qhl[s2], a, 0, 0, 0);
        y[jt] = a;
        s1 += a[0] + a[1] + a[2] + a[3];
      }
      s1 += __shfl_xor(s1, 16); s1 += __shfl_xor(s1, 32);
      const float mean = s1 * (1.f / 64.f);
#pragma unroll
      for (int jt = 0; jt < 4; ++jt) { y[jt] = y[jt] - mean; s2v += y[jt][0] * y[jt][0] + y[jt][1] * y[jt][1] + y[jt][2] * y[jt][2] + y[jt][3] * y[jt][3]; }
      s2v += __shfl_xor(s2v, 16); s2v += __shfl_xor(s2v, 32);
      const float rs = rsqrtf(s2v * (1.f / 64.f) + GN_EPS);
#pragma unroll
      for (int jt = 0; jt < 4; ++jt) *(LAS f32x4*)(OUTl + i * LDF + 16 * jt + 4 * fq) = y[jt] * rs;
    }
    __syncthreads();
    if (t < ntok) {
      const f32x4 y0 = *(const LAS f32x4*)(OUTl + t * LDF + c0), y1 = *(const LAS f32x4*)(OUTl + t * LDF + c0 + 4);
      float g[8]; unpack8(*(const LAS u32x4*)(Gb + t * LDB + c0), g);
      float o[8];
#pragma unroll
      for (int i = 0; i < 8; ++i) { const float yn = i < 4 ? y0[i & 3] : y1[i & 3]; o[i] = (yn * prm[512 + c0 + i] + prm[576 + c0 + i] + bon2 * vv2[i]) * g[i]; }
      u32x4 w; w.x = pk2(o[0], o[1]); w.y = pk2(o[2], o[3]); w.z = pk2(o[4], o[5]); w.w = pk2(o[6], o[7]);
      *(GAS u32x4*)((GAS bf16_t*)p.out + (size_t)rw_row(seq, chunk, t) * DM + hc0) = w;
    }
    __syncthreads();
  }
#undef LITE_PREFETCH
}

__device__ __forceinline__ void rwkv_scan_chain(const Ctx p, int l, int chain, int vt, int lane, bool dry) {
  const int fr = lane & 15, fq = lane >> 4;
  const bool samp = chain >= 32;
  const int seq = samp ? NB + ((chain - 32) >> 3) : (chain >> 3), h = samp ? ((chain - 32) & 7) : (chain & 7);
  const int nstep = samp ? 1 : 65, item0 = samp ? (RW_NPROMPT + (chain - 32)) : chain * 65;
  f32x4 acc[2][4];
  if (samp) {
#pragma unroll
    for (int u = 0; u < 2; ++u) {
      const GAS float* s0 = p.in[3] + ((((size_t)l * SBN + (seq - NB)) * AH + h) * 64 + 16 * (2 * vt + u) + fr) * 64;
#pragma unroll
      for (int i = 0; i < 4; ++i) acc[u][i] = *(const GAS f32x4*)(s0 + 16 * i + 4 * fq);
    }
  } else {
#pragma unroll
    for (int u = 0; u < 2; ++u)
#pragma unroll
      for (int i = 0; i < 4; ++i) acc[u][i] = (f32x4){0.f, 0.f, 0.f, 0.f};
  }
  GAS bf16_t* base = (GAS bf16_t*)(p.ws + WS_AUX) + (size_t)item0 * 8192;
  bf16x8 am[4][2]; u32x2 nn[2][4];
#pragma unroll
  for (int i = 0; i < 4; ++i) {
#pragma unroll
    for (int s = 0; s < 2; ++s) am[i][s] = *(const GAS bf16x8*)(base + (16 * i + fr) * 64 + 32 * s + 8 * fq);
  }
#pragma unroll
  for (int u = 0; u < 2; ++u)
#pragma unroll
    for (int s = 0; s < 2; ++s) {
      const u32x4 d = *(const GAS u32x4*)(base + 4096 + (16 * (2 * vt + u) + fr) * 64 + 32 * s + 8 * fq);
      nn[u][2 * s].x = d.x; nn[u][2 * s].y = d.y; nn[u][2 * s + 1].x = d.z; nn[u][2 * s + 1].y = d.w;
    }
#pragma unroll 1
  for (int st = 0; st < nstep; ++st) {
    GAS bf16_t* cur = base + (size_t)st * 8192;
    bf16x8 bfr[2][2];
#pragma unroll
    for (int u = 0; u < 2; ++u) {
      u32x2 sp[4];
#pragma unroll
      for (int i = 0; i < 4; ++i) sp[i] = pack4(acc[u][i]);
#pragma unroll
      for (int s = 0; s < 2; ++s) { u32x4 w; w.x = sp[2 * s].x; w.y = sp[2 * s].y; w.z = sp[2 * s + 1].x; w.w = sp[2 * s + 1].y; bfr[u][s] = __builtin_bit_cast(bf16x8, w);
        if (!dry) *(GAS u32x4*)(cur + 4096 + (16 * (2 * vt + u) + fr) * 64 + 32 * s + 8 * fq) = w; }
    }
    f32x4 na[2][4];
#pragma unroll
    for (int u = 0; u < 2; ++u)
#pragma unroll
      for (int i = 0; i < 4; ++i) {
        na[u][i] = (f32x4){bflo(nn[u][i].x), bfhi(nn[u][i].x), bflo(nn[u][i].y), bfhi(nn[u][i].y)};
#pragma unroll
        for (int s = 0; s < 2; ++s) na[u][i] = __builtin_amdgcn_mfma_f32_16x16x32_bf16(am[i][s], bfr[u][s], na[u][i], 0, 0, 0);
      }
    if (st + 1 < nstep) {
      const GAS bf16_t* nx = cur + 8192;
#pragma unroll
      for (int i = 0; i < 4; ++i) {
#pragma unroll
        for (int s = 0; s < 2; ++s) am[i][s] = *(const GAS bf16x8*)(nx + (16 * i + fr) * 64 + 32 * s + 8 * fq);
      }
#pragma unroll
      for (int u = 0; u < 2; ++u)
#pragma unroll
        for (int s = 0; s < 2; ++s) {
          const u32x4 d = *(const GAS u32x4*)(nx + 4096 + (16 * (2 * vt + u) + fr) * 64 + 32 * s + 8 * fq);
          nn[u][2 * s].x = d.x; nn[u][2 * s].y = d.y; nn[u][2 * s + 1].x = d.z; nn[u][2 * s + 1].y = d.w;
        }
    }
#pragma unroll
    for (int u = 0; u < 2; ++u)
#pragma unroll
      for (int i = 0; i < 4; ++i) acc[u][i] = na[u][i];
  }
#pragma unroll
  for (int u = 0; u < 2; ++u) {
    GAS float* so = p.out + (samp ? O_SWKV : O_PWKV) + ((((size_t)l * (samp ? SBN : NB) + (samp ? seq - NB : seq)) * AH + h) * 64 + 16 * (2 * vt + u) + fr) * 64;
#pragma unroll
    for (int i = 0; i < 4; ++i) *(GAS f32x4*)(so + 16 * i + 4 * fq) = acc[u][i];
  }
}

constexpr int ML_QP = 136;
constexpr int ML_TP = 72;
constexpr int ML_HP = 132;
constexpr int M_Q = 0, M_K = M_Q + 64 * ML_QP * 2, M_KT = M_K + 64 * ML_QP * 2, M_VT = M_KT + 128 * ML_TP * 2, M_VS = M_VT + 128 * ML_TP * 2;
constexpr int M_S = M_VS + 128 * ML_TP * 2, M_H = M_S + 64 * LDB * 2, M_SC = M_H + 64 * ML_HP * 4;
constexpr int M_CW = M_SC + (64 * 6 + 256 + 512 + 128 + 16 + 128) * 4;
constexpr int M_END = M_CW + (5 * 256 + 128) * 4;
static_assert(M_END <= 163824, "mlstm LDS");
constexpr size_t AGG_BYTES = 128 * 128 * 2 + 128 * 4 + 256;
constexpr int ML_NG = 14;
__device__ __forceinline__ int ml_gstart(int g) { return g == 0 ? 0 : (g < 9 ? 4 + 5 * (g - 1) : 44 + 4 * (g - 9)); }
__device__ __forceinline__ int ml_glen(int g) { return (g >= 1 && g < 9) ? 5 : 4; }
constexpr size_t WS_AGG_OFF = (size_t)2208 * 16384;
static_assert(AGG_BYTES == 33536 && ML_NG == 14, "WS_BONUS assumes 208 aggregate records of 33536 bytes");
constexpr int ML_NP1 = NB * BH * (ML_NG - 1), ML_NP3 = NB * BH * ML_NG + SBN * BH;

__device__ __forceinline__ int ml_row(int seq, int tau) {
  if (seq < NB) return tau < 16 ? (R_META + 16 * seq + tau) : (SEQ * seq + tau - 16);
  return R_SAMP + 16 * (seq - NB) + tau;
}

struct MlPref { u32x4 xr[7]; u32x4 vq[4]; u32x4 og[2]; float gi, gf; };
__device__ __forceinline__ void ml_chunk_range(bool samp, int grp, int ci, int& tau0, int& ntok) {
  if (samp) { tau0 = 0; ntok = 16; }
  else if (grp == 0) { if (ci == 0) { tau0 = 0; ntok = 16; } else { tau0 = 16 + 64 * (ci - 1); ntok = 64; } }
  else { tau0 = 16 + 64 * (ml_gstart(grp) + ci); ntok = 64; }
}
template <int MODE>
__device__ __forceinline__ void ml_prefetch(const Ctx p, int l, int seq, int hd, int grp, int ci, int tid, MlPref& pf) {
  const bool samp = seq >= NB; const int sb = seq - NB;
  int tau0, ntok; ml_chunk_range(samp, grp, ci, tau0, ntok);
  const GAS bf16_t* P = (const GAS bf16_t*)(p.ws + WS_BIG);
  const int MB = ACOLS;
  const u32x4 z = (u32x4){0u, 0u, 0u, 0u};
  const int cgp = tid & 31, run = tid >> 5, part = cgp >> 4, cc = (cgp & 15) * 8;
  if (MODE == 1 || part == 1) {
    const int cwi = part * 512 + hd * 128 + cc, col = MB + cwi;
#pragma unroll
    for (int rr = 0; rr < 7; ++rr) {
      const int tl = 4 * run + rr - 3, tau = tau0 + tl;
      if (tl >= ntok) pf.xr[rr] = z;
      else if (tau >= 0) pf.xr[rr] = *(const u32x4*)(P + (size_t)ml_row(seq, tau) * PLD + col);
      else if (samp) pf.xr[rr] = *(const u32x4*)((const GAS bf16_t*)(p.ws + WS_CONVB) + (((size_t)l * SBN + sb) * 3 + (3 + tau)) * 1024 + cwi);
      else pf.xr[rr] = z;
    }
  }
  if (tid < 256) {
    const int eg = tid & 15, rn = tid >> 4, e0 = eg * 8;
#pragma unroll
    for (int tt = 0; tt < 4; ++tt) { const int tl = 4 * rn + tt; pf.vq[tt] = (tl < ntok) ? *(const u32x4*)(P + (size_t)ml_row(seq, tau0 + tl) * PLD + MB + 1024 + hd * 128 + e0) : z; }
  }
  if (MODE == 1) {
    const int t = tid >> 3, e0 = (tid & 7) * 16;
    if (t < ntok) { const GAS bf16_t* q = P + (size_t)ml_row(seq, tau0 + t) * PLD + MB + 1536 + hd * 128 + e0; pf.og[0] = *(const u32x4*)q; pf.og[1] = *(const u32x4*)(q + 8); }
    else { pf.og[0] = z; pf.og[1] = z; }
  }
  {
    const int t = tid & 63;
    if (t < ntok) { const size_t rb = (size_t)ml_row(seq, tau0 + t) * PLD + MB + 2048; pf.gi = bf2f(P[rb + hd]); pf.gf = bf2f(P[rb + 4 + hd]); }
    else { pf.gi = 0.f; pf.gf = 0.f; }
  }
}

__device__ __forceinline__ int ml_pos(int d) { return (d & ~31) + 8 * ((d & 15) >> 2) + 4 * ((d >> 4) & 1) + (d & 3); }
template <int MODE>
__device__ __forceinline__ void mlstm_group_item(const Ctx p, int l, int item, LAS unsigned char* lds) {
  const int tid0 = opaque_tid(p.wv);
  int seq, hd, grp;
  if (MODE == 0) { grp = item % (ML_NG - 1); const int sh = item / (ML_NG - 1); hd = sh & 3; seq = sh >> 2; }
  else if (item < NB * BH * ML_NG) { grp = item % ML_NG; const int sh = item / ML_NG; hd = sh & 3; seq = sh >> 2; }
  else { const int r = item - NB * BH * ML_NG; grp = 0; hd = r & 3; seq = NB + (r >> 2); }
  const bool samp = seq >= NB; const int sb = seq - NB;
  const GAS bf16_t* P = (const GAS bf16_t*)(p.ws + WS_BIG);
  LAS bf16_t* Qs = (LAS bf16_t*)(lds + M_Q); LAS bf16_t* Ks = (LAS bf16_t*)(lds + M_K); LAS bf16_t* KT = (LAS bf16_t*)(lds + M_KT);
  LAS bf16_t* VT = (LAS bf16_t*)(lds + M_VT); LAS bf16_t* VS = (LAS bf16_t*)(lds + M_VS); LAS bf16_t* Sb = (LAS bf16_t*)(lds + M_S);
  LAS float* Hf = (LAS float*)(lds + M_H);
  LAS float* aj = (LAS float*)(lds + M_SC); LAS float* At = aj + 64; LAS float* wo = At + 64; LAS float* wsv = wo + 64; LAS float* emt = wsv + 64; LAS float* qn = emt + 64;
  LAS float* rsum = qn + 64; LAS float* part = rsum + 256; LAS float* nvec = part + 512;
  LAS float* cwl = (LAS float*)(lds + M_CW);
  GAS unsigned char* agg = p.ws + WS_AUX + WS_AGG_OFF;
  const int MB = ACOLS;
  const float ib = p.in[25][l * BH + hd], fb = p.in[26][l * BH + hd];
  {
    const int wave0 = tid0 >> 6, lane0 = tid0 & 63, fr0 = lane0 & 15, fq0 = lane0 >> 4;
    (void)wave0; (void)fr0; (void)fq0;
    if (tid0 < 256) {
      const int cwi = (tid0 >> 7) * 512 + hd * 128 + (tid0 & 127);
      const GAS float* cw = p.in[23] + (size_t)l * 4 * 1024 + cwi;
      cwl[tid0] = cw[0]; cwl[256 + tid0] = cw[1024]; cwl[512 + tid0] = cw[2048]; cwl[768 + tid0] = cw[3072]; cwl[1024 + tid0] = p.in[24][(size_t)l * 1024 + cwi];
    }
    else if (MODE == 1 && tid0 < 384) cwl[1280 + (tid0 - 256)] = p.in[27][l * 512 + hd * 128 + (tid0 - 256)];
  }
  f32x4 C[8];
#pragma unroll
  for (int i = 0; i < 8; ++i) C[i] = (f32x4){0.f, 0.f, 0.f, 0.f};
  float m = 0.f;
  {
    const int wave = tid0 >> 6, lane = tid0 & 63, fr = lane & 15, fq = lane >> 4;
    if (MODE == 0) { m = -1e30f; if (tid0 < 128) nvec[tid0] = 0.f; }
    else if (samp) {
      const GAS float* c0 = p.in[5] + (((size_t)l * SBN + sb) * BH + hd) * 128 * 128;
#pragma unroll
      for (int i = 0; i < 8; ++i)
#pragma unroll
        for (int r = 0; r < 4; ++r) C[i][r] = c0[(size_t)(16 * i + 4 * fq + r) * 128 + 16 * wave + fr];
      if (tid0 < 128) nvec[ml_pos(tid0)] = p.in[6][(((size_t)l * SBN + sb) * BH + hd) * 128 + tid0];
      m = p.in[7][((size_t)l * SBN + sb) * BH + hd];
    } else {
      float wgt[ML_NG - 1]; float nreg = 0.f;
      {
        float fm = 0.f;
        float am[ML_NG - 1], bmv[ML_NG - 1];
#pragma unroll
        for (int g2 = 0; g2 < ML_NG - 1; ++g2) { const GAS float* sc = (const GAS float*)(agg + ((size_t)((seq * BH + hd) * (ML_NG - 1) + g2)) * AGG_BYTES + 32768 + 512); am[g2] = g2 < grp ? sc[0] : 0.f; bmv[g2] = g2 < grp ? sc[1] : -1e30f; }
#pragma unroll
        for (int g2 = 0; g2 < ML_NG - 1; ++g2) wgt[g2] = 0.f;
#pragma unroll
        for (int g2 = 0; g2 < ML_NG - 1; ++g2) {
          if (g2 < grp) {
            const float me = fmaxf(fm + am[g2], bmv[g2]), f1 = __expf(fm + am[g2] - me), f2 = __expf(bmv[g2] - me);
#pragma unroll
            for (int g3 = 0; g3 < ML_NG - 1; ++g3) if (g3 < g2) wgt[g3] *= f1;
            wgt[g2] = f2; fm = me;
          }
        }
        m = fm;
      }
#pragma unroll
      for (int g2 = 0; g2 < ML_NG - 1; ++g2) {
        if (g2 < grp) {
          const GAS unsigned char* rec = agg + ((size_t)((seq * BH + hd) * (ML_NG - 1) + g2)) * AGG_BYTES;
#pragma unroll
          for (int ip = 0; ip < 4; ++ip) {
            const u32x4 d = *(const GAS u32x4*)((const GAS bf16_t*)rec + (size_t)((wave * 4 + ip) * 64 + lane) * 8);
            C[2 * ip] += (f32x4){bflo(d.x), bfhi(d.x), bflo(d.y), bfhi(d.y)} * wgt[g2];
            C[2 * ip + 1] += (f32x4){bflo(d.z), bfhi(d.z), bflo(d.w), bfhi(d.w)} * wgt[g2];
          }
          if (tid0 < 128) nreg += ((const GAS float*)(rec + 32768))[tid0] * wgt[g2];
        }
      }
      if (tid0 < 128) nvec[ml_pos(tid0)] = nreg;
    }
  }
  float asum = 0.f;
  const int nchunk = samp ? 1 : ((grp == 0) ? 1 + ml_glen(0) : ml_glen(grp));
  MlPref pf;
  ml_prefetch<MODE>(p, l, seq, hd, grp, 0, tid0, pf);
  __syncthreads();
#pragma unroll 1
  for (int ci = 0; ci < nchunk; ++ci) {
    int tid = tid0; asm volatile("" : "+v"(tid));
    const int lane = tid & 63, wave = tid >> 6, fr = lane & 15, fq = lane >> 4;
    int tau0, ntok; ml_chunk_range(samp, grp, ci, tau0, ntok);
    float s_ws, dec, mnew;
    {
      const bool valid = lane < ntok;
      const float li = valid ? pf.gi + ib : -1e30f;
      const float lf = valid ? -softplusf_(-(pf.gf + fb)) : 0.f;
      float b = lf;
#pragma unroll
      for (int o = 1; o < 64; o <<= 1) { const float v = __shfl_up(b, o); if (lane >= o) b += v; }
      const float a = li - b;
      float A = fmaxf(a, m);
#pragma unroll
      for (int o = 1; o < 64; o <<= 1) { const float v = __shfl_up(A, o); if (lane >= o) A = fmaxf(A, v); }
      const float AL = __shfl(A, 63), bL = __shfl(b, 63);
      s_ws = __expf(a - AL);
      dec = __expf(m - AL); mnew = bL + AL; asum += bL;
      if (wave == 0) { aj[lane] = a; At[lane] = A; wo[lane] = __expf(m - A); wsv[lane] = s_ws; emt[lane] = __expf(-(b + A)); }
    }
    {
      const int cgp = tid & 31, run = tid >> 5, part2 = cgp >> 4, cc = (cgp & 15) * 8;
      if (MODE == 1 || part2 == 1) {
        unsigned wq[4][4];
#pragma unroll
        for (int i2 = 0; i2 < 4; ++i2) {
          float oc[2][4];
#pragma unroll
          for (int hlf = 0; hlf < 2; ++hlf) {
            const int i = 2 * i2 + hlf, wcol = part2 * 128 + cc + i;
            const float w0 = cwl[wcol], w1 = cwl[256 + wcol], w2 = cwl[512 + wcol], w3 = cwl[768 + wcol], bb = cwl[1024 + wcol];
            float xv[7];
#pragma unroll
            for (int rr = 0; rr < 7; ++rr) { const unsigned wd = pf.xr[rr][i2]; xv[rr] = hlf ? bfhi(wd) : bflo(wd); }
#pragma unroll
            for (int tt = 0; tt < 4; ++tt) {
              float val = w0 * xv[tt] + w1 * xv[tt + 1] + w2 * xv[tt + 2] + w3 * xv[tt + 3] + bb;
              val = siluf_(val);
              if (part2 == 1) val *= 0.08838834764831845f;
              if (4 * run + tt >= ntok) val = 0.f;
              oc[hlf][tt] = val;
            }
            if (part2 == 1) { u32x2 w; w.x = pk2(oc[hlf][0], oc[hlf][1]); w.y = pk2(oc[hlf][2], oc[hlf][3]); *(LAS u32x2*)(KT + (cc + i) * ML_TP + ((((run >> 1) ^ (cgp & 7)) << 3) | ((run & 1) << 2))) = w; }
          }
#pragma unroll
          for (int tt = 0; tt < 4; ++tt) wq[tt][i2] = pk2(oc[0][tt], oc[1][tt]);
        }
        const int s32 = cc >> 5, hh = (cc >> 4) & 1, qq = (cc & 15) >> 2;
        LAS bf16_t* dst = (part2 == 0 ? Qs : Ks);
#pragma unroll
        for (int tt = 0; tt < 4; ++tt) {
          u32x2 w0; w0.x = wq[tt][0]; w0.y = wq[tt][1];
          u32x2 w1; w1.x = wq[tt][2]; w1.y = wq[tt][3];
          *(LAS u32x2*)(dst + (4 * run + tt) * ML_QP + 32 * s32 + 8 * qq + 4 * hh) = w0;
          *(LAS u32x2*)(dst + (4 * run + tt) * ML_QP + 32 * s32 + 8 * (qq + 1) + 4 * hh) = w1;
        }
      }
      {
        const int eg = tid & 15, rn = (tid >> 4) & 15, e0 = eg * 8;
        const float w40 = __shfl(s_ws, 4 * rn), w41 = __shfl(s_ws, 4 * rn + 1), w42 = __shfl(s_ws, 4 * rn + 2), w43 = __shfl(s_ws, 4 * rn + 3);
        const int vso = (((rn >> 1) ^ (eg & 7)) << 3) | ((rn & 1) << 2);
        if (tid < 256) {
#pragma unroll
          for (int i2 = 0; i2 < 4; ++i2) {
#pragma unroll
            for (int hlf = 0; hlf < 2; ++hlf) {
              const int i = 2 * i2 + hlf;
              float v0 = hlf ? bfhi(pf.vq[0][i2]) : bflo(pf.vq[0][i2]), v1 = hlf ? bfhi(pf.vq[1][i2]) : bflo(pf.vq[1][i2]);
              float v2 = hlf ? bfhi(pf.vq[2][i2]) : bflo(pf.vq[2][i2]), v3 = hlf ? bfhi(pf.vq[3][i2]) : bflo(pf.vq[3][i2]);
              u32x2 w; w.x = pk2(v0, v1); w.y = pk2(v2, v3); *(LAS u32x2*)(VT + (e0 + i) * ML_TP + vso) = w;
              u32x2 ws2; ws2.x = pk2(v0 * w40, v1 * w41); ws2.y = pk2(v2 * w42, v3 * w43); *(LAS u32x2*)(VS + (e0 + i) * ML_TP + vso) = ws2;
            }
          }
        }
      }
    }
    const u32x4 og0 = pf.og[0], og1 = pf.og[1];
    if (ci + 1 < nchunk) { int tidp = tid0; asm volatile("" : "+v"(tidp)); ml_prefetch<MODE>(p, l, seq, hd, grp, ci + 1, tidp, pf); }
    __syncthreads();
    if (MODE == 1) {
      {
        const int it = wave >> 1, jt0 = (wave & 1) * 2;
        float rs = 0.f;
#pragma unroll
        for (int jj = 0; jj < 2; ++jj) {
          const int jt = jt0 + jj, i = 16 * it + fr, j0 = 16 * jt + 4 * fq;
          f32x4 sc = (f32x4){0.f, 0.f, 0.f, 0.f};
          if (jt <= it) {
            sc = mma_nt<128>(Qs + 16 * it * ML_QP, ML_QP, Ks + 16 * jt * ML_QP, ML_QP, lane, sc);
            const f32x4 a4 = *(const LAS f32x4*)(aj + j0); const float Ai = At[i];
#pragma unroll
            for (int u = 0; u < 4; ++u) { sc[u] = (j0 + u <= i) ? sc[u] * __expf(a4[u] - Ai) : 0.f; rs += sc[u]; }
          }
          *(LAS u32x2*)(Sb + i * LDB + j0) = pack4(sc);
        }
        rs += __shfl_xor(rs, 16); rs += __shfl_xor(rs, 32);
        if (fq == 0) rsum[(16 * it + fr) * 4 + (wave & 1)] = rs;
      }
      {
        const int t = tid >> 3, d0 = (tid & 7) * 16;
        float s = 0.f;
#pragma unroll
        for (int u = 0; u < 2; ++u) {
          float qv[8]; unpack8(*(const LAS u32x4*)(Qs + t * ML_QP + d0 + 8 * u), qv);
          { const f32x4 n0 = *(const LAS f32x4*)(nvec + d0 + 8 * u), n1 = *(const LAS f32x4*)(nvec + d0 + 8 * u + 4);
            s += qv[0] * n0[0] + qv[1] * n0[1] + qv[2] * n0[2] + qv[3] * n0[3] + qv[4] * n1[0] + qv[5] * n1[1] + qv[6] * n1[2] + qv[7] * n1[3]; }
        }
        s += __shfl_xor(s, 1); s += __shfl_xor(s, 2); s += __shfl_xor(s, 4);
        if ((tid & 7) == 0) qn[t] = s;
      }
      __syncthreads();
      {
        bf16x8 cf[4];
#pragma unroll
        for (int s = 0; s < 4; ++s) { const u32x2 lo = pack4(C[2 * s]), hi = pack4(C[2 * s + 1]); u32x4 w; w.x = lo.x; w.y = lo.y; w.z = hi.x; w.w = hi.y; cf[s] = __builtin_bit_cast(bf16x8, w); }
        float p2[4][4];
#pragma unroll
        for (int it = 0; it < 4; ++it) {
          f32x4 acc = (f32x4){0.f, 0.f, 0.f, 0.f};
#pragma unroll
          for (int s = 0; s < 4; ++s) acc = __builtin_amdgcn_mfma_f32_16x16x32_bf16(ldfrag(Qs + (16 * it + fr) * ML_QP + 32 * s + 8 * fq), cf[s], acc, 0, 0, 0);
          const f32x4 w4 = *(const LAS f32x4*)(wo + 16 * it + 4 * fq);
          acc = acc * w4;
#pragma unroll
          for (int s = 0; s < 2; ++s) acc = __builtin_amdgcn_mfma_f32_16x16x32_bf16(ldfrag(Sb + (16 * it + fr) * LDB + 32 * s + 8 * fq), ldfrag(VT + (16 * wave + fr) * ML_TP + 8 * ((4 * s + fq) ^ ((2 * wave + (fr >> 3)) & 7))), acc, 0, 0, 0);
#pragma unroll
          for (int r = 0; r < 4; ++r) {
            const int t = 16 * it + 4 * fq + r;
            const float den = wo[t] * qn[t] + rsum[t * 4] + rsum[t * 4 + 1];
            const float hv = acc[r] * __builtin_amdgcn_rcpf(fmaxf(fabsf(den), emt[t]));
            Hf[t * ML_HP + 16 * wave + fr] = hv;
            float sq = hv * hv;
            sq += __shfl_xor(sq, 1); sq += __shfl_xor(sq, 2); sq += __shfl_xor(sq, 4); sq += __shfl_xor(sq, 8);
            p2[it][r] = sq;
          }
        }
        if (fr == 0) {
#pragma unroll
          for (int it = 0; it < 4; ++it)
#pragma unroll
            for (int r = 0; r < 4; ++r) part[(16 * it + 4 * fq + r) * 8 + wave] = p2[it][r];
        }
      }
    }
    {
#pragma unroll
      for (int i = 0; i < 8; ++i) {
        f32x4 acc = C[i] * dec;
#pragma unroll
        for (int s = 0; s < 2; ++s) acc = __builtin_amdgcn_mfma_f32_16x16x32_bf16(ldfrag(KT + (16 * i + fr) * ML_TP + 8 * ((4 * s + fq) ^ ((2 * i + (fr >> 3)) & 7))), ldfrag(VS + (16 * wave + fr) * ML_TP + 8 * ((4 * s + fq) ^ ((2 * wave + (fr >> 3)) & 7))), acc, 0, 0, 0);
        C[i] = acc;
      }
    }
    {
      f32x4 acc = (f32x4){0.f, 0.f, 0.f, 0.f};
#pragma unroll
      for (int s2 = 0; s2 < 2; ++s2) {
        bf16x8 wb;
        { const f32x4 a0 = *(const LAS f32x4*)(wsv + 32 * s2 + 8 * fq), a1 = *(const LAS f32x4*)(wsv + 32 * s2 + 8 * fq + 4);
          u32x4 w; w.x = pk2(a0[0], a0[1]); w.y = pk2(a0[2], a0[3]); w.z = pk2(a1[0], a1[1]); w.w = pk2(a1[2], a1[3]);
          if (fr != 0) w = (u32x4){0u, 0u, 0u, 0u};
          wb = __builtin_bit_cast(bf16x8, w); }
        acc = __builtin_amdgcn_mfma_f32_16x16x32_bf16(ldfrag(KT + (16 * wave + fr) * ML_TP + 8 * ((4 * s2 + fq) ^ ((2 * wave + (fr >> 3)) & 7))), wb, acc, 0, 0, 0);
      }
      if (fr == 0) {
        LAS float* np = nvec + 32 * (wave >> 1) + 8 * fq + 4 * (wave & 1);
        const f32x4 old = *(const LAS f32x4*)np;
        *(LAS f32x4*)np = old * dec + acc;
      }
    }
    __syncthreads();
    if (MODE == 1) {
      const int t = tid >> 3, e0 = (tid & 7) * 16;
      if (t < ntok) {
        float ps = 0.f;
#pragma unroll
        for (int w = 0; w < 8; ++w) ps += part[t * 8 + w];
        const float rs = rsqrtf(ps * (1.f / 128.f) + RMS_EPS);
        const size_t row = (size_t)ml_row(seq, tau0 + t);
        float og[16]; unpack8(og0, og); unpack8(og1, og + 8);
        float o[16];
#pragma unroll
        for (int i = 0; i < 16; ++i) o[i] = Hf[t * ML_HP + e0 + i] * rs * cwl[1280 + e0 + i] * sigmoidf_(og[i]);
        u32x4 w; w.x = pk2(o[0], o[1]); w.y = pk2(o[2], o[3]); w.z = pk2(o[4], o[5]); w.w = pk2(o[6], o[7]);
        GAS bf16_t* mx = (GAS bf16_t*)p.out + row * DM + 512 + hd * 128 + e0;
        *(u32x4*)mx = w;
        w.x = pk2(o[8], o[9]); w.y = pk2(o[10], o[11]); w.z = pk2(o[12], o[13]); w.w = pk2(o[14], o[15]);
        *(u32x4*)(mx + 8) = w;
      }
    }
    m = mnew;
  }
  {
    const int tid = tid0, lane = tid & 63, wave = tid >> 6, fr = lane & 15, fq = lane >> 4;
    if (MODE == 0) {
      GAS unsigned char* rec = agg + ((size_t)((seq * BH + hd) * (ML_NG - 1) + grp)) * AGG_BYTES;
#pragma unroll
      for (int ip = 0; ip < 4; ++ip) { const u32x2 a = pack4(C[2 * ip]), b = pack4(C[2 * ip + 1]); u32x4 w; w.x = a.x; w.y = a.y; w.z = b.x; w.w = b.y; *(GAS u32x4*)((GAS bf16_t*)rec + (size_t)((wave * 4 + ip) * 64 + lane) * 8) = w; }
      if (tid < 128) ((GAS float*)(rec + 32768))[tid] = nvec[ml_pos(tid)];
      if (tid == 0) { ((GAS float*)(rec + 32768 + 512))[0] = asum; ((GAS float*)(rec + 32768 + 512))[1] = m; }
    } else if (samp || grp == ML_NG - 1) {
      const int nb_ = samp ? SBN : NB, bi = samp ? sb : seq;
      GAS float* co = p.out + (samp ? O_SC : O_PC) + (((size_t)l * nb_ + bi) * BH + hd) * 128 * 128;
#pragma unroll
      for (int i = 0; i < 8; ++i)
#pragma unroll
        for (int r = 0; r < 4; ++r) co[(size_t)(16 * i + 4 * fq + r) * 128 + 16 * wave + fr] = C[i][r];
      if (tid < 128) p.out[(samp ? O_SN : O_PN) + (((size_t)l * nb_ + bi) * BH + hd) * 128 + tid] = nvec[ml_pos(tid)];
      if (tid == 0) p.out[(samp ? O_SM : O_PM) + ((size_t)l * nb_ + bi) * BH + hd] = m;
      if (tid < 256) {
        const int cwi = (tid >> 7) * 512 + hd * 128 + (tid & 127);
        GAS float* cvo = p.out + (samp ? O_SCONV : O_PCONV) + ((size_t)l * nb_ + bi) * 3 * 1024;
        const int last = samp ? 15 : (TP - 1);
#pragma unroll
        for (int j = 0; j < 3; ++j) cvo[j * 1024 + cwi] = bf2f(P[(size_t)ml_row(seq, last - 2 + j) * PLD + MB + cwi]);
      }
    }
  }
  __syncthreads();
}


__device__ __forceinline__ void gates_pass(const Ctx p, int l, unsigned* flag, unsigned need) {
  const int tid = opaque_tid(p.wv), lane = tid & 63, wave = tid >> 6, fr = lane & 15, fq = lane >> 4;
  const int blk = p.bid * 8 + wave;
  if (blk >= R_TOT / 16) return;
  if (blk >= R_SAMP / 16 && need) {
    unsigned sp = 0;
    while ((unsigned)__builtin_amdgcn_readfirstlane(__hip_atomic_load(flag, __ATOMIC_RELAXED, __HIP_MEMORY_SCOPE_AGENT)) < need) { __builtin_amdgcn_s_sleep(2); if (++sp > (1u << 22)) break; }
    __builtin_amdgcn_fence(__ATOMIC_ACQUIRE, "agent");
  }
  const GAS bf16_t* X = (const GAS bf16_t*)(p.ws + WS_XB0) + (size_t)(16 * blk + fr) * DM + 8 * fq;
  const GAS bf16_t* W = (const GAS bf16_t*)(p.ws + WS_WIN) + ((size_t)l * NINP + 3840 + fr) * DM + 8 * fq;
  f32x4 acc = (f32x4){0.f, 0.f, 0.f, 0.f};
#pragma unroll 8
  for (int s = 0; s < DM / 32; ++s) acc = __builtin_amdgcn_mfma_f32_16x16x32_bf16(*(const GAS bf16x8*)(W + 32 * s), *(const GAS bf16x8*)(X + 32 * s), acc, 0, 0, 0);
  if (fq < 2) {
    const int row = 16 * blk + fr;
    const float rs = row_rstd((const GAS float*)(p.ws + WS_SS) + (size_t)(2 * l) * MPAD * 4, row);
    *(GAS u32x2*)((GAS bf16_t*)(p.ws + WS_BIG) + (size_t)row * PLD + 3840 + 4 * fq) = pack4(acc * rs);
  }
}


constexpr int XF_FLAG0 = 3520;
template <bool FINAL>
__device__ __forceinline__ void convert_special(const Ctx p, const GAS float* slab, int nsl, const GAS bf16_t* Xin, GAS bf16_t* Xout, GAS float* ssd, unsigned* flag, const GAS float* nf) {
  const int tid = opaque_tid(p.wv), lane = tid & 63, wave = tid >> 6;
  const int w16 = p.bid - (p.nblk - 16);
#pragma unroll 1
  for (int q = 0; q < 4; ++q) {
    const int r2 = 32 * w16 + 4 * wave + q, row = R_SAMP + r2, tm = r2 >> 8, rin = r2 & 255;
    f32x4 v[4]; float s = 0.f;
#pragma unroll
    for (int j = 0; j < 4; ++j) {
      const u32x2 xi = *(const GAS u32x2*)(Xin + (size_t)row * DM + 256 * j + 4 * lane);
      f32x4 a = (f32x4){bflo(xi.x), bfhi(xi.x), bflo(xi.y), bfhi(xi.y)};
      for (int sl = 0; sl < nsl; ++sl) a += *(const GAS f32x4*)(slab + ((size_t)((tm * 4 + j) * nsl + sl) * 256 + rin) * 256 + 4 * lane);
      v[j] = a; s += a[0] * a[0] + a[1] * a[1] + a[2] * a[2] + a[3] * a[3];
    }
    s = wave_sum(s);
    if (FINAL) {
      const float rs = rsqrtf(s * (1.f / DM) + RMS_EPS);
      if (row < R_META) {
        GAS float* y = p.out + (size_t)row * DM;
#pragma unroll
        for (int j = 0; j < 4; ++j) { const f32x4 g = *(const GAS f32x4*)(nf + 256 * j + 4 * lane); *(GAS f32x4*)(y + 256 * j + 4 * lane) = v[j] * rs * g; }
      }
    } else {
#pragma unroll
      for (int j = 0; j < 4; ++j) {
        u32x2 w; w.x = pk2(v[j][0], v[j][1]); w.y = pk2(v[j][2], v[j][3]);
        *(GAS u32x2*)(Xout + (size_t)row * DM + 256 * j + 4 * lane) = w;
      }
      if (lane == 0) *(GAS f32x4*)(ssd + (size_t)row * 4) = (f32x4){s, 0.f, 0.f, 0.f};
    }
  }
  if (!FINAL) {
    asm volatile("s_waitcnt vmcnt(0)" ::: "memory");
    __syncthreads();
    if (tid == 0) {
      __builtin_amdgcn_fence(__ATOMIC_RELEASE, "agent");
      asm volatile("s_waitcnt vmcnt(0)" ::: "memory");
      __hip_atomic_fetch_add(flag, 1u, __ATOMIC_RELAXED, __HIP_MEMORY_SCOPE_AGENT);
    }
  }
}

__device__ __forceinline__ int prev_row(int r, int d) {
  if (r < R_MAIN) { const int t = r & (SEQ - 1), b = r >> 12; return t >= d ? r - d : (R_META + 16 * b + 16 + (t - d)); }
  if (r < R_META) { const int t = (r - R_SAMP) & 15; return t >= d ? r - d : (-2 - (2 + (t - d))); }
  { const int t = (r - R_META) & 15; return t >= d ? r - d : -1; }
}
__device__ __forceinline__ void ffn_conv8(const float* u0, const float* u1, const float* u2, const float* gt, const GAS float* cw, const GAS float* cb, int ff, GAS bf16_t* dst) {
  float o[8];
#pragma unroll
  for (int i = 0; i < 8; ++i) { const float val = cw[ff + i] * u2[i] + cw[DFF + ff + i] * u1[i] + cw[2 * DFF + ff + i] * u0[i] + cb[ff + i]; o[i] = siluf_(val) * gt[i]; }
  u32x4 w; w.x = pk2(o[0], o[1]); w.y = pk2(o[2], o[3]); w.z = pk2(o[4], o[5]); w.w = pk2(o[6], o[7]);
  *(GAS u32x4*)dst = w;
}
__device__ __forceinline__ void phase_ffn_fixup(const Ctx p, int l) {
  GAS bf16_t* G = (GAS bf16_t*)(p.ws + WS_BIG);
  const GAS bf16_t* UH = G + pg8::FS_UH; const GAS bf16_t* UD = G + pg8::FS_UD; const GAS bf16_t* GD = G + pg8::FS_GD; const GAS bf16_t* US = G + pg8::FS_US; const GAS bf16_t* GS = G + pg8::FS_GS;
  const GAS float* cw = p.in[31] + (size_t)l * 3 * DFF; const GAS float* cb = p.in[32] + (size_t)l * DFF;
  constexpr int NA = 256 * 2 * 352, NBS = 320 * 352, NC = (NB + SBN) * 2 * 352;
  for (int idx = p.bid * 512 + opaque_tid(p.wv); idx < NA + NBS + NC; idx += p.nblk * 512) {
    float u0[8], u1[8], u2[8], gt[8];
    if (idx < NA) {
      const int s = idx / 704, rem = idx - s * 704, j = rem / 352, c0 = (rem - j * 352) * 8;
      load8(UD + ((size_t)s * 2 + j) * DFF + c0, u0); load8(GD + ((size_t)s * 2 + j) * DFF + c0, gt);
      const GAS bf16_t* h1; const GAS bf16_t* h2;
      if ((s & 63) == 0) { const int b = s >> 6; h1 = US + (size_t)(256 + 16 * b + 15) * DFF; h2 = US + (size_t)(256 + 16 * b + 14) * DFF; }
      else { h1 = UH + ((size_t)(s - 1) * 2 + 1) * DFF; h2 = UH + ((size_t)(s - 1) * 2) * DFF; }
      if (j == 0) { load8(h1 + c0, u1); load8(h2 + c0, u2); }
      else { load8(UD + ((size_t)s * 2) * DFF + c0, u1); load8(h1 + c0, u2); }
      ffn_conv8(u0, u1, u2, gt, cw, cb, c0, G + (size_t)(64 * s + j) * DFF + c0);
    } else if (idx < NA + NBS) {
      const int k = idx - NA, r2 = k / 352, c0 = (k - r2 * 352) * 8, t = r2 & 15;
      const bool samp = r2 < 256;
      load8(US + (size_t)r2 * DFF + c0, u0); load8(GS + (size_t)r2 * DFF + c0, gt);
#pragma unroll
      for (int d = 1; d <= 2; ++d) {
        float* dstv = d == 1 ? u1 : u2;
        if (t >= d) load8(US + (size_t)(r2 - d) * DFF + c0, dstv);
        else if (samp) { const GAS float* st = p.in[8] + (((size_t)l * SBN + (r2 >> 4)) * 2 + (2 + (t - d))) * DFF + c0;
#pragma unroll
          for (int i = 0; i < 8; ++i) dstv[i] = st[i]; }
        else {
#pragma unroll
          for (int i = 0; i < 8; ++i) dstv[i] = 0.f; }
      }
      ffn_conv8(u0, u1, u2, gt, cw, cb, c0, G + (size_t)(R_SAMP + r2) * DFF + c0);
    } else {
      const int k = idx - NA - NBS, q = k / 352, c0 = (k - q * 352) * 8, sq = q >> 1, j = q & 1;
      const bool samp = sq >= NB;
      const GAS bf16_t* src = samp ? (US + (size_t)(16 * (sq - NB) + 14 + j) * DFF) : (UH + ((size_t)(64 * sq + 63) * 2 + j) * DFF);
      load8(src + c0, u0);
      GAS float* dst = p.out + (samp ? O_SF : O_PF) + (((size_t)l * (samp ? SBN : NB) + (samp ? sq - NB : sq)) * 2 + j) * DFF + c0;
#pragma unroll
      for (int i = 0; i < 8; ++i) dst[i] = u0[i];
    }
  }
}

__device__ __forceinline__ void phase_final(const Ctx p) {
  const int tid = opaque_tid(p.wv), lane = tid & 63, wave = tid >> 6;
  const int gw = p.bid * 8 + wave, NGW = p.nblk * 8;
  const GAS float* nf = p.in[34];
  const GAS bf16_t* X = (const GAS bf16_t*)(p.ws + WS_XB0);
  for (int r = gw; r < R_MAIN; r += NGW) {
    f32x4 v[4]; float s = 0.f;
#pragma unroll
    for (int j = 0; j < 4; ++j) { const u32x2 xi = *(const GAS u32x2*)(X + (size_t)r * DM + 256 * j + 4 * lane); v[j] = (f32x4){bflo(xi.x), bfhi(xi.x), bflo(xi.y), bfhi(xi.y)}; s += v[j][0] * v[j][0] + v[j][1] * v[j][1] + v[j][2] * v[j][2] + v[j][3] * v[j][3]; }
    s = wave_sum(s);
    const float rs = rsqrtf(s * (1.f / DM) + RMS_EPS);
    GAS float* y = p.out + (size_t)r * DM;
#pragma unroll
    for (int j = 0; j < 4; ++j) { const f32x4 g = *(const GAS f32x4*)(nf + 256 * j + 4 * lane); *(GAS f32x4*)(y + 256 * j + 4 * lane) = v[j] * rs * g; }
  }
}

constexpr int kThreads = 512;
constexpr size_t kDynLds = 163840;

__global__ void __launch_bounds__(512, 2) fwd_megakernel(Params p) {
  extern __shared__ __attribute__((aligned(16))) unsigned char shm[];
  LAS unsigned char* lds = (LAS unsigned char*)shm;
  cg::grid_group grid = cg::this_grid();
#define GSYNC() do { xcd_barrier((unsigned*)cx0.ws, xb_st, opaque_tid(cx0.wv) == 0); if (PROBE_SYNC) xcd_barrier((unsigned*)cx0.ws, xb_st, opaque_tid(cx0.wv) == 0); } while (0)
#define PHASE_CTX() const Ctx cx = opaque_ctx(cx0); const int G = cx.nblk, c = cx.bid; (void)G; (void)c; GAS unsigned char* ws = cx.ws; GAS float* ss = (GAS float*)(ws + WS_SS); GAS float* xmeta = (GAS float*)(ws + WS_XMETA); \
    GAS bf16_t* Xb0 = (GAS bf16_t*)(ws + WS_XB0); GAS bf16_t* Xb1 = (GAS bf16_t*)(ws + WS_XB1); GAS bf16_t* BIG = (GAS bf16_t*)(ws + WS_BIG); (void)ss; (void)xmeta; (void)Xb0; (void)Xb1; (void)BIG;

  volatile LAS unsigned* xb_st = (volatile LAS unsigned*)(lds + 163824);
  if (threadIdx.x == 0) { xb_st[0] = 0u; xb_st[1] = 0u; (void)xb_add(&((unsigned*)p.ws)[XB_XCNT(xb_xcc_id())], 1u); }
#ifndef NO_PRO
  for (int rep = 0; rep < 1 + PROBE_PRO; ++rep) { phase_prologue(p, lds); __syncthreads(); }
#endif
  if (threadIdx.x < 35) ((const float**)(p.ws + WS_TAB))[threadIdx.x] = p.in[threadIdx.x];
  grid.sync();
  Ctx cx0; cx0.out = (GAS float*)p.out; cx0.ws = (GAS unsigned char*)p.ws; cx0.in = (const gcf_t GAS*)(p.ws + WS_TAB); cx0.wv = __builtin_amdgcn_readfirstlane(threadIdx.x >> 6); cx0.bid = blockIdx.x; cx0.nblk = gridDim.x; cx0.pad_ = 0;
#pragma unroll 1
  for (int l0 = 0; l0 < DEPTH; ++l0) {
    {
      PHASE_CTX(); int l = l0; asm volatile("" : "+s"(l));
      unsigned* flag = (unsigned*)ws + XF_FLAG0 + 64 * (2 * l);
      const unsigned need = l > 0 ? 16u : 0u;
      if (l > 0 && c >= G - 16) convert_special<false>(cx, (const GAS float*)(ws + WS_SLAB_OUT), 4, Xb1, Xb0, ss + (size_t)(2 * l) * MPAD * 4, flag, nullptr);
      pg8::Gemm g{(const bf16_t*)Xb0, (const bf16_t*)(ws + WS_WIN) + (size_t)l * NINP * DM, MPAD, 3840, DM, DM};
      pg8::WaitOrder S; S.init(MPAD, 3840, DM, G, c); S.flag = flag; S.need = need; S.wv = cx.wv;
      pg8::EpiScaleBf16 E{BIG, PLD, PLD, ss + (size_t)(2 * l) * MPAD * 4};
      for (int rep = 0; rep < 1 + PROBE_GEMM; ++rep)
      pg8::gemm_phase<pg8::EpiScaleBf16, pg8::WaitOrder>(lds, g, S, E, cx.wv);
      gates_pass(cx, l, flag, need);
    }
    GSYNC();
    {
      PHASE_CTX(); int l = l0; asm volatile("" : "+s"(l));
      if (c < ML_NP1) { for (int rep = 0; rep < 1 + PROBE_P1; ++rep) mlstm_group_item<0>(cx, l, c, lds); }
      rwkv_phase<0>(cx, l, lds, 1 + PROBE_MIXA);
    }
    GSYNC();
    {
      PHASE_CTX(); int l = l0; asm volatile("" : "+s"(l));
      const int tid = opaque_tid(cx.wv), wave = tid >> 6, lane = tid & 63;
      for (int rep = PROBE_SCAN; rep >= 0; --rep) {
        const int chain = c < 32 ? c : 32 + (c - 32) * 2 + (wave >> 2);
        if ((wave & 3) < 2 && (c < 32 ? wave < 2 : c < 96)) rwkv_scan_chain(cx, l, chain, wave & 1, lane, rep > 0);
      }
      if (c >= 32) {
        for (int rep = 0; rep < 1 + PROBE_P3; ++rep) {
          const int it = c - 32;
          const int grp = it % ML_NG, k = (it / ML_NG) * 4 + (grp - 9);
          const int n2 = (it < NB * BH * ML_NG) ? ((grp >= 9 && grp <= 12 && k < SBN * BH) ? 2 : 1) : 0;
          for (int q = 0; q < n2; ++q) mlstm_group_item<1>(cx, l, q == 0 ? it : NB * BH * ML_NG + k, lds);
        }
      }
    }
    GSYNC();
    {
      PHASE_CTX(); int l = l0; asm volatile("" : "+s"(l));
      for (int rep = 0; rep < 1 + PROBE_MIXC; ++rep) rwkv_phase_lite(cx, l, lds);
    }
    GSYNC();
    {
      PHASE_CTX(); int l = l0; asm volatile("" : "+s"(l));
      pg8::Gemm g{(const bf16_t*)cx.out, (const bf16_t*)(ws + WS_WOUT) + (size_t)l * DM * DM, MPAD, DM, DM, DM};
      pg8::TailOrder S; S.init(R_MAIN, DM, DM, G, c); S.nsl = 4;
      pg8::EpiRes E{Xb0, Xb1, ss + (size_t)(2 * l + 1) * MPAD * 4, 1, (GAS float*)(ws + WS_SLAB_OUT), 4, (LAS float*)(lds + 131072)};
      pg8::gemm_phase<pg8::EpiRes, pg8::TailOrder>(lds, g, S, E, cx.wv);
      if (PROBE_OUT) { pg8::EpiRes E2 = E; E2.write_ss = -1; pg8::gemm_phase<pg8::EpiRes, pg8::TailOrder>(lds, g, S, E2, cx.wv); }
    }
    GSYNC();
    {
      PHASE_CTX(); int l = l0; asm volatile("" : "+s"(l));
      unsigned* flag = (unsigned*)ws + XF_FLAG0 + 64 * (2 * l + 1);
      if (c >= G - 16) convert_special<false>(cx, (const GAS float*)(ws + WS_SLAB_OUT), 4, Xb0, Xb1, ss + (size_t)(2 * l + 1) * MPAD * 4, flag, nullptr);
      {
        constexpr int NUP = (MPAD / 256) * (2 * DFF / 256);
        const int lo = NUP % G;
        if (lo && c >= lo) {
          const int tidq = opaque_tid(cx.wv), waveq = tidq >> 6, laneq = tidq & 63, wq = (c - lo) * 8 + waveq, nwq = (G - lo) * 8;
          LAS float* scr = (LAS float*)(lds + waveq * 16384);
          convert_weights(cx.in[11], cx.in[10], cx.in[28], cx.in[30], cx.in[29], cx.in[33], ws, l, WI_IN + WI_OUT + WI_UP, WI_L, wq, nwq, scr, laneq);
          if (l + 1 < DEPTH) convert_weights(cx.in[11], cx.in[10], cx.in[28], cx.in[30], cx.in[29], cx.in[33], ws, l + 1, 0, WI_IN, wq, nwq, scr, laneq);
          __syncthreads();
        } else if (!lo) {
          const int tidq = opaque_tid(cx.wv), waveq = tidq >> 6, laneq = tidq & 63, wq = c * 8 + waveq, nwq = G * 8;
          LAS float* scr = (LAS float*)(lds + waveq * 16384);
          convert_weights(cx.in[11], cx.in[10], cx.in[28], cx.in[30], cx.in[29], cx.in[33], ws, l, WI_IN + WI_OUT + WI_UP, WI_L, wq, nwq, scr, laneq);
          if (l + 1 < DEPTH) convert_weights(cx.in[11], cx.in[10], cx.in[28], cx.in[30], cx.in[29], cx.in[33], ws, l + 1, 0, WI_IN, wq, nwq, scr, laneq);
          __syncthreads();
        }
      }
      pg8::Gemm g{(const bf16_t*)Xb1, (const bf16_t*)(ws + WS_WUP) + (size_t)l * 2 * DFF * DM, MPAD, 2 * DFF, DM, DM};
      pg8::WaitOrder S; S.init(MPAD, 2 * DFF, DM, G, c); S.flag = flag; S.need = 16u; S.wv = cx.wv;
      pg8::EpiUpConv E{BIG, ss + (size_t)(2 * l + 1) * MPAD * 4, cx.in[31] + (size_t)l * 3 * DFF, cx.in[32] + (size_t)l * DFF};
      for (int rep = 0; rep < 1 + PROBE_GEMM; ++rep)
      pg8::gemm_phase<pg8::EpiUpConv, pg8::WaitOrder>(lds, g, S, E, cx.wv);
    }
    GSYNC();
    { PHASE_CTX(); int l = l0; asm volatile("" : "+s"(l)); for (int rep = 0; rep < 1 + PROBE_FIX; ++rep) phase_ffn_fixup(cx, l); }
    GSYNC();
    {
      PHASE_CTX(); int l = l0; asm volatile("" : "+s"(l));
      pg8::Gemm g{(const bf16_t*)BIG, (const bf16_t*)(ws + WS_WDN) + (size_t)l * DM * DFF, MPAD, DM, DFF, DFF};
      pg8::TailOrder S; S.init(R_MAIN, DM, DFF, G, c); S.nsl = 4;
      const int wx = (l + 1 < DEPTH) ? 1 : 0;
      pg8::EpiRes E{Xb1, Xb0, ss + (size_t)(2 * l + 2) * MPAD * 4, wx, (GAS float*)(ws + WS_SLAB_OUT), 4, (LAS float*)(lds + 131072)};
      pg8::gemm_phase<pg8::EpiRes, pg8::TailOrder>(lds, g, S, E, cx.wv);
      if (PROBE_DOWN) { pg8::EpiRes E2 = E; E2.write_ss = -1; pg8::gemm_phase<pg8::EpiRes, pg8::TailOrder>(lds, g, S, E2, cx.wv); }
      if (l + 1 < DEPTH && c >= 32) {
        const int tidq = opaque_tid(cx.wv), waveq = tidq >> 6, laneq = tidq & 63, wq = (c - 32) * 8 + waveq, nwq = (G - 32) * 8;
        LAS float* scr = (LAS float*)(lds + waveq * 16384);
        convert_weights(cx.in[11], cx.in[10], cx.in[28], cx.in[30], cx.in[29], cx.in[33], ws, l + 1, WI_IN, WI_IN + WI_OUT + WI_UP, wq, nwq, scr, laneq);
      }
    }
    GSYNC();
  }
  {
    PHASE_CTX();
    if (c >= G - 16) convert_special<true>(cx, (const GAS float*)(ws + WS_SLAB_OUT), 4, Xb1, nullptr, nullptr, nullptr, cx.in[34]);
  }
  { PHASE_CTX(); phase_final(cx); }
}

extern "C" void kernel_launch(void* const* d_in, const int* in_sizes, int n_in, void* d_out, int out_size, void* d_ws,
                              size_t ws_size, hipStream_t stream) {
  static int grid_blocks = 0;
  if (!grid_blocks) {
    int dev = 0, cus = 0, per_cu = 0;
    (void)hipGetDevice(&dev);
    (void)hipDeviceGetAttribute(&cus, hipDeviceAttributeMultiprocessorCount, dev);
    (void)hipFuncSetAttribute((const void*)fwd_megakernel, hipFuncAttributeMaxDynamicSharedMemorySize, (int)kDynLds);
    (void)hipOccupancyMaxActiveBlocksPerMultiprocessor(&per_cu, fwd_megakernel, kThreads, kDynLds);
    grid_blocks = cus > 0 ? cus : 256;
    if (n_in != 35 || out_size != (int)O_END || ws_size < WS_END) fprintf(stderr, "kernel_launch: unexpected shapes n_in=%d out=%d ws=%zu\n", n_in, out_size, ws_size);
  }
  (void)hipMemsetAsync(d_ws, 0, 16384, stream);
  Params p{};
  for (int i = 0; i < 35; ++i) p.in[i] = (const float*)d_in[i];
  p.out = (float*)d_out;
  p.ws = (unsigned char*)d_ws;
  p.ph_lo = 0; p.ph_hi = 0;
  void* args[] = {&p};
  hipError_t e = hipLaunchCooperativeKernel((void*)fwd_megakernel, dim3(grid_blocks), dim3(kThreads), args, kDynLds, stream);
  if (e != hipSuccess) fprintf(stderr, "cooperative launch failed: %s (grid %d)\n", hipGetErrorString(e), grid_blocks);
}
```

```cpp
#define PROBE_SYNC 0
#define PROBE_MIXA 0
#define PROBE_MIXC 0
#define PROBE_GEMM 0
#define PROBE_ML 0
#define PROBE_PRO 0
#define PROBE_OUT 0
#define PROBE_DOWN 0
#define PROBE_FIX 0
#define PROBE_P1 0
#define PROBE_P3 0
#define PROBE_SCAN 0
#include <hip/hip_runtime.h>
#include <hip/hip_cooperative_groups.h>
#include <cstdio>
#include <cstdint>
namespace cg = cooperative_groups;

#define LAS __attribute__((address_space(3)))
#define GAS __attribute__((address_space(1)))
typedef unsigned short bf16_t;
typedef short bf16x8 __attribute__((ext_vector_type(8)));
typedef float f32x4 __attribute__((ext_vector_type(4)));
typedef unsigned u32x4 __attribute__((ext_vector_type(4)));
typedef unsigned u32x2 __attribute__((ext_vector_type(2)));

constexpr int DM = 1024, NB = 4, SEQ = 4096, NMETA = 16, TP = 4112, DEPTH = 2, SBN = 16, STN = 16;
constexpr int AH = 8, AD = 64, AW = 512, ACOLS = 1792, BH = 4, BD = 128, BCOLS = 2056, DIN = 3848, DFF = 2816, HFF = 1408;
constexpr int R_MAIN = 16384, R_SAMP = 16384, R_META = 16640, R_TOT = 16704, MPAD = 16896;
constexpr int PLD = 3856;
constexpr int NINP = 4096;
constexpr float RMS_EPS = 1e-6f, GN_EPS = 64e-5f;

constexpr size_t O_YP = 0, O_YS = O_YP + (size_t)NB * SEQ * DM, O_PSHIFT = O_YS + (size_t)SBN * STN * DM;
constexpr size_t O_PWKV = O_PSHIFT + (size_t)DEPTH * NB * ACOLS, O_PCONV = O_PWKV + (size_t)DEPTH * NB * AH * AD * AD;
constexpr size_t O_PC = O_PCONV + (size_t)DEPTH * NB * 3 * 1024, O_PN = O_PC + (size_t)DEPTH * NB * BH * BD * BD;
constexpr size_t O_PM = O_PN + (size_t)DEPTH * NB * BH * BD, O_PF = O_PM + (size_t)DEPTH * NB * BH;
constexpr size_t O_SSHIFT = O_PF + (size_t)DEPTH * NB * 2 * DFF;
constexpr size_t O_SWKV = O_SSHIFT + (size_t)DEPTH * SBN * ACOLS, O_SCONV = O_SWKV + (size_t)DEPTH * SBN * AH * AD * AD;
constexpr size_t O_SC = O_SCONV + (size_t)DEPTH * SBN * 3 * 1024, O_SN = O_SC + (size_t)DEPTH * SBN * BH * BD * BD;
constexpr size_t O_SM = O_SN + (size_t)DEPTH * SBN * BH * BD, O_SF = O_SM + (size_t)DEPTH * SBN * BH;
constexpr size_t O_END = O_SF + (size_t)DEPTH * SBN * 2 * DFF;
static_assert(O_END == 21412000, "output size");

constexpr size_t WS_TAB = 32768;
constexpr size_t WS_SS = 65536;
constexpr size_t WS_XMETA = WS_SS + 4 * (size_t)MPAD * 16 + 256;
constexpr size_t WS_LORA = (WS_XMETA + 255) / 256 * 256;
constexpr size_t WS_ZROW = WS_LORA + (size_t)DEPTH * AH * 16384 * 2;
constexpr size_t WS_SHIFTB = WS_ZROW + 8192;
constexpr size_t WS_CONVB = (WS_SHIFTB + (size_t)DEPTH * SBN * ACOLS * 2 + 255) / 256 * 256;
constexpr size_t WS_WIN = (WS_CONVB + (size_t)DEPTH * SBN * 3 * 1024 * 2 + 255) / 256 * 256;
constexpr size_t WS_WOUT = WS_WIN + 2 * (size_t)NINP * DM * 2;
constexpr size_t WS_WUP = WS_WOUT + 2 * (size_t)DM * DM * 2;
constexpr size_t WS_WDN = WS_WUP + 2 * (size_t)2 * DFF * DM * 2;
constexpr size_t WS_XB0 = WS_WDN + 2 * (size_t)2 * DM * HFF * 2;
constexpr size_t WS_BIG = WS_XB0 + (size_t)MPAD * DM * 2;
constexpr size_t WS_AUX = WS_BIG + (size_t)MPAD * PLD * 2;
constexpr size_t WS_XB1 = WS_AUX;
constexpr size_t WS_END = WS_AUX + (size_t)2208 * 16384 + (size_t)8 * 1024 * 1024;
static_assert(WS_END <= 268435456, "workspace");
constexpr size_t WS_SLAB_OUT = WS_AUX + (size_t)MPAD * DM * 2;
static_assert(WS_SLAB_OUT + (size_t)8 * 4 * 65536 * 4 <= 268435456, "slab_out");
constexpr size_t WS_BONUS = WS_AUX + (((size_t)2208 * 16384 + (size_t)208 * 33536 + 255) / 256) * 256;
static_assert(WS_BONUS + (size_t)2208 * 64 * 4 <= WS_END, "bonus scalars fit in AUX");

struct Params {
  const float* in[35];
  float* out;
  unsigned char* ws;
  int ph_lo, ph_hi;
};

typedef const GAS float* gcf_t;
struct Ctx { GAS float* out; GAS unsigned char* ws; const gcf_t GAS* in; int wv; int bid; int nblk; int pad_; };

__device__ __forceinline__ int opaque_tid(int wv) { unsigned z = 0u; asm volatile("" : "+v"(z)); int t = (wv << 6) | (int)__builtin_amdgcn_mbcnt_hi(~0u, __builtin_amdgcn_mbcnt_lo(~0u, z)); asm volatile("" : "+v"(t)); return t; }
__device__ __forceinline__ Ctx opaque_ctx(Ctx c) { asm volatile("" : "+s"(c.out), "+s"(c.ws), "+s"(c.in), "+s"(c.wv), "+s"(c.bid), "+s"(c.nblk)); return c; }

typedef float f32x2_t __attribute__((ext_vector_type(2)));
typedef __bf16 bf16x2_t __attribute__((ext_vector_type(2)));
__device__ __forceinline__ unsigned pk2(float lo, float hi) { const f32x2_t v = {lo, hi}; const bf16x2_t b = __builtin_convertvector(v, bf16x2_t); return __builtin_bit_cast(unsigned, b); }
__device__ __forceinline__ unsigned f2bf(float f) { return pk2(f, 0.f) & 0xffffu; }
__device__ __forceinline__ float bf2f(unsigned b) { return __builtin_bit_cast(float, b << 16); }
__device__ __forceinline__ float bflo(unsigned w) { return __builtin_bit_cast(float, w << 16); }
__device__ __forceinline__ float bfhi(unsigned w) { return __builtin_bit_cast(float, w & 0xffff0000u); }
__device__ __forceinline__ float wave_sum(float v) {
#pragma unroll
  for (int o = 1; o < 64; o <<= 1) v += __shfl_xor(v, o);
  return v;
}
__device__ __forceinline__ float sigmoidf_(float x) { return __builtin_amdgcn_rcpf(1.f + __expf(-x)); }
__device__ __forceinline__ float siluf_(float x) { return x * __builtin_amdgcn_rcpf(1.f + __expf(-x)); }
__device__ __forceinline__ float softplusf_(float x) { return fmaxf(x, 0.f) + __logf(1.f + __expf(-fabsf(x))); }
__device__ __forceinline__ void load8(const GAS bf16_t* p, float* o) {
  const u32x4 w = *(const GAS u32x4*)p;
  o[0] = bflo(w.x); o[1] = bfhi(w.x); o[2] = bflo(w.y); o[3] = bfhi(w.y); o[4] = bflo(w.z); o[5] = bfhi(w.z); o[6] = bflo(w.w); o[7] = bfhi(w.w);
}
__device__ __forceinline__ float row_rstd(const GAS float* ss4, int row) { const f32x4 p = *(const GAS f32x4*)(ss4 + (size_t)row * 4); return rsqrtf((((p[0] + p[1]) + p[2]) + p[3]) * (1.f / DM) + RMS_EPS); }
__device__ __forceinline__ GAS float* xrow_ptr(GAS float* out, GAS float* xmeta, int r) { return r < R_META ? out + (size_t)r * DM : xmeta + (size_t)(r - R_META) * DM; }

namespace pg8 {
constexpr int BM = 256, BK = 64, HALF = 128, HTB = HALF * BK * 2, STAGE_BYTES = 8 * HTB, NXCD = 8, WGM = 8;
__host__ __device__ __forceinline__ int lds_byte(int r, int c) { const int st = (r >> 4) * 2 + (c >> 5), rr = r & 15, cc = c & 31, ob = rr * 64 + cc * 2; return st * 1024 + (ob ^ (((ob >> 9) & 1) << 5)); }
__host__ __device__ __forceinline__ void stage_rc(int b, int& R, int& C) { const int st = b / 1024, sb = b % 1024, swz = sb ^ (((sb >> 9) & 1) << 5); R = (st >> 1) * 16 + swz / 64; C = (st & 1) * 32 + (swz % 64) / 2; }
__host__ __device__ __forceinline__ int perm32(int rho) { const int n = rho >> 4, i = rho & 15; return 8 * (i >> 2) + 4 * n + (i & 3); }
struct Unit { int pm, pn, kofs, nt, slice; };
struct Gemm { const bf16_t* A; const bf16_t* Bt; int M, N, K, lda; };
struct StaticOrder {
  int nM, nN, nwg, G, c, ntf;
  __device__ void init(int M, int N, int K, int G_, int c_) { nM = M / BM; nN = N / BM; nwg = nM * nN; G = G_; c = c_; ntf = K / BK; }
  __device__ bool next(int i, Unit& u) const {
    const long L = (long)i * G + c; if (L >= nwg) return false;
    int wgid = (int)L; { const int q = nwg / NXCD, r = nwg % NXCD, xcd = wgid % NXCD, off = wgid / NXCD; wgid = (xcd < r ? xcd * (q + 1) : r * (q + 1) + (xcd - r) * q) + off; }
    const int nig = WGM * nN, gid = wgid / nig, fm = gid * WGM, gsz = (nM - fm) < WGM ? (nM - fm) : WGM;
    u.pm = fm + ((wgid % nig) % gsz); u.pn = (wgid % nig) / gsz; u.kofs = 0; u.nt = ntf; u.slice = 0; return true;
  }
  __device__ __forceinline__ void a_ready(const Unit&) const {}
};
struct WaitOrder : StaticOrder {
  unsigned* flag; unsigned need; int wv;
  __device__ __forceinline__ void a_ready(const Unit& u) const {
    if (u.pm < 64) return;
    if (wv == 0) {
      unsigned sp = 0;
      while ((unsigned)__builtin_amdgcn_readfirstlane(__hip_atomic_load(flag, __ATOMIC_RELAXED, __HIP_MEMORY_SCOPE_AGENT)) < need) { __builtin_amdgcn_s_sleep(2); if (++sp > (1u << 22)) break; }
      __builtin_amdgcn_fence(__ATOMIC_ACQUIRE, "agent");
      asm volatile("s_waitcnt vmcnt(0)" ::: "memory");
    }
    asm volatile("" ::: "memory"); __builtin_amdgcn_s_barrier(); asm volatile("" ::: "memory");
  }
};
struct TailOrder : StaticOrder {
  int nsl;
  __device__ bool next(int i, Unit& u) const {
    if (i == 0) return StaticOrder::next(0, u);
    if (i == 1 && c < 8 * nsl) {
      const int tile = c & 7, sl = c >> 3;
      const int st = (ntf == 16) ? 4 * sl : (sl < 2 ? 12 * sl : 24 + 10 * (sl - 2)), n = (ntf == 16) ? 4 : (sl < 2 ? 12 : 10);
      u.pm = 64 + (tile >> 2); u.pn = tile & 3; u.kofs = st * BK * 2; u.nt = n; u.slice = 1 + sl; return true;
    }
    return false;
  }
};
__device__ __forceinline__ unsigned cvt_pk_bf16(float lo, float hi) { unsigned r; asm volatile("v_cvt_pk_bf16_f32 %0, %1, %2" : "=v"(r) : "v"(lo), "v"(hi)); return r; }

template <class Epi, class Sched, bool ALIGN_EPI = true>
__device__ __forceinline__ void gemm_phase(LAS unsigned char* lds, const Gemm g, const Sched& S, const Epi& E, int wv) {
  const int tid = opaque_tid(wv), wid = __builtin_amdgcn_readfirstlane(tid >> 6), lane = tid & 63, wr = wid >> 2, wc = wid & 3, fr = lane & 15, fq = lane >> 4;
  const int K = g.K, lda = g.lda;
  unsigned voffA[2], voffB[2];
#pragma unroll
  for (int i = 0; i < 2; ++i) { int R, C; stage_rc(tid * 16 + i * 8192, R, C); const int Rb = Epi::PERM ? ((R & ~31) + perm32(R & 31)) : R;
    voffA[i] = (unsigned)(R * lda + C) * 2u; voffB[i] = (unsigned)(Rb * K + C) * 2u; }
  const size_t kstep = (size_t)(BK * 2);
  const size_t hstepA = (size_t)HALF * lda * 2, hstepB = (size_t)HALF * K * 2;
  const size_t tstepA = 2 * hstepA, tstepB = 2 * hstepB;
  const unsigned ldsw = (unsigned)wid * 1024u;
  const int aoff = lds_byte(wr * 64 + fr, fq * 8), boff = lds_byte(wc * 32 + fr, fq * 8);
#define PG8_SA(b, h) (((b) * 2 + (h)) * HTB)
#define PG8_SB(b, h) ((4 + (b) * 2 + (h)) * HTB)
#define PG8_STAGE(bufoff, gbase, voff) do { _Pragma("unroll") for (int _i = 0; _i < 2; ++_i) \
    __builtin_amdgcn_global_load_lds((const unsigned*)((const char*)(gbase) + (voff)[_i]), (LAS unsigned*)(lds + (bufoff) + ldsw + _i * 8192), 16, 0, 0); } while (0)
#define PG8_LDA(dst, b, h) do { _Pragma("unroll") for (int m = 0; m < 4; ++m) _Pragma("unroll") for (int k = 0; k < 2; ++k) dst[m][k] = *(const LAS bf16x8*)(lds + PG8_SA(b, h) + aoff + m * 2048 + k * 1024); } while (0)
#define PG8_LDB(dst, b, h) do { _Pragma("unroll") for (int n = 0; n < 2; ++n) _Pragma("unroll") for (int k = 0; k < 2; ++k) dst[n][k] = *(const LAS bf16x8*)(lds + PG8_SB(b, h) + boff + n * 2048 + k * 1024); } while (0)
#define PG8_MMA(ai, bj, At, Bt) do { __builtin_amdgcn_s_setprio(1); _Pragma("unroll") for (int m = 0; m < 4; ++m) _Pragma("unroll") for (int n = 0; n < 2; ++n) _Pragma("unroll") for (int k = 0; k < 2; ++k) \
    acc[ai][bj][m][n] = __builtin_amdgcn_mfma_f32_16x16x32_bf16(Bt[n][k], At[m][k], acc[ai][bj][m][n], 0, 0, 0); __builtin_amdgcn_s_setprio(0); } while (0)
#define PG8_WAIT_V(n) asm volatile("s_waitcnt vmcnt(" #n ")" ::: "memory")
#define PG8_WAIT_L(n) asm volatile("s_waitcnt lgkmcnt(" #n ")" ::: "memory")
#define PG8_BAR __builtin_amdgcn_s_barrier()
#define PG8_SCHED __builtin_amdgcn_sched_barrier(0)
  Unit cur, nxt; int ui = 0;
  if (!S.next(0, cur)) return;
  f32x4 acc[2][2][4][2];
#pragma unroll
  for (int a = 0; a < 2; ++a)
#pragma unroll
    for (int b = 0; b < 2; ++b)
#pragma unroll
      for (int m = 0; m < 4; ++m)
#pragma unroll
        for (int n = 0; n < 2; ++n) acc[a][b][m][n] = (f32x4){0.f, 0.f, 0.f, 0.f};
  bf16x8 At[4][2], B0[2][2], B1[2][2];
  const char* cA = (const char*)g.A + (size_t)cur.pm * tstepA + cur.kofs; const char* cB = (const char*)g.Bt + (size_t)cur.pn * tstepB + cur.kofs;
  S.a_ready(cur);
  PG8_STAGE(PG8_SB(0, 0), cB, voffB); PG8_STAGE(PG8_SB(0, 1), cB + hstepB, voffB); PG8_STAGE(PG8_SA(0, 0), cA, voffA); PG8_STAGE(PG8_SA(0, 1), cA + hstepA, voffA);
  if (wr == 1) PG8_BAR;
  PG8_WAIT_V(2); PG8_BAR;
  PG8_STAGE(PG8_SB(1, 0), cB + kstep, voffB); PG8_STAGE(PG8_SA(1, 0), cA + kstep, voffA); PG8_STAGE(PG8_SB(1, 1), cB + hstepB + kstep, voffB);
  PG8_WAIT_V(6); PG8_BAR;
  for (;;) {
    const bool has_next = S.next(ui + 1, nxt);
    const char* nA = has_next ? (const char*)g.A + (size_t)nxt.pm * tstepA + nxt.kofs : cA; const char* nB = has_next ? (const char*)g.Bt + (size_t)nxt.pn * tstepB + nxt.kofs : cB;
    const int nt = cur.nt;
    for (int t = 0; t < nt; t += 2) {
      const bool last = (t == nt - 2);
      if (last && has_next) S.a_ready(nxt);
      const char* a1 = cA + (size_t)(t + 1) * kstep;
      const char* a2 = last ? nA : cA + (size_t)(t + 2) * kstep; const char* b2 = last ? nB : cB + (size_t)(t + 2) * kstep;
      const char* a3 = a2 + kstep; const char* b3 = b2 + kstep;
      PG8_LDB(B0, 0, 0); PG8_LDB(B1, 0, 1); PG8_SCHED; PG8_LDA(At, 0, 0); PG8_STAGE(PG8_SA(1, 1), a1 + hstepA, voffA);
      PG8_WAIT_V(8); PG8_WAIT_L(0); PG8_BAR; PG8_MMA(0, 0, At, B0); PG8_MMA(0, 1, At, B1); PG8_BAR; PG8_SCHED;
      PG8_LDA(At, 0, 1); PG8_STAGE(PG8_SB(0, 0), b2, voffB); PG8_STAGE(PG8_SB(0, 1), b2 + hstepB, voffB); PG8_STAGE(PG8_SA(0, 0), a2, voffA);
      PG8_WAIT_V(8); PG8_WAIT_L(0); PG8_BAR; PG8_MMA(1, 0, At, B0); PG8_MMA(1, 1, At, B1); PG8_BAR; PG8_SCHED;
      PG8_LDB(B0, 1, 0); PG8_LDB(B1, 1, 1); PG8_SCHED; PG8_LDA(At, 1, 0); PG8_STAGE(PG8_SA(0, 1), a2 + hstepA, voffA);
      PG8_WAIT_V(8); PG8_WAIT_L(0); PG8_BAR; PG8_MMA(0, 0, At, B0); PG8_MMA(0, 1, At, B1); PG8_BAR; PG8_SCHED;
      PG8_LDA(At, 1, 1); PG8_STAGE(PG8_SB(1, 0), b3, voffB); PG8_STAGE(PG8_SB(1, 1), b3 + hstepB, voffB); PG8_STAGE(PG8_SA(1, 0), a3, voffA);
      PG8_WAIT_V(8); PG8_WAIT_L(0); PG8_BAR; PG8_MMA(1, 0, At, B0); PG8_MMA(1, 1, At, B1); PG8_BAR; PG8_SCHED;
    }
    if constexpr (ALIGN_EPI) { if (wr == 0) PG8_BAR; }
    E(acc, cur, wr, wc, fr, fq);
    if (!has_next) break;
#pragma unroll
    for (int a = 0; a < 2; ++a)
#pragma unroll
      for (int b = 0; b < 2; ++b)
#pragma unroll
        for (int m = 0; m < 4; ++m)
#pragma unroll
          for (int n = 0; n < 2; ++n) acc[a][b][m][n] = (f32x4){0.f, 0.f, 0.f, 0.f};
    cur = nxt; cA = nA; cB = nB; ++ui;
    if constexpr (ALIGN_EPI) { if (wr == 1) PG8_BAR; }
  }
  PG8_WAIT_V(0);
  if constexpr (!ALIGN_EPI) { if (wr == 0) PG8_BAR; }
  PG8_BAR;
#undef PG8_SA
#undef PG8_SB
#undef PG8_STAGE
#undef PG8_LDA
#undef PG8_LDB
#undef PG8_MMA
#undef PG8_WAIT_V
#undef PG8_WAIT_L
#undef PG8_BAR
#undef PG8_SCHED
}

struct EpiScaleBf16 {
  static constexpr bool PERM = true;
  GAS bf16_t* O; int ldo; int ncols; const GAS float* ss;
  __device__ __forceinline__ void operator()(const f32x4 (&acc)[2][2][4][2], const Unit& u, int wr, int wc, int fr, int fq) const {
    const int row0 = u.pm * BM + wr * 64 + fr, col0 = u.pn * BM + wc * 32 + 8 * fq;
#pragma unroll
    for (int ai = 0; ai < 2; ++ai)
#pragma unroll
      for (int m = 0; m < 4; ++m) {
        const int row = row0 + ai * HALF + m * 16;
        const float rs = row_rstd(ss, row);
        GAS bf16_t* rowp = O + (size_t)row * ldo + col0;
#pragma unroll
        for (int bj = 0; bj < 2; ++bj) {
          if (col0 + bj * HALF < ncols) {
            const f32x4 v0 = acc[ai][bj][m][0] * rs, v1 = acc[ai][bj][m][1] * rs;
            u32x4 w; w.x = cvt_pk_bf16(v0[0], v0[1]); w.y = cvt_pk_bf16(v0[2], v0[3]); w.z = cvt_pk_bf16(v1[0], v1[1]); w.w = cvt_pk_bf16(v1[2], v1[3]);
            *(GAS u32x4*)(rowp + bj * HALF) = w;
          }
        }
      }
  }
};
struct EpiRes {
  static constexpr bool PERM = true;
  const GAS bf16_t* Xin; GAS bf16_t* Xout; GAS float* ssn; int write_ss; GAS float* slab; int nsl; LAS float* red;
  __device__ __forceinline__ void operator()(const f32x4 (&acc)[2][2][4][2], const Unit& u, int wr, int wc, int fr, int fq) const {
    if (write_ss < 0) return;
    if (u.slice) {
      GAS float* sb = slab + ((size_t)(((u.pm - 64) * 4 + u.pn) * nsl + (u.slice - 1)) * 256 + wr * 64 + fr) * 256 + wc * 32 + 8 * fq;
#pragma unroll
      for (int ai = 0; ai < 2; ++ai)
#pragma unroll
        for (int m = 0; m < 4; ++m)
#pragma unroll
          for (int bj = 0; bj < 2; ++bj)
#pragma unroll
            for (int n = 0; n < 2; ++n) *(GAS f32x4*)(sb + (size_t)(ai * HALF + m * 16) * 256 + bj * HALF + n * 4) = acc[ai][bj][m][n];
      return;
    }
    const int row0 = u.pm * BM + wr * 64 + fr, col0 = u.pn * BM + wc * 32 + 8 * fq;
#pragma unroll
    for (int ai = 0; ai < 2; ++ai)
#pragma unroll
      for (int m = 0; m < 4; ++m) {
        const int row = row0 + ai * HALF + m * 16;
        const size_t ro = (size_t)row * DM + col0;
        float sq = 0.f;
#pragma unroll
        for (int bj = 0; bj < 2; ++bj) {
          const u32x4 xi = *(const GAS u32x4*)(Xin + ro + bj * HALF);
          const f32x4 x0 = (f32x4){__builtin_bit_cast(float, xi.x << 16), __builtin_bit_cast(float, xi.x & 0xffff0000u), __builtin_bit_cast(float, xi.y << 16), __builtin_bit_cast(float, xi.y & 0xffff0000u)} + acc[ai][bj][m][0];
          const f32x4 x1 = (f32x4){__builtin_bit_cast(float, xi.z << 16), __builtin_bit_cast(float, xi.z & 0xffff0000u), __builtin_bit_cast(float, xi.w << 16), __builtin_bit_cast(float, xi.w & 0xffff0000u)} + acc[ai][bj][m][1];
          u32x4 w; w.x = cvt_pk_bf16(x0[0], x0[1]); w.y = cvt_pk_bf16(x0[2], x0[3]); w.z = cvt_pk_bf16(x1[0], x1[1]); w.w = cvt_pk_bf16(x1[2], x1[3]);
          *(GAS u32x4*)(Xout + ro + bj * HALF) = w;
          sq += x0[0] * x0[0] + x0[1] * x0[1] + x0[2] * x0[2] + x0[3] * x0[3] + x1[0] * x1[0] + x1[1] * x1[1] + x1[2] * x1[2] + x1[3] * x1[3];
        }
        if (write_ss) {
          sq += __shfl_xor(sq, 16); sq += __shfl_xor(sq, 32);
          if (fq == 0) red[(ai * HALF + wr * 64 + m * 16 + fr) * 4 + wc] = sq;
        }
      }
    if (write_ss) {
      asm volatile("s_waitcnt lgkmcnt(0)" ::: "memory"); __builtin_amdgcn_s_barrier(); asm volatile("" ::: "memory");
      const int t2 = wr * 256 + wc * 64 + fq * 16 + fr;
      if (t2 < 256) { const f32x4 q = *(const LAS f32x4*)(red + t2 * 4); ssn[(size_t)(u.pm * BM + t2) * 4 + u.pn] = ((q[0] + q[1]) + q[2]) + q[3]; }
    }
  }
};
constexpr size_t FS_G = (size_t)MPAD * DFF;
constexpr size_t FS_UH = FS_G, FS_UD = FS_UH + (size_t)256 * 2 * DFF, FS_GD = FS_UD + (size_t)256 * 2 * DFF, FS_US = FS_GD + (size_t)256 * 2 * DFF, FS_GS = FS_US + (size_t)512 * DFF;
static_assert((FS_GS + (size_t)512 * DFF) * 2 <= (size_t)MPAD * PLD * 2, "FFN side buffers fit in BIG");
__device__ __forceinline__ float dpp_prev(float prv, float cur, int sh) {
  const int pr = __builtin_bit_cast(int, prv), cu = __builtin_bit_cast(int, cur);
  int r;
  if (sh == 1) { const int o = __builtin_amdgcn_update_dpp(0, pr, 0x121, 0xf, 0xf, false); r = __builtin_amdgcn_update_dpp(o, cu, 0x111, 0xf, 0xf, false); }
  else { const int o = __builtin_amdgcn_update_dpp(0, pr, 0x122, 0xf, 0xf, false); r = __builtin_amdgcn_update_dpp(o, cu, 0x112, 0xf, 0xf, false); }
  return __builtin_bit_cast(float, r);
}
struct EpiUpConv {
  static constexpr bool PERM = true;
  GAS bf16_t* G; const GAS float* ss; const GAS float* cw; const GAS float* cb;
  __device__ __forceinline__ void operator()(const f32x4 (&acc)[2][2][4][2], const Unit& u, int wr, int wc, int fr, int fq) const {
    const int row0 = u.pm * BM + wr * 64 + fr, ff0 = u.pn * 128 + wc * 32 + 8 * fq;
    const bool spec = u.pm >= 64;
    f32x4 w0[2], w1[2], w2[2], bb[2];
#pragma unroll
    for (int n = 0; n < 2; ++n) { w0[n] = *(const GAS f32x4*)(cw + ff0 + 4 * n); w1[n] = *(const GAS f32x4*)(cw + DFF + ff0 + 4 * n); w2[n] = *(const GAS f32x4*)(cw + 2 * DFF + ff0 + 4 * n); bb[n] = *(const GAS f32x4*)(cb + ff0 + 4 * n); }
#pragma unroll
    for (int ai = 0; ai < 2; ++ai) {
      f32x4 prv[2] = {(f32x4){0.f, 0.f, 0.f, 0.f}, (f32x4){0.f, 0.f, 0.f, 0.f}};
      const int stripe = u.pm * 4 + ai * 2 + wr;
#pragma unroll
      for (int m = 0; m < 4; ++m) {
        const int row = row0 + ai * HALF + m * 16;
        const float rs = row_rstd(ss, row);
        f32x4 cur[2], gt[2], o[2];
#pragma unroll
        for (int n = 0; n < 2; ++n) {
          cur[n] = acc[ai][0][m][n] * rs; gt[n] = acc[ai][1][m][n] * rs;
#pragma unroll
          for (int uu = 0; uu < 4; ++uu) {
            const float p1 = dpp_prev(prv[n][uu], cur[n][uu], 1), p2 = dpp_prev(prv[n][uu], cur[n][uu], 2);
            const float val = w0[n][uu] * p2 + w1[n][uu] * p1 + w2[n][uu] * cur[n][uu] + bb[n][uu];
            o[n][uu] = val * __builtin_amdgcn_rcpf(1.f + __expf(-val)) * gt[n][uu];
          }
          prv[n] = cur[n];
        }
        u32x4 w; w.x = cvt_pk_bf16(o[0][0], o[0][1]); w.y = cvt_pk_bf16(o[0][2], o[0][3]); w.z = cvt_pk_bf16(o[1][0], o[1][1]); w.w = cvt_pk_bf16(o[1][2], o[1][3]);
        *(GAS u32x4*)(G + (size_t)row * DFF + ff0) = w;
        const bool needu = spec || (m == 0 && fr < 2) || (m == 3 && fr >= 14);
        if (needu) {
          u32x4 wu; wu.x = cvt_pk_bf16(cur[0][0], cur[0][1]); wu.y = cvt_pk_bf16(cur[0][2], cur[0][3]); wu.z = cvt_pk_bf16(cur[1][0], cur[1][1]); wu.w = cvt_pk_bf16(cur[1][2], cur[1][3]);
          u32x4 wg; wg.x = cvt_pk_bf16(gt[0][0], gt[0][1]); wg.y = cvt_pk_bf16(gt[0][2], gt[0][3]); wg.z = cvt_pk_bf16(gt[1][0], gt[1][1]); wg.w = cvt_pk_bf16(gt[1][2], gt[1][3]);
          if (spec) { *(GAS u32x4*)(G + FS_US + (size_t)(row - R_SAMP) * DFF + ff0) = wu; *(GAS u32x4*)(G + FS_GS + (size_t)(row - R_SAMP) * DFF + ff0) = wg; }
          else if (m == 0) { *(GAS u32x4*)(G + FS_UD + ((size_t)stripe * 2 + fr) * DFF + ff0) = wu; *(GAS u32x4*)(G + FS_GD + ((size_t)stripe * 2 + fr) * DFF + ff0) = wg; }
          else *(GAS u32x4*)(G + FS_UH + ((size_t)stripe * 2 + (fr - 14)) * DFF + ff0) = wu;
        }
      }
    }
  }
};
}


#define XB_TMO      128
#define XB_XCNT(j)  (256  + 64 * (j))
#define XB_XSUB(j)  (1280 + 64 * (j))
#define XB_XGEN(j)  (2304 + 64 * (j))
#define XB_TOP      3328
#define XB_TOPGEN   3392
#define XCD_BAR_WORDS 3456
#define XB_SPIN_CAP (1u << 20)
__device__ __forceinline__ unsigned xb_ld(unsigned* p)              { return __hip_atomic_load(p, __ATOMIC_RELAXED, __HIP_MEMORY_SCOPE_AGENT); }
__device__ __forceinline__ unsigned xb_add(unsigned* p, unsigned v) { return __hip_atomic_fetch_add(p, v, __ATOMIC_RELAXED, __HIP_MEMORY_SCOPE_AGENT); }
__device__ __forceinline__ unsigned xb_xcc_id() { return (unsigned)__builtin_amdgcn_s_getreg((3 << 11) | 20) & 0xFu; }
#define XB_SPIN(cond, bar) do { unsigned _sp = 0; while (cond) { __builtin_amdgcn_s_sleep(1); \
    if ((++_sp & 255u) == 0u) { if (xb_ld(&(bar)[XB_TMO])) break; if (_sp > XB_SPIN_CAP) { atomicAdd(&(bar)[XB_TMO], 1u); break; } } } } while (0)
__device__ __forceinline__ void xcd_barrier_complete(unsigned* bar, unsigned x, unsigned& nloc, unsigned& nx) {
  const unsigned G = gridDim.x * gridDim.y * gridDim.z;
  unsigned sum, cnt, mine, sp = 0u;
  for (;;) {
    sum = 0u; cnt = 0u; mine = 0u;
#pragma unroll
    for (unsigned j = 0; j < 16; ++j) { const unsigned c = xb_ld(&bar[XB_XCNT(j)]); sum += c; cnt += (c > 0u) ? 1u : 0u; mine = (j == x) ? c : mine; }
    if (sum == G) break;
    __builtin_amdgcn_s_sleep(1);
    if ((++sp & 255u) == 0u) { if (xb_ld(&bar[XB_TMO])) break; if (sp > XB_SPIN_CAP) { atomicAdd(&bar[XB_TMO], 1u); break; } }
  }
  nloc = mine > 0u ? mine : 1u; nx = cnt > 0u ? cnt : 1u;
}
__device__ __forceinline__ void xcd_barrier(unsigned* bar, volatile LAS unsigned* st, bool tid0) {
  asm volatile("s_waitcnt vmcnt(0)" ::: "memory");
  __syncthreads();
  if (tid0) {
    __builtin_amdgcn_s_waitcnt(0);
    const unsigned x = xb_xcc_id();
    unsigned nloc = st[0], nx = st[1];
    if (nloc == 0u) { xcd_barrier_complete(bar, x, nloc, nx); st[0] = nloc; st[1] = nx; }
    const unsigned old = xb_add(&bar[XB_XSUB(x)], 1u);
    const unsigned gen = old / nloc;
    if (old + 1u == (gen + 1u) * nloc) {
      __builtin_amdgcn_fence(__ATOMIC_RELEASE, "agent");
      asm volatile("s_waitcnt vmcnt(0)" ::: "memory");
      const unsigned og = xb_add(&bar[XB_TOP], 1u);
      const unsigned tg = og / nx;
      if (og + 1u == (tg + 1u) * nx) xb_add(&bar[XB_TOPGEN], 1u);
      else XB_SPIN(xb_ld(&bar[XB_TOPGEN]) == tg, bar);
      __builtin_amdgcn_fence(__ATOMIC_ACQUIRE, "agent");
      xb_add(&bar[XB_XGEN(x)], 1u);
      asm volatile("s_waitcnt vmcnt(0)" ::: "memory");
    } else {
      XB_SPIN(xb_ld(&bar[XB_XGEN(x)]) == gen, bar);
      __builtin_amdgcn_fence(__ATOMIC_ACQUIRE, "agent");
      asm volatile("s_waitcnt vmcnt(0)" ::: "memory");
    }
  }
  __syncthreads();
}

__device__ __forceinline__ void transpose_item(const GAS float* W, int N, int k0, int n0, int nvalid, const GAS float* scale, GAS bf16_t* WT, int ldt, int dst_row0, int dst_k0, LAS float* scr, int lane) {
  {
    const int n4 = 4 * (lane & 7);
    f32x4 v[8];
#pragma unroll
    for (int i = 0; i < 8; ++i) {
      const int kk = (lane >> 3) + 8 * i;
      v[i] = (n0 + n4 < nvalid) ? *(const GAS f32x4*)(W + (size_t)(k0 + kk) * N + n0 + n4) : (f32x4){0.f, 0.f, 0.f, 0.f};
    }
#pragma unroll
    for (int i = 0; i < 8; ++i) {
      const int kk = (lane >> 3) + 8 * i;
      const float sc = scale ? scale[k0 + kk] : 1.f;
      scr[kk * 33 + n4] = v[i][0] * sc; scr[kk * 33 + n4 + 1] = v[i][1] * sc; scr[kk * 33 + n4 + 2] = v[i][2] * sc; scr[kk * 33 + n4 + 3] = v[i][3] * sc;
    }
  }
  asm volatile("s_waitcnt lgkmcnt(0)" ::: "memory");
  const int c = lane & 7;
#pragma unroll
  for (int j = 0; j < 4; ++j) {
    const int n = (lane >> 3) + 8 * j; const LAS float* s = scr + (8 * c) * 33 + n;
    u32x4 o; o.x = pk2(s[0 * 33], s[1 * 33]); o.y = pk2(s[2 * 33], s[3 * 33]); o.z = pk2(s[4 * 33], s[5 * 33]); o.w = pk2(s[6 * 33], s[7 * 33]);
    *(GAS u32x4*)(WT + (size_t)(dst_row0 + n) * ldt + dst_k0 + 8 * c) = o;
  }
  asm volatile("s_waitcnt lgkmcnt(0)" ::: "memory");
}

constexpr int WI_IN = 16 * 128, WI_OUT = 16 * 32, WI_UP = 16 * 176, WI_DN = 44 * 32, WI_L = WI_IN + WI_OUT + WI_UP + WI_DN;
__device__ __forceinline__ void convert_weights(const GAS float* w_in, const GAS float* nmix, const GAS float* w_out, const GAS float* w_up, const GAS float* nffn, const GAS float* w_dn,
                                                GAS unsigned char* ws, int l, int r_lo, int r_hi, int widx, int nw, LAS float* scr, int lane) {
  for (int r0 = r_lo + widx; r0 < r_hi; r0 += nw) {
    int r = r0;
    if (r < WI_IN) {
      const int kb = r / 128, nb = r % 128;
      transpose_item(w_in + (size_t)l * DM * DIN, DIN, kb * 64, nb * 32, DIN, nmix + l * DM, (GAS bf16_t*)(ws + WS_WIN) + (size_t)l * NINP * DM, DM, nb * 32, kb * 64, scr, lane);
      continue; }
    r -= WI_IN;
    if (r < WI_OUT) {
      const int kb = r / 32, nb = r % 32;
      transpose_item(w_out + (size_t)l * DM * DM, DM, kb * 64, nb * 32, DM, nullptr, (GAS bf16_t*)(ws + WS_WOUT) + (size_t)l * DM * DM, DM, nb * 32, kb * 64, scr, lane);
      continue; }
    r -= WI_OUT;
    if (r < WI_UP) {
      const int kb = r / 176, nb = r % 176;
      const int drow = nb * 32, pn = drow >> 8, j = drow & 255;
      const int src = (j < 128) ? (128 * pn + j) : (DFF + 128 * pn + (j - 128));
      transpose_item(w_up + (size_t)l * DM * 2 * DFF, 2 * DFF, kb * 64, src, 2 * DFF, nffn + l * DM, (GAS bf16_t*)(ws + WS_WUP) + (size_t)l * 2 * DFF * DM, DM, drow, kb * 64, scr, lane);
      continue; }
    r -= WI_UP;
    {
      const int kb = r / 32, nb = r % 32;
      transpose_item(w_dn + (size_t)l * DFF * DM, DM, kb * 64, nb * 32, DM, nullptr, (GAS bf16_t*)(ws + WS_WDN) + (size_t)l * DM * DFF, DFF, nb * 32, kb * 64, scr, lane);
    }
  }
}

__device__ __forceinline__ void phase_prologue(const Params& p, LAS unsigned char* lds) {
  const int tid = threadIdx.x, lane = tid & 63, wave = tid >> 6;
  const int gw = blockIdx.x * 8 + wave, NGW = gridDim.x * 8;
  LAS float* scr = (LAS float*)(lds + wave * 16384);
  unsigned char* ws = p.ws;
  convert_weights((const GAS float*)p.in[11], (const GAS float*)p.in[10], (const GAS float*)p.in[28], (const GAS float*)p.in[30], (const GAS float*)p.in[29], (const GAS float*)p.in[33], (GAS unsigned char*)ws, 0, 0, WI_IN + WI_OUT + WI_UP, gw, NGW, scr, lane);
  {
    bf16_t* lo = (bf16_t*)(ws + WS_LORA);
    for (int idx = blockIdx.x * 512 + tid; idx < DEPTH * AH * 16384; idx += gridDim.x * 512) {
      const int l = idx / (AH * 16384), h = (idx / 16384) % AH, e = idx % 16384;
      float v;
      if (e < 4096) v = p.in[14][((size_t)l * 64 + (e & 63)) * AW + h * 64 + (e >> 6)];
      else if (e < 8192) v = p.in[16][((size_t)l * 64 + (e & 63)) * AW + h * 64 + ((e - 4096) >> 6)];
      else v = p.in[17][((size_t)l * 128 + ((e - 8192) & 127)) * AW + h * 64 + ((e - 8192) >> 7)];
      lo[idx] = (bf16_t)f2bf(v);
    }
  }
  {
    bf16_t* zr = (bf16_t*)(ws + WS_ZROW); bf16_t* shb = (bf16_t*)(ws + WS_SHIFTB);
    for (int idx = blockIdx.x * 512 + tid; idx < 4096 + DEPTH * SBN * ACOLS; idx += gridDim.x * 512) {
      if (idx < 4096) zr[idx] = 0; else shb[idx - 4096] = (bf16_t)f2bf(p.in[2][idx - 4096]);
    }
    bf16_t* cvb = (bf16_t*)(ws + WS_CONVB);
    for (int idx = blockIdx.x * 512 + tid; idx < DEPTH * SBN * 3 * 1024; idx += gridDim.x * 512) cvb[idx] = (bf16_t)f2bf(p.in[4][idx]);
  }
  float* ss = (float*)(ws + WS_SS);
  bf16_t* Xb0 = (bf16_t*)(ws + WS_XB0);
  for (int r = gw; r < MPAD; r += NGW) {
    const float* src = nullptr;
    if (r < R_SAMP) src = p.in[0] + (size_t)r * DM;
    else if (r < R_META) src = p.in[1] + (size_t)(r - R_SAMP) * DM;
    else if (r < R_TOT) src = p.in[9] + (size_t)((r - R_META) & 15) * DM;
    float s = 0.f;
#pragma unroll
    for (int j = 0; j < 4; ++j) {
      f32x4 v = src ? *(const GAS f32x4*)((const GAS float*)src + 256 * j + 4 * lane) : (f32x4){0.f, 0.f, 0.f, 0.f};
      u32x2 w; w.x = pk2(v[0], v[1]); w.y = pk2(v[2], v[3]);
      *(GAS u32x2*)((GAS bf16_t*)Xb0 + (size_t)r * DM + 256 * j + 4 * lane) = w;
      s += v[0] * v[0] + v[1] * v[1] + v[2] * v[2] + v[3] * v[3];
    }
    s = wave_sum(s);
    if (lane == 0) *(GAS f32x4*)((GAS float*)ss + (size_t)r * 4) = (f32x4){s, 0.f, 0.f, 0.f};
  }
}

constexpr int RW_NPROMPT = NB * AH * 65, RW_NITEMS = RW_NPROMPT + SBN * AH;
constexpr int LDB = 72;
constexpr int ARRB = 64 * LDB * 2;
constexpr int LDF = 68;
constexpr int LDT = 65;
constexpr int L_R1 = 0;
constexpr int L_R2 = L_R1 + 8 * ARRB;
constexpr int L_R3 = L_R2 + 4 * ARRB;
constexpr int L_R4 = L_R3 + 2 * 64 * LDF * 4;
constexpr int L_R5 = L_R4 + ARRB;
constexpr int L_RWEND = L_R5 + (8 * 64 + 64 + 64) * 4;
static_assert(2 * 64 * LDT * 4 <= 2 * 64 * LDF * 4, "Tf + Zf fit in R3");
static_assert(L_RWEND <= 163840, "rwkv LDS");

__device__ __forceinline__ void rw_decode(int item, int& seq, int& h, int& chunk) {
  if (item < RW_NPROMPT) { chunk = item % 65; const int sh = item / 65; h = sh & 7; seq = sh >> 3; }
  else { const int r = item - RW_NPROMPT; chunk = 0; h = r & 7; seq = NB + (r >> 3); }
}
__device__ __forceinline__ int rw_row(int seq, int chunk, int t) {
  if (seq < NB) return chunk == 0 ? (R_META + 16 * seq + t) : (SEQ * seq + 64 * (chunk - 1) + t);
  return R_SAMP + 16 * (seq - NB) + t;
}
__device__ __forceinline__ bf16x8 ldfrag(const LAS bf16_t* p) { return *(const LAS bf16x8*)p; }
__device__ __forceinline__ bf16x8 ldfrag(const GAS bf16_t* p) { return *(const GAS bf16x8*)p; }
template <int K, class PX, class PY>
__device__ __forceinline__ f32x4 mma_nt(PX X, int ldx, PY Y, int ldy, int lane, f32x4 acc) {
  const int r = lane & 15, q = lane >> 4;
#pragma unroll
  for (int s = 0; s < K / 32; ++s) {
    const bf16x8 xb = ldfrag(X + r * ldx + 32 * s + 8 * q);
    const bf16x8 ya = ldfrag(Y + r * ldy + 32 * s + 8 * q);
    acc = __builtin_amdgcn_mfma_f32_16x16x32_bf16(ya, xb, acc, 0, 0, 0);
  }
  return acc;
}
template <int K, bool SWX, bool SWY, class PX, class PY>
__device__ __forceinline__ f32x4 mma_sw(PX X, int ldx, int xt, PY Y, int ldy, int yt, int lane, f32x4 acc) {
  const int r = lane & 15, q = lane >> 4;
  const int sx = SWX ? ((2 * xt + (r >> 3)) & 7) : 0, sy = SWY ? ((2 * yt + (r >> 3)) & 7) : 0;
#pragma unroll
  for (int s = 0; s < K / 32; ++s) {
    const bf16x8 xb = ldfrag(X + r * ldx + 8 * ((4 * s + q) ^ sx));
    const bf16x8 ya = ldfrag(Y + r * ldy + 8 * ((4 * s + q) ^ sy));
    acc = __builtin_amdgcn_mfma_f32_16x16x32_bf16(ya, xb, acc, 0, 0, 0);
  }
  return acc;
}
__device__ __forceinline__ u32x2 pack4(f32x4 v) { u32x2 w; w.x = pk2(v[0], v[1]); w.y = pk2(v[2], v[3]); return w; }

__device__ __forceinline__ const GAS bf16_t* rw_prev_row(const Ctx p, int l, int seq, int chunk, int t) {
  const GAS bf16_t* P = (const GAS bf16_t*)(p.ws + WS_BIG);
  if (t > 0) return P + (size_t)rw_row(seq, chunk, t - 1) * PLD;
  if (seq >= NB) return (const GAS bf16_t*)(p.ws + WS_SHIFTB) + ((size_t)l * SBN + (seq - NB)) * ACOLS;
  if (chunk == 0) return (const GAS bf16_t*)(p.ws + WS_ZROW);
  return P + (size_t)(chunk == 1 ? (R_META + 16 * seq + 15) : (rw_row(seq, chunk, 0) - 1)) * PLD;
}
__device__ __forceinline__ GAS bf16_t* rw_trec(GAS unsigned char* ws, int l, int item) {
  const int lo = 1 - l;
  if (item < 1408) return (GAS bf16_t*)(ws + WS_WUP + (size_t)lo * 2 * DFF * DM * 2) + (size_t)item * 4096;
  if (item < 2112) return (GAS bf16_t*)(ws + WS_WDN + (size_t)lo * DM * DFF * 2) + (size_t)(item - 1408) * 4096;
  return (GAS bf16_t*)(ws + WS_WOUT + (size_t)lo * DM * DM * 2) + (size_t)(item - 2112) * 4096;
}
static_assert(DEPTH == 2 && RW_NITEMS == 2208, "T record placement");
constexpr int RW_LC = 62;
constexpr int RW_NLITE = 1984;
static_assert((size_t)MPAD * DM * 2 + (size_t)RW_NLITE * 16384 <= (size_t)NB * SEQ * DM * 4, "Qh / Yhat records fit behind MIX in d_out");
__device__ __forceinline__ GAS bf16_t* rw_qrec(const Ctx p, int l, int seq, int h, int chunk) {
  if (seq < NB && chunk < RW_LC) return (GAS bf16_t*)p.out + (size_t)MPAD * DM + (size_t)((seq * 8 + h) * RW_LC + chunk) * 8192;
  const int hidx = seq < NB ? (seq * 8 + h) * 3 + (chunk - RW_LC) : NB * 8 * 3 + (seq - NB) * 8 + h;
  return (GAS bf16_t*)(p.ws + WS_WUP + (size_t)(1 - l) * 2 * DFF * DM * 2) + (size_t)hidx * 8192;
}
struct RwPref { u32x4 lc[4], lp[4], rc[3], rp[3]; };
template <int LIST>
__device__ __forceinline__ void rw_item_ids(int h, int k, int& seq, int& chunk, int& item) {
  if (LIST == 0) {
    if (k < NB * 65) { seq = k / 65; chunk = k - seq * 65; } else { seq = NB + (k - NB * 65); chunk = 0; }
  } else if (LIST == 1) {
    if (k < NB * 3) { seq = k / 3; chunk = RW_LC + (k - seq * 3); } else { seq = NB + (k - NB * 3); chunk = 0; }
  } else { seq = k / RW_LC; chunk = k - seq * RW_LC; }
  item = seq < NB ? (seq * 8 + h) * 65 + chunk : RW_NPROMPT + (seq - NB) * 8 + h;
}
template <int MODE, int LIST>
__device__ __forceinline__ void rw_prefetch(const Ctx p, int l, int h, int k, int tid, RwPref& pf) {
  int seq, chunk, item; rw_item_ids<LIST>(h, k, seq, chunk, item);
  const int ntok = (chunk == 0) ? 16 : 64;
  const GAS bf16_t* P = (const GAS bf16_t*)(p.ws + WS_BIG);
  const u32x4 z = (u32x4){0u, 0u, 0u, 0u};
  const int grp = MODE == 1 ? (tid & 31) : (tid & 15), colL = 1536 + 8 * grp;
#pragma unroll
  for (int u = 0; u < (MODE == 1 ? 4 : 2); ++u) {
    const int t = MODE == 1 ? ((tid >> 5) + 16 * u) : ((tid >> 4) + 32 * u);
    if (t < ntok) { pf.lc[u] = *(const u32x4*)(P + (size_t)rw_row(seq, chunk, t) * PLD + colL); pf.lp[u] = *(const u32x4*)(rw_prev_row(p, l, seq, chunk, t) + colL); }
    else { pf.lc[u] = z; pf.lp[u] = z; }
  }
  const int t2 = tid >> 3, hc0 = h * 64 + 8 * (tid & 7);
  if (t2 < ntok) {
    const GAS bf16_t* rb = P + (size_t)rw_row(seq, chunk, t2) * PLD; const GAS bf16_t* pb = rw_prev_row(p, l, seq, chunk, t2);
#pragma unroll
    for (int part = 0; part < 3; ++part) { pf.rc[part] = *(const u32x4*)(rb + part * 512 + hc0); pf.rp[part] = *(const u32x4*)(pb + part * 512 + hc0); }
  } else {
#pragma unroll
    for (int part = 0; part < 3; ++part) { pf.rc[part] = z; pf.rp[part] = z; }
  }
}
__device__ __forceinline__ void unpack8(const u32x4 w, float* o) { o[0] = bflo(w.x); o[1] = bfhi(w.x); o[2] = bflo(w.y); o[3] = bfhi(w.y); o[4] = bflo(w.z); o[5] = bfhi(w.z); o[6] = bflo(w.w); o[7] = bfhi(w.w); }

typedef short s16x4_t __attribute__((ext_vector_type(4)));
__device__ __forceinline__ bf16x8 ldfrag_tr(const LAS bf16_t* ARR, int ct, int s, int lane) {
  const int g = lane >> 4, i = lane & 15;
  const LAS bf16_t* p = ARR + (32 * s + 8 * g + (i >> 2)) * LDB + 16 * ct + 4 * (i & 3);
  const s16x4_t lo = __builtin_amdgcn_ds_read_tr16_b64_v4i16((LAS s16x4_t*)p), hi = __builtin_amdgcn_ds_read_tr16_b64_v4i16((LAS s16x4_t*)(p + 4 * LDB));
  u32x4 w; w.x = __builtin_bit_cast(u32x2, lo).x; w.y = __builtin_bit_cast(u32x2, lo).y; w.z = __builtin_bit_cast(u32x2, hi).x; w.w = __builtin_bit_cast(u32x2, hi).y;
  return __builtin_bit_cast(bf16x8, w);
}
template <bool TX, bool TY>
__device__ __forceinline__ f32x4 mma_tt(const LAS bf16_t* X, int xt, const LAS bf16_t* Y, int yt, int lane, f32x4 acc) {
  const int r = lane & 15, q = lane >> 4;
#pragma unroll
  for (int s = 0; s < 2; ++s) {
    const bf16x8 xb = TX ? ldfrag_tr(X, xt, s, lane) : ldfrag(X + (16 * xt + r) * LDB + 32 * s + 8 * q);
    const bf16x8 ya = TY ? ldfrag_tr(Y, yt, s, lane) : ldfrag(Y + (16 * yt + r) * LDB + 32 * s + 8 * q);
    acc = __builtin_amdgcn_mfma_f32_16x16x32_bf16(ya, xb, acc, 0, 0, 0);
  }
  return acc;
}

constexpr int L_PRM = L_RWEND;
static_assert(L_PRM + 640 * 4 <= 163824, "rwkv params LDS");

template <int MODE>
__device__ __forceinline__ void rwkv_phase(const Ctx p, int l, LAS unsigned char* lds, int rep) {
  const int tid0 = opaque_tid(p.wv);
  const int h = p.bid & 7, slot = p.bid >> 3, nslot = p.nblk >> 3;
  constexpr int LIST = MODE;
  constexpr int NK = MODE == 0 ? NB * 65 + SBN : NB * 3 + SBN;
  LAS bf16_t* A_row = (LAS bf16_t*)(lds + L_R1);            LAS bf16_t* B_row = A_row + 64 * LDB;  LAS bf16_t* K_row = B_row + 64 * LDB;  LAS bf16_t* R_row = K_row + 64 * LDB;
  LAS bf16_t* AT = R_row + 64 * LDB;  LAS bf16_t* VT = AT + 64 * LDB;  LAS bf16_t* BCT = VT + 64 * LDB;  LAS bf16_t* KCT = BCT + 64 * LDB;
  static_assert(MODE == 0, "only the state pass is kept up to date (token-major operand arrays + transposed reads); the output side is rwkv_phase_lite");
  LAS bf16_t* WT = AT; LAS bf16_t* X1T = B_row; LAS bf16_t* UT = K_row;
  LAS bf16_t* V_row = VT; LAS bf16_t* BC_row = BCT; LAS bf16_t* KC_row = KCT;
  LAS bf16_t* XW = (LAS bf16_t*)(lds + L_R2); LAS bf16_t* XA = XW + 64 * LDB; LAS bf16_t* XG = XA + 64 * LDB;
  LAS bf16_t* Aak = (LAS bf16_t*)(lds + L_R2); LAS bf16_t* Arb = Aak + 64 * LDB; LAS bf16_t* Ark = Arb + 64 * LDB; LAS bf16_t* Tb = Ark + 64 * LDB;
  LAS float* F0 = (LAS float*)(lds + L_R3); LAS float* F1 = F0 + 64 * LDF;
  LAS float* Tf = (LAS float*)(lds + L_R3); LAS float* Zf = Tf + 64 * LDT;
  LAS bf16_t* Gb = (LAS bf16_t*)(lds + L_R4);
  LAS float* segsum = (LAS float*)(lds + L_R5); LAS float* cumC = segsum + 512; LAS float* bonS = cumC + 64;
  LAS float* prm = (LAS float*)(lds + L_PRM);
  constexpr int LDG = 136;
  const GAS bf16_t* P = (const GAS bf16_t*)(p.ws + WS_BIG);

  if (tid0 < 192) prm[tid0] = p.in[12][(size_t)l * ACOLS + (tid0 >> 6) * 512 + h * 64 + (tid0 & 63)];
  else if (tid0 < 256) {
    const int c = tid0 - 192, hc = l * AW + h * 64 + c;
    prm[192 + c] = p.in[13][hc]; prm[256 + c] = p.in[15][hc]; prm[320 + c] = p.in[18][hc]; prm[384 + c] = p.in[19][hc]; prm[448 + c] = p.in[20][hc];
    prm[512 + c] = p.in[21][hc]; prm[576 + c] = p.in[22][hc];
  }
  float muL[8];
  { const GAS float* mu = p.in[12] + (size_t)l * ACOLS + 1536 + 8 * (MODE == 1 ? (tid0 & 31) : (tid0 & 15));
#pragma unroll
    for (int i = 0; i < 8; ++i) muL[i] = mu[i]; }
  const GAS bf16_t* w2T = (const GAS bf16_t*)(p.ws + WS_LORA) + ((size_t)l * AH + h) * 16384;
  const GAS bf16_t* a2T = w2T + 4096; const GAS bf16_t* g2T = w2T + 8192;

  const bool bal = (MODE == 0) && (nslot == 32);
  int xk = -1;
  if (bal && slot < 26 && (p.bid % 13) >= 9) { int rank = 0; for (int s2 = 0; s2 < slot; ++s2) rank += ((h + 8 * s2) % 13) >= 9 ? 1 : 0; if (rank < 8) xk = 256 + rank; }
  const int nmine = bal ? (slot < 26 ? (xk >= 0 ? 9 : 8) : 10) : (MODE == 1 ? (NK - (nslot - 1 - slot) + nslot - 1) / nslot : (NK - slot + nslot - 1) / nslot);
#define RW_KTH(j) (MODE == 1 ? (nslot - 1 - slot) + (j) * nslot : bal ? ((j) < 8 ? (j) * 32 + slot : (slot < 26 ? xk : 264 + ((j) - 8) * 6 + (slot - 26))) : (slot + (j) * nslot))
  const int lane_h = tid0 & 63, fr = lane_h & 15, fq = lane_h >> 4, jt0_ = ((tid0 >> 6) & 1) * 2;
    bf16x8 fw[2][2], fa[2][2], fg[2][4];
#pragma unroll
    for (int jj = 0; jj < 2; ++jj) {
#pragma unroll
      for (int s = 0; s < 2; ++s) { fw[jj][s] = *(const bf16x8*)(w2T + (16 * (jt0_ + jj) + fr) * 64 + 32 * s + 8 * fq); fa[jj][s] = *(const bf16x8*)(a2T + (16 * (jt0_ + jj) + fr) * 64 + 32 * s + 8 * fq); }
      if (MODE == 1) {
#pragma unroll
        for (int s = 0; s < 4; ++s) fg[jj][s] = *(const bf16x8*)(g2T + (16 * (jt0_ + jj) + fr) * 128 + 32 * s + 8 * fq);
      }
    }
  RwPref pf;
  int jj = 0;
  if (jj < nmine * rep) rw_prefetch<MODE, LIST>(p, l, h, RW_KTH(jj % nmine), tid0, pf);
  __syncthreads();
#pragma unroll 1
  for (; jj < nmine * rep; ++jj) {
    const int k = RW_KTH(jj % nmine);
    int tid = tid0; asm volatile("" : "+v"(tid));
    const int lane = tid & 63, wave = tid >> 6, fr = lane & 15, fq = lane >> 4, t = tid >> 3, cg = tid & 7, c0 = 8 * cg, hc0 = h * 64 + c0;
    int seq, chunk, item; rw_item_ids<LIST>(h, k, seq, chunk, item);
    const bool samp = seq >= NB; const int sb = seq - NB;
    const int ntok = (chunk == 0) ? 16 : 64;
    const int it_ = wave >> 1, jt0_ = (wave & 1) * 2;
    const bool sto = (MODE == 0);
    {
      const int grp = MODE == 1 ? (tid & 31) : (tid & 15);
#pragma unroll
      for (int u = 0; u < (MODE == 1 ? 4 : 2); ++u) {
        const int tt = MODE == 1 ? ((tid >> 5) + 16 * u) : ((tid >> 4) + 32 * u);
        float cur[8], prv[8], o[8];
        unpack8(pf.lc[u], cur); unpack8(pf.lp[u], prv);
        const bool valid = tt < ntok;
#pragma unroll
        for (int i = 0; i < 8; ++i) {
          const float pm = cur[i] + (prv[i] - cur[i]) * muL[i];
          const float sg = __builtin_amdgcn_rcpf(1.f + __expf(grp < 8 ? -2.f * pm : -pm));
          o[i] = grp < 8 ? 2.f * sg - 1.f : (grp < 16 ? pm : sg);
          if (!valid) o[i] = 0.f;
        }
        u32x4 w; w.x = pk2(o[0], o[1]); w.y = pk2(o[2], o[3]); w.z = pk2(o[4], o[5]); w.w = pk2(o[6], o[7]);
        if (grp < 8) *(LAS u32x4*)(XW + tt * LDB + 8 * grp) = w;
        else if (grp < 16) *(LAS u32x4*)(XA + tt * LDB + 8 * (grp - 8)) = w;
        else if (MODE == 1) *(LAS u32x4*)(XG + tt * LDG + 8 * (grp - 16)) = w;
      }
    }
    __syncthreads();
    {
#pragma unroll
      for (int jj = 0; jj < 2; ++jj) {
        const int jt = jt0_ + jj;
        f32x4 aw = (f32x4){0.f, 0.f, 0.f, 0.f}, aa = aw;
#pragma unroll
        for (int s = 0; s < 2; ++s) {
          aw = __builtin_amdgcn_mfma_f32_16x16x32_bf16(fw[jj][s], ldfrag(XW + (16 * it_ + fr) * LDB + 32 * s + 8 * fq), aw, 0, 0, 0);
          aa = __builtin_amdgcn_mfma_f32_16x16x32_bf16(fa[jj][s], ldfrag(XA + (16 * it_ + fr) * LDB + 32 * s + 8 * fq), aa, 0, 0, 0);
        }
        *(LAS f32x4*)(F0 + (16 * it_ + fr) * LDF + 16 * jt + 4 * fq) = aw;
        *(LAS f32x4*)(F1 + (16 * it_ + fr) * LDF + 16 * jt + 4 * fq) = aa;
        if (MODE == 1) {
          f32x4 ag = (f32x4){0.f, 0.f, 0.f, 0.f};
#pragma unroll
          for (int s = 0; s < 4; ++s) ag = __builtin_amdgcn_mfma_f32_16x16x32_bf16(fg[jj][s], ldfrag(XG + (16 * it_ + fr) * LDG + 32 * s + 8 * fq), ag, 0, 0, 0);
          *(LAS u32x2*)(Gb + (16 * it_ + fr) * LDB + 16 * jt + 4 * fq) = pack4(ag);
        }
      }
    }
    __syncthreads();
    float rr[8], kb[8], k2[8], vv[8], lw[8], nk[8];
    {
      const bool valid = t < ntok;
      float kraw[8];
#pragma unroll
      for (int part = 0; part < 3; ++part) {
        float cur[8], prv[8];
        unpack8(pf.rc[part], cur); unpack8(pf.rp[part], prv);
#pragma unroll
        for (int i = 0; i < 8; ++i) { const float pm = cur[i] + (prv[i] - cur[i]) * prm[part * 64 + c0 + i]; if (part == 0) rr[i] = pm; else if (part == 1) kraw[i] = pm; else vv[i] = pm; }
      }
      const f32x4 dw0 = *(const LAS f32x4*)(F0 + t * LDF + c0), dw1 = *(const LAS f32x4*)(F0 + t * LDF + c0 + 4);
      const f32x4 da0 = *(const LAS f32x4*)(F1 + t * LDF + c0), da1 = *(const LAS f32x4*)(F1 + t * LDF + c0 + 4);
      float nrm = 0.f, bon = 0.f, av[8];
#pragma unroll
      for (int i = 0; i < 8; ++i) {
        const float dwv = i < 4 ? dw0[i & 3] : dw1[i & 3], dav = i < 4 ? da0[i & 3] : da1[i & 3];
        const float wl = -softplusf_(-(prm[192 + c0 + i] + dwv)) - 0.5f;
        lw[i] = valid ? -__expf(wl) : 0.f;
        av[i] = sigmoidf_(prm[256 + c0 + i] + dav);
        nk[i] = kraw[i] * prm[320 + c0 + i];
        nrm += nk[i] * nk[i];
        k2[i] = kraw[i] * (1.f + (av[i] - 1.f) * prm[384 + c0 + i]);
        bon += rr[i] * k2[i] * prm[448 + c0 + i];
      }
      nrm += __shfl_xor(nrm, 1); nrm += __shfl_xor(nrm, 2); nrm += __shfl_xor(nrm, 4);
      bon += __shfl_xor(bon, 1); bon += __shfl_xor(bon, 2); bon += __shfl_xor(bon, 4);
      const float rn = rsqrtf(nrm + 1e-12f);
#pragma unroll
      for (int i = 0; i < 8; ++i) { nk[i] *= rn; kb[i] = nk[i] * av[i]; }
      if (MODE == 1 && cg == 0) bonS[t] = bon;
      if (MODE == 0 && cg == 0) ((GAS float*)(p.ws + WS_BONUS))[(size_t)item * 64 + t] = bon;
      *(LAS f32x4*)(F0 + t * LDF + c0) = (f32x4){lw[0], lw[1], lw[2], lw[3]};
      *(LAS f32x4*)(F0 + t * LDF + c0 + 4) = (f32x4){lw[4], lw[5], lw[6], lw[7]};
    }
    __syncthreads();
    {
      const int c = tid & 63, seg = tid >> 6;
      float s = 0.f;
#pragma unroll
      for (int i = 0; i < 8; ++i) { s += F0[(8 * seg + i) * LDF + c]; F0[(8 * seg + i) * LDF + c] = s; }
      segsum[seg * 64 + c] = s;
      __syncthreads();
      float off = 0.f;
      for (int s2 = 0; s2 < seg; ++s2) off += segsum[s2 * 64 + c];
#pragma unroll
      for (int i = 0; i < 8; ++i) F0[(8 * seg + i) * LDF + c] += off;
      if (seg == 7) cumC[c] = s + off;
    }
    __syncthreads();
    {
      const f32x4 cu0 = *(const LAS f32x4*)(F0 + t * LDF + c0), cu1 = *(const LAS f32x4*)(F0 + t * LDF + c0 + 4);
      float oa[8], ob[8], ok[8], orr[8], obc[8], okc[8];
#pragma unroll
      for (int i = 0; i < 8; ++i) {
        const float cu = i < 4 ? cu0[i & 3] : cu1[i & 3], cc = cumC[c0 + i];
        const float ec = __expf(cu), em1 = __expf(cu - lw[i]), ei = __expf(-cu), eC = __expf(cc - cu);
        oa[i] = -nk[i] * em1; ob[i] = kb[i] * ei; ok[i] = k2[i] * ei; orr[i] = rr[i] * ec; obc[i] = kb[i] * eC; okc[i] = k2[i] * eC;
      }
      u32x4 w;
      w.x = pk2(oa[0], oa[1]); w.y = pk2(oa[2], oa[3]); w.z = pk2(oa[4], oa[5]); w.w = pk2(oa[6], oa[7]); *(LAS u32x4*)(A_row + t * LDB + c0) = w;
      w.x = pk2(ob[0], ob[1]); w.y = pk2(ob[2], ob[3]); w.z = pk2(ob[4], ob[5]); w.w = pk2(ob[6], ob[7]); *(LAS u32x4*)(B_row + t * LDB + c0) = w;
      w.x = pk2(ok[0], ok[1]); w.y = pk2(ok[2], ok[3]); w.z = pk2(ok[4], ok[5]); w.w = pk2(ok[6], ok[7]); *(LAS u32x4*)(K_row + t * LDB + c0) = w;
      if (MODE == 1 || sto) { w.x = pk2(orr[0], orr[1]); w.y = pk2(orr[2], orr[3]); w.z = pk2(orr[4], orr[5]); w.w = pk2(orr[6], orr[7]); *(LAS u32x4*)(R_row + t * LDB + c0) = w; }
      w.x = pk2(vv[0], vv[1]); w.y = pk2(vv[2], vv[3]); w.z = pk2(vv[4], vv[5]); w.w = pk2(vv[6], vv[7]); *(LAS u32x4*)(V_row + t * LDB + c0) = w;
      w.x = pk2(obc[0], obc[1]); w.y = pk2(obc[2], obc[3]); w.z = pk2(obc[4], obc[5]); w.w = pk2(obc[6], obc[7]); *(LAS u32x4*)(BC_row + t * LDB + c0) = w;
      w.x = pk2(okc[0], okc[1]); w.y = pk2(okc[2], okc[3]); w.z = pk2(okc[4], okc[5]); w.w = pk2(okc[6], okc[7]); *(LAS u32x4*)(KC_row + t * LDB + c0) = w;
    }
    if (jj + 1 < nmine * rep) { int tidp = tid; asm volatile("" : "+v"(tidp)); rw_prefetch<MODE, LIST>(p, l, h, RW_KTH((jj + 1) % nmine), tidp, pf); }
    GAS bf16_t* MTg = (GAS bf16_t*)(p.ws + WS_AUX) + (size_t)item * 8192;
    u32x4 trec = (u32x4){0u, 0u, 0u, 0u};
    if (MODE == 1) trec = *(const GAS u32x4*)(rw_trec(p.ws, l, item) + t * 64 + c0);
    GAS bf16_t* Ng = MTg + 4096;
    __syncthreads();
    {
      const int it = wave >> 1, jt0 = (wave & 1) * 2;
#pragma unroll
      for (int jj = 0; jj < 2; ++jj) {
        const int jt = jt0 + jj, i = 16 * it + fr, j0 = 16 * jt + 4 * fq;
        f32x4 z = (f32x4){0.f, 0.f, 0.f, 0.f};
        f32x4 ab = z, ak = z;
        if (jt <= it) {
          if (MODE == 0) ab = mma_nt<64>(A_row + 16 * it * LDB, LDB, B_row + 16 * jt * LDB, LDB, lane, ab);
          ak = mma_nt<64>(A_row + 16 * it * LDB, LDB, K_row + 16 * jt * LDB, LDB, lane, ak);
        }
#pragma unroll
        for (int u = 0; u < 4; ++u) { if (j0 + u >= i) { ab[u] = 0.f; ak[u] = 0.f; } if (MODE == 0) Tf[i * LDT + j0 + u] = ab[u]; }
        *(LAS u32x2*)(Aak + i * LDB + j0) = pack4(ak);
        if (MODE == 1 || sto) {
          f32x4 rb = z, rk = z;
          if (jt <= it) {
            rb = mma_nt<64>(R_row + 16 * it * LDB, LDB, B_row + 16 * jt * LDB, LDB, lane, rb);
            rk = mma_nt<64>(R_row + 16 * it * LDB, LDB, K_row + 16 * jt * LDB, LDB, lane, rk);
          }
#pragma unroll
          for (int u = 0; u < 4; ++u) if (j0 + u > i) { rb[u] = 0.f; rk[u] = 0.f; }
          *(LAS u32x2*)(Arb + i * LDB + j0) = pack4(rb);
          *(LAS u32x2*)(Ark + i * LDB + j0) = pack4(rk);
        }
      }
    }
    if (MODE == 1) *(LAS u32x4*)(Tb + t * LDB + c0) = trec;
    __syncthreads();
    if (MODE == 0) {
    if (tid < 64) {
      const int b = tid >> 4, j = tid & 15; const LAS float* Ab = Tf + (16 * b) * LDT + 16 * b;
      float x[16];
#pragma unroll
      for (int i = 0; i < 16; ++i) {
        float s = (i == j) ? 1.f : 0.f;
#pragma unroll
        for (int m = 0; m < i; ++m) s += Ab[i * LDT + m] * x[m];
        x[i] = (i < j) ? 0.f : s;
      }
#pragma unroll
      for (int i = 0; i < 16; ++i) Tf[(16 * b + i) * LDT + 16 * b + j] = x[i];
    }
    __syncthreads();
    if (wave < 2) {
      const int r0 = 32 * wave + 16, cb = 32 * wave, lm = lane & 15, lk = lane >> 4;
      f32x4 z = (f32x4){0.f, 0.f, 0.f, 0.f};
#pragma unroll
      for (int ks = 0; ks < 4; ++ks) z = __builtin_amdgcn_mfma_f32_16x16x4f32(Tf[(r0 + lm) * LDT + cb + 4 * ks + lk], Tf[(cb + 4 * ks + lk) * LDT + cb + lm], z, 0, 0, 0);
#pragma unroll
      for (int r = 0; r < 4; ++r) Zf[(r0 + 4 * lk + r) * LDT + cb + lm] = z[r];
      asm volatile("s_waitcnt lgkmcnt(0)" ::: "memory");
      f32x4 o = (f32x4){0.f, 0.f, 0.f, 0.f};
#pragma unroll
      for (int ks = 0; ks < 4; ++ks) o = __builtin_amdgcn_mfma_f32_16x16x4f32(Tf[(r0 + lm) * LDT + r0 + 4 * ks + lk], Zf[(r0 + 4 * ks + lk) * LDT + cb + lm], o, 0, 0, 0);
#pragma unroll
      for (int r = 0; r < 4; ++r) Tf[(r0 + 4 * lk + r) * LDT + cb + lm] = o[r];
    }
    __syncthreads();
    if (wave < 4) {
      const int ti = wave >> 1, tj = wave & 1, lm = lane & 15, lk = lane >> 4;
      f32x4 z = (f32x4){0.f, 0.f, 0.f, 0.f};
#pragma unroll
      for (int ks = 0; ks < 8; ++ks) z = __builtin_amdgcn_mfma_f32_16x16x4f32(Tf[(32 + 16 * ti + lm) * LDT + 4 * ks + lk], Tf[(4 * ks + lk) * LDT + 16 * tj + lm], z, 0, 0, 0);
#pragma unroll
      for (int r = 0; r < 4; ++r) Zf[(32 + 16 * ti + 4 * lk + r) * LDT + 16 * tj + lm] = z[r];
    } else {
      const int w4 = tid - 256;
#pragma unroll
      for (int q = 0; q < 2; ++q) {
        const int idx = w4 + 256 * q;
        if (idx < 384) {
          const int row = idx < 256 ? (idx >> 3) : 32 + ((idx - 256) >> 2), ch = idx < 256 ? (idx & 7) : 4 + ((idx - 256) & 3);
          float o[8];
#pragma unroll
          for (int i = 0; i < 8; ++i) o[i] = Tf[row * LDT + 8 * ch + i];
          u32x4 w; w.x = pk2(o[0], o[1]); w.y = pk2(o[2], o[3]); w.z = pk2(o[4], o[5]); w.w = pk2(o[6], o[7]);
          *(LAS u32x4*)(Tb + row * LDB + 8 * ch) = w;
        }
      }
    }
    __syncthreads();
    if (wave < 4) {
      const int ti = wave >> 1, tj = wave & 1, lm = lane & 15, lk = lane >> 4;
      f32x4 o = (f32x4){0.f, 0.f, 0.f, 0.f};
#pragma unroll
      for (int ks = 0; ks < 8; ++ks) o = __builtin_amdgcn_mfma_f32_16x16x4f32(Tf[(32 + 16 * ti + lm) * LDT + 32 + 4 * ks + lk], Zf[(32 + 4 * ks + lk) * LDT + 16 * tj + lm], o, 0, 0, 0);
#pragma unroll
      for (int r = 0; r < 4; ++r) Tb[(32 + 16 * ti + 4 * lk + r) * LDB + 16 * tj + lm] = (bf16_t)f2bf(o[r]);
    }
    __syncthreads();
    }
    bf16x8 s0f[4][2];
    if (MODE == 1 && wave < 4) {
#pragma unroll
      for (int jt = 0; jt < 4; ++jt)
#pragma unroll
        for (int s = 0; s < 2; ++s) s0f[jt][s] = *(const bf16x8*)(Ng + (16 * jt + fr) * 64 + 32 * s + 8 * fq);
    }
    {
      const int it = wave >> 1, jt0 = (wave & 1) * 2;
#pragma unroll
      for (int jj = 0; jj < 2; ++jj) {
        const int jt = jt0 + jj, i = 16 * it + fr, j0 = 16 * jt + 4 * fq;
        f32x4 z = (f32x4){0.f, 0.f, 0.f, 0.f};
        const f32x4 wt = mma_tt<true, false>(A_row, it, Tb, jt, lane, z);
        const f32x4 x1 = mma_tt<true, false>(V_row, it, Aak, jt, lane, z);
        *(LAS u32x2*)(WT + i * LDB + j0) = pack4(wt);
        *(LAS u32x2*)(X1T + i * LDB + j0) = pack4(x1);
      }
    }
    __syncthreads();
    {
      const int it = wave >> 1, jt0 = (wave & 1) * 2;
#pragma unroll
      for (int jj = 0; jj < 2; ++jj) {
        const int jt = jt0 + jj, i = 16 * it + fr, j0 = 16 * jt + 4 * fq;
        const f32x4 ut = mma_nt<64>(X1T + 16 * it * LDB, LDB, Tb + 16 * jt * LDB, LDB, lane, (f32x4){0.f, 0.f, 0.f, 0.f});
        *(LAS u32x2*)(UT + i * LDB + j0) = pack4(ut);
      }
    }
    __syncthreads();
    if (MODE == 0) {
      const int it = wave >> 1, jt0 = (wave & 1) * 2;
      u32x2 recp[4][2];
#pragma unroll
      for (int a_ = 0; a_ < 4; ++a_) { recp[a_][0] = (u32x2){0u, 0u}; recp[a_][1] = (u32x2){0u, 0u}; }
#pragma unroll
      for (int jj = 0; jj < 2; ++jj) {
        const int jt = jt0 + jj, i = 16 * it + fr, j0 = 16 * jt + 4 * fq;
        f32x4 z = (f32x4){0.f, 0.f, 0.f, 0.f};
        f32x4 mt = mma_tt<true, false>(BC_row, it, WT, jt, lane, z);
#pragma unroll
        for (int u = 0; u < 4; ++u) if (j0 + u == i) mt[u] += __expf(cumC[i]);
        recp[0][jj] = pack4(mt);
        f32x4 nn = mma_tt<false, true>(UT, it, BC_row, jt, lane, z);
        nn = mma_tt<true, true>(V_row, it, KC_row, jt, lane, nn);
        recp[1][jj] = pack4(nn);
        if (sto) {
          f32x4 qh = mma_nt<64>(Arb + 16 * it * LDB, LDB, WT + 16 * jt * LDB, LDB, lane, z);
          const u32x2 rv = *(const LAS u32x2*)(R_row + i * LDB + j0);
          qh[0] += bflo(rv.x); qh[1] += bfhi(rv.x); qh[2] += bflo(rv.y); qh[3] += bfhi(rv.y);
          recp[2][jj] = pack4(qh);
          f32x4 yh = mma_nt<64>(Arb + 16 * it * LDB, LDB, UT + 16 * jt * LDB, LDB, lane, z);
          yh = mma_tt<false, true>(Ark, it, V_row, jt, lane, yh);
          recp[3][jj] = pack4(yh);
        }
      }
      {
        const int ro = (16 * it + fr) * 64 + 32 * (jt0 >> 1) + 8 * fq;
        GAS bf16_t* Qg = rw_qrec(p, l, seq, h, chunk);
        u32x4 w;
        w.x = recp[0][0].x; w.y = recp[0][0].y; w.z = recp[0][1].x; w.w = recp[0][1].y; *(GAS u32x4*)(MTg + ro) = w;
        w.x = recp[1][0].x; w.y = recp[1][0].y; w.z = recp[1][1].x; w.w = recp[1][1].y; *(GAS u32x4*)(Ng + ro) = w;
        if (sto) {
          w.x = recp[2][0].x; w.y = recp[2][0].y; w.z = recp[2][1].x; w.w = recp[2][1].y; *(GAS u32x4*)(Qg + ro) = w;
          w.x = recp[3][0].x; w.y = recp[3][0].y; w.z = recp[3][1].x; w.w = recp[3][1].y; *(GAS u32x4*)(Qg + 4096 + ro) = w;
        }
      }
      const bool lastc = samp ? true : (chunk == 64);
      if (h == 0 && lastc) {
        const int lastrow = samp ? (R_SAMP + 16 * sb + 15) : (SEQ * seq + SEQ - 1);
        GAS float* sh = p.out + (samp ? O_SSHIFT : O_PSHIFT) + ((size_t)l * (samp ? SBN : NB) + (samp ? sb : seq)) * ACOLS;
        for (int e = tid; e < ACOLS; e += 512) sh[e] = bf2f(P[(size_t)lastrow * PLD + e]);
      }
    } else {
      {
        const int it = wave >> 1, jt0 = (wave & 1) * 2;
#pragma unroll
        for (int jj = 0; jj < 2; ++jj) {
          const int jt = jt0 + jj, i = 16 * it + fr, j0 = 16 * jt + 4 * fq;
          f32x4 qh = mma_nt<64>(Arb + 16 * it * LDB, LDB, WT + 16 * jt * LDB, LDB, lane, (f32x4){0.f, 0.f, 0.f, 0.f});
          const u32x2 rv = *(const LAS u32x2*)(R_row + i * LDB + j0);
          qh[0] += bflo(rv.x); qh[1] += bfhi(rv.x); qh[2] += bflo(rv.y); qh[3] += bfhi(rv.y);
          *(LAS u32x2*)(R_row + i * LDB + j0) = pack4(qh);
        }
      }
      __syncthreads();
      LAS float* OUTf = F0;
      if (wave < 4) {
        const int it = wave, i = 16 * it + fr;
        f32x4 y[4];
        float s1 = 0.f, s2 = 0.f;
#pragma unroll
        for (int jt = 0; jt < 4; ++jt) {
          f32x4 a = (f32x4){0.f, 0.f, 0.f, 0.f};
#pragma unroll
          for (int s = 0; s < 2; ++s) a = __builtin_amdgcn_mfma_f32_16x16x32_bf16(s0f[jt][s], ldfrag(R_row + (16 * it + fr) * LDB + 32 * s + 8 * fq), a, 0, 0, 0);
          a = mma_nt<64>(Arb + 16 * it * LDB, LDB, UT + 16 * jt * LDB, LDB, lane, a);
          a = mma_sw<64, false, true>(Ark + 16 * it * LDB, LDB, it, VT + 16 * jt * LDB, LDB, jt, lane, a);
          y[jt] = a;
          s1 += a[0] + a[1] + a[2] + a[3];
        }
        s1 += __shfl_xor(s1, 16); s1 += __shfl_xor(s1, 32);
        const float mean = s1 * (1.f / 64.f);
#pragma unroll
        for (int jt = 0; jt < 4; ++jt) { y[jt] = y[jt] - mean; s2 += y[jt][0] * y[jt][0] + y[jt][1] * y[jt][1] + y[jt][2] * y[jt][2] + y[jt][3] * y[jt][3]; }
        s2 += __shfl_xor(s2, 16); s2 += __shfl_xor(s2, 32);
        const float rs = rsqrtf(s2 * (1.f / 64.f) + GN_EPS);
#pragma unroll
        for (int jt = 0; jt < 4; ++jt) *(LAS f32x4*)(OUTf + i * LDF + 16 * jt + 4 * fq) = y[jt] * rs;
      }
      __syncthreads();
      if (t < ntok) {
        const f32x4 y0 = *(const LAS f32x4*)(OUTf + t * LDF + c0), y1 = *(const LAS f32x4*)(OUTf + t * LDF + c0 + 4);
        const u32x4 gw = *(const LAS u32x4*)(Gb + t * LDB + c0);
        const float g[8] = {bflo(gw.x), bfhi(gw.x), bflo(gw.y), bfhi(gw.y), bflo(gw.z), bfhi(gw.z), bflo(gw.w), bfhi(gw.w)};
        const float bon = bonS[t];
        float o[8];
#pragma unroll
        for (int i = 0; i < 8; ++i) {
          const float yn = i < 4 ? y0[i & 3] : y1[i & 3];
          o[i] = (yn * prm[512 + c0 + i] + prm[576 + c0 + i] + bon * vv[i]) * g[i];
        }
        u32x4 w; w.x = pk2(o[0], o[1]); w.y = pk2(o[2], o[3]); w.z = pk2(o[4], o[5]); w.w = pk2(o[6], o[7]);
        *(GAS u32x4*)((GAS bf16_t*)p.out + (size_t)rw_row(seq, chunk, t) * DM + hc0) = w;
      }
    }
    __syncthreads();
  }
}

__device__ __forceinline__ void rwkv_phase_lite(const Ctx p, int l, LAS unsigned char* lds) {
  const int tid0 = opaque_tid(p.wv);
  const int h = p.bid & 7, slot = p.bid >> 3, nslot = p.nblk >> 3;
  constexpr int NK = NB * 65 + SBN;
  constexpr int LDG = 136;
  LAS bf16_t* XG = (LAS bf16_t*)(lds + L_R2) + 128 * LDB;
  LAS float* OUTl = (LAS float*)(lds + L_R3);
  LAS bf16_t* Gb = (LAS bf16_t*)(lds + L_R4);
  LAS float* prm = (LAS float*)(lds + L_PRM);
  if (tid0 < 64) prm[128 + tid0] = p.in[12][(size_t)l * ACOLS + 2 * 512 + h * 64 + tid0];
  else if (tid0 < 128) { const int c = tid0 - 64, hc = l * AW + h * 64 + c; prm[512 + c] = p.in[21][hc]; prm[576 + c] = p.in[22][hc]; }
  float muL[8];
  { const GAS float* mu = p.in[12] + (size_t)l * ACOLS + 1536 + 128 + 8 * (tid0 & 15);
#pragma unroll
    for (int i = 0; i < 8; ++i) muL[i] = mu[i]; }
  const GAS bf16_t* g2T = (const GAS bf16_t*)(p.ws + WS_LORA) + ((size_t)l * AH + h) * 16384 + 8192;
  const GAS bf16_t* P = (const GAS bf16_t*)(p.ws + WS_BIG);
  const GAS float* bonG = (const GAS float*)(p.ws + WS_BONUS);
  const int nmine = (NK - slot + nslot - 1) / nslot;
  u32x4 glc[2], glp[2], vc, vp; float bonp;
#define LITE_PREFETCH(kk, tidx) do { int seq_, chunk_, item_; rw_item_ids<0>(h, (kk), seq_, chunk_, item_); const int ntok_ = (chunk_ == 0) ? 16 : 64; const u32x4 z_ = (u32x4){0u, 0u, 0u, 0u}; \
    _Pragma("unroll") for (int u = 0; u < 2; ++u) { const int t_ = ((tidx) >> 4) + 32 * u; \
      if (t_ < ntok_) { glc[u] = *(const GAS u32x4*)(P + (size_t)rw_row(seq_, chunk_, t_) * PLD + 1536 + 128 + 8 * ((tidx) & 15)); glp[u] = *(const GAS u32x4*)(rw_prev_row(p, l, seq_, chunk_, t_) + 1536 + 128 + 8 * ((tidx) & 15)); } \
      else { glc[u] = z_; glp[u] = z_; } } \
    { const int t2_ = (tidx) >> 3, hc0_ = h * 64 + 8 * ((tidx) & 7); \
      if (t2_ < ntok_) { vc = *(const GAS u32x4*)(P + (size_t)rw_row(seq_, chunk_, t2_) * PLD + 1024 + hc0_); vp = *(const GAS u32x4*)(rw_prev_row(p, l, seq_, chunk_, t2_) + 1024 + hc0_); } else { vc = z_; vp = z_; } \
      bonp = bonG[(size_t)item_ * 64 + t2_]; } } while (0)
  glc[0] = glc[1] = glp[0] = glp[1] = vc = vp = (u32x4){0u, 0u, 0u, 0u}; bonp = 0.f;
  if (nmine > 0) LITE_PREFETCH(slot, tid0);
  bf16x8 fg2[2][4];
  { const int lane0 = tid0 & 63, wave0 = tid0 >> 6, fr0 = lane0 & 15, fq0 = lane0 >> 4, jt00 = (wave0 & 1) * 2;
#pragma unroll
    for (int jj = 0; jj < 2; ++jj)
#pragma unroll
      for (int s2 = 0; s2 < 4; ++s2) fg2[jj][s2] = *(const GAS bf16x8*)(g2T + (16 * (jt00 + jj) + fr0) * 128 + 32 * s2 + 8 * fq0);
  }
  __syncthreads();
#pragma unroll 1
  for (int jj = 0; jj < nmine; ++jj) {
    const int k = slot + jj * nslot;
    int tid = tid0; asm volatile("" : "+v"(tid));
    const int lane = tid & 63, wave = tid >> 6, fr = lane & 15, fq = lane >> 4, t = tid >> 3, c0 = 8 * (tid & 7), hc0 = h * 64 + c0;
    int seq, chunk, item; rw_item_ids<0>(h, k, seq, chunk, item);
    const int ntok = (chunk == 0) ? 16 : 64;
    const int it_ = wave >> 1, jt0_ = (wave & 1) * 2;
    const GAS bf16_t* Qg = rw_qrec(p, l, seq, h, chunk); const GAS bf16_t* Yg = Qg + 4096;
    const GAS bf16_t* S0g = (const GAS bf16_t*)(p.ws + WS_AUX) + (size_t)item * 8192 + 4096;
    bf16x8 s0l[4][2], qhl[2]; u32x2 yhl[4];
    if (wave < 4) {
#pragma unroll
      for (int jt = 0; jt < 4; ++jt)
#pragma unroll
        for (int s2 = 0; s2 < 2; ++s2) s0l[jt][s2] = *(const GAS bf16x8*)(S0g + (16 * jt + fr) * 64 + 32 * s2 + 8 * fq);
#pragma unroll
      for (int s2 = 0; s2 < 2; ++s2) qhl[s2] = *(const GAS bf16x8*)(Qg + (16 * wave + fr) * 64 + 32 * s2 + 8 * fq);
#pragma unroll
      for (int s2 = 0; s2 < 2; ++s2) { const u32x4 d = *(const GAS u32x4*)(Yg + (size_t)(16 * wave + fr) * 64 + 32 * s2 + 8 * fq); yhl[2 * s2].x = d.x; yhl[2 * s2].y = d.y; yhl[2 * s2 + 1].x = d.z; yhl[2 * s2 + 1].y = d.w; }
    }
#pragma unroll
    for (int u = 0; u < 2; ++u) {
      const int tt = (tid >> 4) + 32 * u;
      float cur[8], prv[8], o[8];
      unpack8(glc[u], cur); unpack8(glp[u], prv);
#pragma unroll
      for (int i = 0; i < 8; ++i) { const float pm = cur[i] + (prv[i] - cur[i]) * muL[i]; o[i] = (tt < ntok) ? sigmoidf_(pm) : 0.f; }
      u32x4 w; w.x = pk2(o[0], o[1]); w.y = pk2(o[2], o[3]); w.z = pk2(o[4], o[5]); w.w = pk2(o[6], o[7]);
      *(LAS u32x4*)(XG + tt * LDG + 8 * (tid & 15)) = w;
    }
    float vv2[8]; const float bon2 = bonp;
    {
      float cur[8], prv[8];
      unpack8(vc, cur); unpack8(vp, prv);
#pragma unroll
      for (int i = 0; i < 8; ++i) vv2[i] = cur[i] + (prv[i] - cur[i]) * prm[128 + c0 + i];
    }
    __syncthreads();
    if (jj + 1 < nmine) { int tidp = tid; asm volatile("" : "+v"(tidp)); LITE_PREFETCH(slot + (jj + 1) * nslot, tidp); }
#pragma unroll
    for (int j2 = 0; j2 < 2; ++j2) {
      const int jt = jt0_ + j2;
      f32x4 ag = (f32x4){0.f, 0.f, 0.f, 0.f};
#pragma unroll
      for (int s2 = 0; s2 < 4; ++s2) ag = __builtin_amdgcn_mfma_f32_16x16x32_bf16(fg2[j2][s2], ldfrag(XG + (16 * it_ + fr) * LDG + 32 * s2 + 8 * fq), ag, 0, 0, 0);
      *(LAS u32x2*)(Gb + (16 * it_ + fr) * LDB + 16 * jt + 4 * fq) = pack4(ag);
    }
    if (wave < 4) {
      const int i = 16 * wave + fr;
      f32x4 y[4];
      float s1 = 0.f, s2v = 0.f;
#pragma unroll
      for (int jt = 0; jt < 4; ++jt) {
        const u32x2 yh = yhl[jt];
        f32x4 a = (f32x4){bflo(yh.x), bfhi(yh.x), bflo(yh.y), bfhi(yh.y)};
#pragma unroll
        for (int s2 = 0; s2 < 2; ++s2) a = __builtin_amdgcn_mfma_f32_16x16x32_bf16(s0l[jt][s2], qhl[s2], a, 0, 0, 0);
        y[jt] = a;
        s1 += a[0] + a[1] + a[2] + a[3];
      }
      s1 += __shfl_xor(s1, 16); s1 += __shfl_xor(s1, 32);
      const float mean = s1 * (1.f / 64.f);
#pragma unroll
      for (int jt = 0; jt < 4; ++jt) { y[jt] = y[jt] - mean; s2v += y[jt][0] * y[jt][0] + y[jt][1] * y[jt][1] + y[jt][2] * y[jt][2] + y[jt][3] * y[jt][3]; }
      s2v += __shfl_xor(s2v, 16); s2v += __shfl_xor(s2v, 32);
      const float rs = rsqrtf(s2v * (1.f / 64.f) + GN_EPS);
#pragma unroll
      for (int jt = 0; jt < 4; ++jt) *(LAS f32x4*)(OUTl + i * LDF + 16 * jt + 4 * fq) = y[jt] * rs;
    }
    __syncthreads();
    if (t < ntok) {
      const f32x4 y0 = *(const LAS f32x4*)(OUTl + t * LDF + c0), y1 = *(const LAS f32x4*)(OUTl + t * LDF + c0 + 4);
      float g[8]; unpack8(*(const LAS u32x4*)(Gb + t * LDB + c0), g);
      float o[8];
#pragma unroll
      for (int i = 0; i < 8; ++i) { const float yn = i < 4 ? y0[i & 3] : y1[i & 3]; o[i] = (yn * prm[512 + c0 + i] + prm[576 + c0 + i] + bon2 * vv2[i]) * g[i]; }
      u32x4 w; w.x = pk2(o[0], o[1]); w.y = pk2(o[2], o[3]); w.z = pk2(o[4], o[5]); w.w = pk2(o[6], o[7]);
      *(GAS u32x4*)((GAS bf16_t*)p.out + (size_t)rw_row(seq, chunk, t) * DM + hc0) = w;
    }
    __syncthreads();
  }
#undef LITE_PREFETCH
}

__device__ __forceinline__ void rwkv_scan_chain(const Ctx p, int l, int chain, int vt, int lane, bool dry) {
  const int fr = lane & 15, fq = lane >> 4;
  const bool samp = chain >= 32;
  const int seq = samp ? NB + ((chain - 32) >> 3) : (chain >> 3), h = samp ? ((chain - 32) & 7) : (chain & 7);
  const int nstep = samp ? 1 : 65, item0 = samp ? (RW_NPROMPT + (chain - 32)) : chain * 65;
  f32x4 acc[2][4];
  if (samp) {
#pragma unroll
    for (int u = 0; u < 2; ++u) {
      const GAS float* s0 = p.in[3] + ((((size_t)l * SBN + (seq - NB)) * AH + h) * 64 + 16 * (2 * vt + u) + fr) * 64;
#pragma unroll
      for (int i = 0; i < 4; ++i) acc[u][i] = *(const GAS f32x4*)(s0 + 16 * i + 4 * fq);
    }
  } else {
#pragma unroll
    for (int u = 0; u < 2; ++u)
#pragma unroll
      for (int i = 0; i < 4; ++i) acc[u][i] = (f32x4){0.f, 0.f, 0.f, 0.f};
  }
  GAS bf16_t* base = (GAS bf16_t*)(p.ws + WS_AUX) + (size_t)item0 * 8192;
  bf16x8 am[4][2]; u32x2 nn[2][4];
#pragma unroll
  for (int i = 0; i < 4; ++i) {
#pragma unroll
    for (int s = 0; s < 2; ++s) am[i][s] = *(const GAS bf16x8*)(base + (16 * i + fr) * 64 + 32 * s + 8 * fq);
  }
#pragma unroll
  for (int u = 0; u < 2; ++u)
#pragma unroll
    for (int s = 0; s < 2; ++s) {
      const u32x4 d = *(const GAS u32x4*)(base + 4096 + (16 * (2 * vt + u) + fr) * 64 + 32 * s + 8 * fq);
      nn[u][2 * s].x = d.x; nn[u][2 * s].y = d.y; nn[u][2 * s + 1].x = d.z; nn[u][2 * s + 1].y = d.w;
    }
#pragma unroll 1
  for (int st = 0; st < nstep; ++st) {
    GAS bf16_t* cur = base + (size_t)st * 8192;
    bf16x8 bfr[2][2];
#pragma unroll
    for (int u = 0; u < 2; ++u) {
      u32x2 sp[4];
#pragma unroll
      for (int i = 0; i < 4; ++i) sp[i] = pack4(acc[u][i]);
#pragma unroll
      for (int s = 0; s < 2; ++s) { u32x4 w; w.x = sp[2 * s].x; w.y = sp[2 * s].y; w.z = sp[2 * s + 1].x; w.w = sp[2 * s + 1].y; bfr[u][s] = __builtin_bit_cast(bf16x8, w);
        if (!dry) *(GAS u32x4*)(cur + 4096 + (16 * (2 * vt + u) + fr) * 64 + 32 * s + 8 * fq) = w; }
    }
    f32x4 na[2][4];
#pragma unroll
    for (int u = 0; u < 2; ++u)
#pragma unroll
      for (int i = 0; i < 4; ++i) {
        na[u][i] = (f32x4){bflo(nn[u][i].x), bfhi(nn[u][i].x), bflo(nn[u][i].y), bfhi(nn[u][i].y)};
#pragma unroll
        for (int s = 0; s < 2; ++s) na[u][i] = __builtin_amdgcn_mfma_f32_16x16x32_bf16(am[i][s], bfr[u][s], na[u][i], 0, 0, 0);
      }
    if (st + 1 < nstep) {
      const GAS bf16_t* nx = cur + 8192;
#pragma unroll
      for (int i = 0; i < 4; ++i) {
#pragma unroll
        for (int s = 0; s < 2; ++s) am[i][s] = *(const GAS bf16x8*)(nx + (16 * i + fr) * 64 + 32 * s + 8 * fq);
      }
#pragma unroll
      for (int u = 0; u < 2; ++u)
#pragma unroll
        for (int s = 0; s < 2; ++s) {
          const u32x4 d = *(const GAS u32x4*)(nx + 4096 + (16 * (2 * vt + u) + fr) * 64 + 32 * s + 8 * fq);
          nn[u][2 * s].x = d.x; nn[u][2 * s].y = d.y; nn[u][2 * s + 1].x = d.z; nn[u][2 * s + 1].y = d.w;
        }
    }
#pragma unroll
    for (int u = 0; u < 2; ++u)
#pragma unroll
      for (int i = 0; i < 4; ++i) acc[u][i] = na[u][i];
  }
#pragma unroll
  for (int u = 0; u < 2; ++u) {
    GAS float* so = p.out + (samp ? O_SWKV : O_PWKV) + ((((size_t)l * (samp ? SBN : NB) + (samp ? seq - NB : seq)) * AH + h) * 64 + 16 * (2 * vt + u) + fr) * 64;
#pragma unroll
    for (int i = 0; i < 4; ++i) *(GAS f32x4*)(so + 16 * i + 4 * fq) = acc[u][i];
  }
}

constexpr int ML_QP = 136;
constexpr int ML_TP = 72;
constexpr int ML_HP = 132;
constexpr int M_Q = 0, M_K = M_Q + 64 * ML_QP * 2, M_KT = M_K + 64 * ML_QP * 2, M_VT = M_KT + 128 * ML_TP * 2, M_VS = M_VT + 128 * ML_TP * 2;
constexpr int M_S = M_VS + 128 * ML_TP * 2, M_H = M_S + 64 * LDB * 2, M_SC = M_H + 64 * ML_HP * 4;
constexpr int M_CW = M_SC + (64 * 6 + 256 + 512 + 128 + 16 + 128) * 4;
constexpr int M_END = M_CW + (5 * 256 + 128) * 4;
static_assert(M_END <= 163824, "mlstm LDS");
constexpr size_t AGG_BYTES = 128 * 128 * 2 + 128 * 4 + 256;
constexpr int ML_NG = 14;
__device__ __forceinline__ int ml_gstart(int g) { return g == 0 ? 0 : (g < 9 ? 4 + 5 * (g - 1) : 44 + 4 * (g - 9)); }
__device__ __forceinline__ int ml_glen(int g) { return (g >= 1 && g < 9) ? 5 : 4; }
constexpr size_t WS_AGG_OFF = (size_t)2208 * 16384;
static_assert(AGG_BYTES == 33536 && ML_NG == 14, "WS_BONUS assumes 208 aggregate records of 33536 bytes");
constexpr int ML_NP1 = NB * BH * (ML_NG - 1), ML_NP3 = NB * BH * ML_NG + SBN * BH;

__device__ __forceinline__ int ml_row(int seq, int tau) {
  if (seq < NB) return tau < 16 ? (R_META + 16 * seq + tau) : (SEQ * seq + tau - 16);
  return R_SAMP + 16 * (seq - NB) + tau;
}

struct MlPref { u32x4 xr[7]; u32x4 vq[4]; u32x4 og[2]; float gi, gf; };
__device__ __forceinline__ void ml_chunk_range(bool samp, int grp, int ci, int& tau0, int& ntok) {
  if (samp) { tau0 = 0; ntok = 16; }
  else if (grp == 0) { if (ci == 0) { tau0 = 0; ntok = 16; } else { tau0 = 16 + 64 * (ci - 1); ntok = 64; } }
  else { tau0 = 16 + 64 * (ml_gstart(grp) + ci); ntok = 64; }
}
template <int MODE>
__device__ __forceinline__ void ml_prefetch(const Ctx p, int l, int seq, int hd, int grp, int ci, int tid, MlPref& pf) {
  const bool samp = seq >= NB; const int sb = seq - NB;
  int tau0, ntok; ml_chunk_range(samp, grp, ci, tau0, ntok);
  const GAS bf16_t* P = (const GAS bf16_t*)(p.ws + WS_BIG);
  const int MB = ACOLS;
  const u32x4 z = (u32x4){0u, 0u, 0u, 0u};
  const int cgp = tid & 31, run = tid >> 5, part = cgp >> 4, cc = (cgp & 15) * 8;
  if (MODE == 1 || part == 1) {
    const int cwi = part * 512 + hd * 128 + cc, col = MB + cwi;
#pragma unroll
    for (int rr = 0; rr < 7; ++rr) {
      const int tl = 4 * run + rr - 3, tau = tau0 + tl;
      if (tl >= ntok) pf.xr[rr] = z;
      else if (tau >= 0) pf.xr[rr] = *(const u32x4*)(P + (size_t)ml_row(seq, tau) * PLD + col);
      else if (samp) pf.xr[rr] = *(const u32x4*)((const GAS bf16_t*)(p.ws + WS_CONVB) + (((size_t)l * SBN + sb) * 3 + (3 + tau)) * 1024 + cwi);
      else pf.xr[rr] = z;
    }
  }
  if (tid < 256) {
    const int eg = tid & 15, rn = tid >> 4, e0 = eg * 8;
#pragma unroll
    for (int tt = 0; tt < 4; ++tt) { const int tl = 4 * rn + tt; pf.vq[tt] = (tl < ntok) ? *(const u32x4*)(P + (size_t)ml_row(seq, tau0 + tl) * PLD + MB + 1024 + hd * 128 + e0) : z; }
  }
  if (MODE == 1) {
    const int t = tid >> 3, e0 = (tid & 7) * 16;
    if (t < ntok) { const GAS bf16_t* q = P + (size_t)ml_row(seq, tau0 + t) * PLD + MB + 1536 + hd * 128 + e0; pf.og[0] = *(const u32x4*)q; pf.og[1] = *(const u32x4*)(q + 8); }
    else { pf.og[0] = z; pf.og[1] = z; }
  }
  {
    const int t = tid & 63;
    if (t < ntok) { const size_t rb = (size_t)ml_row(seq, tau0 + t) * PLD + MB + 2048; pf.gi = bf2f(P[rb + hd]); pf.gf = bf2f(P[rb + 4 + hd]); }
    else { pf.gi = 0.f; pf.gf = 0.f; }
  }
}

__device__ __forceinline__ int ml_pos(int d) { return (d & ~31) + 8 * ((d & 15) >> 2) + 4 * ((d >> 4) & 1) + (d & 3); }
template <int MODE>
__device__ __forceinline__ void mlstm_group_item(const Ctx p, int l, int item, LAS unsigned char* lds) {
  const int tid0 = opaque_tid(p.wv);
  int seq, hd, grp;
  if (MODE == 0) { grp = item % (ML_NG - 1); const int sh = item / (ML_NG - 1); hd = sh & 3; seq = sh >> 2; }
  else if (item < NB * BH * ML_NG) { grp = item % ML_NG; const int sh = item / ML_NG; hd = sh & 3; seq = sh >> 2; }
  else { const int r = item - NB * BH * ML_NG; grp = 0; hd = r & 3; seq = NB + (r >> 2); }
  const bool samp = seq >= NB; const int sb = seq - NB;
  const GAS bf16_t* P = (const GAS bf16_t*)(p.ws + WS_BIG);
  LAS bf16_t* Qs = (LAS bf16_t*)(lds + M_Q); LAS bf16_t* Ks = (LAS bf16_t*)(lds + M_K); LAS bf16_t* KT = (LAS bf16_t*)(lds + M_KT);
  LAS bf16_t* VT = (LAS bf16_t*)(lds + M_VT); LAS bf16_t* VS = (LAS bf16_t*)(lds + M_VS); LAS bf16_t* Sb = (LAS bf16_t*)(lds + M_S);
  LAS float* Hf = (LAS float*)(lds + M_H);
  LAS float* aj = (LAS float*)(lds + M_SC); LAS float* At = aj + 64; LAS float* wo = At + 64; LAS float* wsv = wo + 64; LAS float* emt = wsv + 64; LAS float* qn = emt + 64;
  LAS float* rsum = qn + 64; LAS float* part = rsum + 256; LAS float* nvec = part + 512;
  LAS float* cwl = (LAS float*)(lds + M_CW);
  GAS unsigned char* agg = p.ws + WS_AUX + WS_AGG_OFF;
  const int MB = ACOLS;
  const float ib = p.in[25][l * BH + hd], fb = p.in[26][l * BH + hd];
  {
    const int wave0 = tid0 >> 6, lane0 = tid0 & 63, fr0 = lane0 & 15, fq0 = lane0 >> 4;
    (void)wave0; (void)fr0; (void)fq0;
    if (tid0 < 256) {
      const int cwi = (tid0 >> 7) * 512 + hd * 128 + (tid0 & 127);
      const GAS float* cw = p.in[23] + (size_t)l * 4 * 1024 + cwi;
      cwl[tid0] = cw[0]; cwl[256 + tid0] = cw[1024]; cwl[512 + tid0] = cw[2048]; cwl[768 + tid0] = cw[3072]; cwl[1024 + tid0] = p.in[24][(size_t)l * 1024 + cwi];
    }
    else if (MODE == 1 && tid0 < 384) cwl[1280 + (tid0 - 256)] = p.in[27][l * 512 + hd * 128 + (tid0 - 256)];
  }
  f32x4 C[8];
#pragma unroll
  for (int i = 0; i < 8; ++i) C[i] = (f32x4){0.f, 0.f, 0.f, 0.f};
  float m = 0.f;
  {
    const int wave = tid0 >> 6, lane = tid0 & 63, fr = lane & 15, fq = lane >> 4;
    if (MODE == 0) { m = -1e30f; if (tid0 < 128) nvec[tid0] = 0.f; }
    else if (samp) {
      const GAS float* c0 = p.in[5] + (((size_t)l * SBN + sb) * BH + hd) * 128 * 128;
#pragma unroll
      for (int i = 0; i < 8; ++i)
#pragma unroll
        for (int r = 0; r < 4; ++r) C[i][r] = c0[(size_t)(16 * i + 4 * fq + r) * 128 + 16 * wave + fr];
      if (tid0 < 128) nvec[ml_pos(tid0)] = p.in[6][(((size_t)l * SBN + sb) * BH + hd) * 128 + tid0];
      m = p.in[7][((size_t)l * SBN + sb) * BH + hd];
    } else {
      float wgt[ML_NG - 1]; float nreg = 0.f;
      {
        float fm = 0.f;
        float am[ML_NG - 1], bmv[ML_NG - 1];
#pragma unroll
        for (int g2 = 0; g2 < ML_NG - 1; ++g2) { const GAS float* sc = (const GAS float*)(agg + ((size_t)((seq * BH + hd) * (ML_NG - 1) + g2)) * AGG_BYTES + 32768 + 512); am[g2] = g2 < grp ? sc[0] : 0.f; bmv[g2] = g2 < grp ? sc[1] : -1e30f; }
#pragma unroll
        for (int g2 = 0; g2 < ML_NG - 1; ++g2) wgt[g2] = 0.f;
#pragma unroll
        for (int g2 = 0; g2 < ML_NG - 1; ++g2) {
          if (g2 < grp) {
            const float me = fmaxf(fm + am[g2], bmv[g2]), f1 = __expf(fm + am[g2] - me), f2 = __expf(bmv[g2] - me);
#pragma unroll
            for (int g3 = 0; g3 < ML_NG - 1; ++g3) if (g3 < g2) wgt[g3] *= f1;
            wgt[g2] = f2; fm = me;
          }
        }
        m = fm;
      }
#pragma unroll
      for (int g2 = 0; g2 < ML_NG - 1; ++g2) {
        if (g2 < grp) {
          const GAS unsigned char* rec = agg + ((size_t)((seq * BH + hd) * (ML_NG - 1) + g2)) * AGG_BYTES;
#pragma unroll
          for (int ip = 0; ip < 4; ++ip) {
            const u32x4 d = *(const GAS u32x4*)((const GAS bf16_t*)rec + (size_t)((wave * 4 + ip) * 64 + lane) * 8);
            C[2 * ip] += (f32x4){bflo(d.x), bfhi(d.x), bflo(d.y), bfhi(d.y)} * wgt[g2];
            C[2 * ip + 1] += (f32x4){bflo(d.z), bfhi(d.z), bflo(d.w), bfhi(d.w)} * wgt[g2];
          }
          if (tid0 < 128) nreg += ((const GAS float*)(rec + 32768))[tid0] * wgt[g2];
        }
      }
      if (tid0 < 128) nvec[ml_pos(tid0)] = nreg;
    }
  }
  float asum = 0.f;
  const int nchunk = samp ? 1 : ((grp == 0) ? 1 + ml_glen(0) : ml_glen(grp));
  MlPref pf;
  ml_prefetch<MODE>(p, l, seq, hd, grp, 0, tid0, pf);
  __syncthreads();
#pragma unroll 1
  for (int ci = 0; ci < nchunk; ++ci) {
    int tid = tid0; asm volatile("" : "+v"(tid));
    const int lane = tid & 63, wave = tid >> 6, fr = lane & 15, fq = lane >> 4;
    int tau0, ntok; ml_chunk_range(samp, grp, ci, tau0, ntok);
    float s_ws, dec, mnew;
    {
      const bool valid = lane < ntok;
      const float li = valid ? pf.gi + ib : -1e30f;
      const float lf = valid ? -softplusf_(-(pf.gf + fb)) : 0.f;
      float b = lf;
#pragma unroll
      for (int o = 1; o < 64; o <<= 1) { const float v = __shfl_up(b, o); if (lane >= o) b += v; }
      const float a = li - b;
      float A = fmaxf(a, m);
#pragma unroll
      for (int o = 1; o < 64; o <<= 1) { const float v = __shfl_up(A, o); if (lane >= o) A = fmaxf(A, v); }
      const float AL = __shfl(A, 63), bL = __shfl(b, 63);
      s_ws = __expf(a - AL);
      dec = __expf(m - AL); mnew = bL + AL; asum += bL;
      if (wave == 0) { aj[lane] = a; At[lane] = A; wo[lane] = __expf(m - A); wsv[lane] = s_ws; emt[lane] = __expf(-(b + A)); }
    }
    {
      const int cgp = tid & 31, run = tid >> 5, part2 = cgp >> 4, cc = (cgp & 15) * 8;
      if (MODE == 1 || part2 == 1) {
        unsigned wq[4][4];
#pragma unroll
        for (int i2 = 0; i2 < 4; ++i2) {
          float oc[2][4];
#pragma unroll
          for (int hlf = 0; hlf < 2; ++hlf) {
            const int i = 2 * i2 + hlf, wcol = part2 * 128 + cc + i;
            const float w0 = cwl[wcol], w1 = cwl[256 + wcol], w2 = cwl[512 + wcol], w3 = cwl[768 + wcol], bb = cwl[1024 + wcol];
            float xv[7];
#pragma unroll
            for (int rr = 0; rr < 7; ++rr) { const unsigned wd = pf.xr[rr][i2]; xv[rr] = hlf ? bfhi(wd) : bflo(wd); }
#pragma unroll
            for (int tt = 0; tt < 4; ++tt) {
              float val = w0 * xv[tt] + w1 * xv[tt + 1] + w2 * xv[tt + 2] + w3 * xv[tt + 3] + bb;
              val = siluf_(val);
              if (part2 == 1) val *= 0.08838834764831845f;
              if (4 * run + tt >= ntok) val = 0.f;
              oc[hlf][tt] = val;
            }
            if (part2 == 1) { u32x2 w; w.x = pk2(oc[hlf][0], oc[hlf][1]); w.y = pk2(oc[hlf][2], oc[hlf][3]); *(LAS u32x2*)(KT + (cc + i) * ML_TP + ((((run >> 1) ^ (cgp & 7)) << 3) | ((run & 1) << 2))) = w; }
          }
#pragma unroll
          for (int tt = 0; tt < 4; ++tt) wq[tt][i2] = pk2(oc[0][tt], oc[1][tt]);
        }
        const int s32 = cc >> 5, hh = (cc >> 4) & 1, qq = (cc & 15) >> 2;
        LAS bf16_t* dst = (part2 == 0 ? Qs : Ks);
#pragma unroll
        for (int tt = 0; tt < 4; ++tt) {
          u32x2 w0; w0.x = wq[tt][0]; w0.y = wq[tt][1];
          u32x2 w1; w1.x = wq[tt][2]; w1.y = wq[tt][3];
          *(LAS u32x2*)(dst + (4 * run + tt) * ML_QP + 32 * s32 + 8 * qq + 4 * hh) = w0;
          *(LAS u32x2*)(dst + (4 * run + tt) * ML_QP + 32 * s32 + 8 * (qq + 1) + 4 * hh) = w1;
        }
      }
      {
        const int eg = tid & 15, rn = (tid >> 4) & 15, e0 = eg * 8;
        const float w40 = __shfl(s_ws, 4 * rn), w41 = __shfl(s_ws, 4 * rn + 1), w42 = __shfl(s_ws, 4 * rn + 2), w43 = __shfl(s_ws, 4 * rn + 3);
        const int vso = (((rn >> 1) ^ (eg & 7)) << 3) | ((rn & 1) << 2);
        if (tid < 256) {
#pragma unroll
          for (int i2 = 0; i2 < 4; ++i2) {
#pragma unroll
            for (int hlf = 0; hlf < 2; ++hlf) {
              const int i = 2 * i2 + hlf;
              float v0 = hlf ? bfhi(pf.vq[0][i2]) : bflo(pf.vq[0][i2]), v1 = hlf ? bfhi(pf.vq[1][i2]) : bflo(pf.vq[1][i2]);
              float v2 = hlf ? bfhi(pf.vq[2][i2]) : bflo(pf.vq[2][i2]), v3 = hlf ? bfhi(pf.vq[3][i2]) : bflo(pf.vq[3][i2]);
              u32x2 w; w.x = pk2(v0, v1); w.y = pk2(v2, v3); *(LAS u32x2*)(VT + (e0 + i) * ML_TP + vso) = w;
              u32x2 ws2; ws2.x = pk2(v0 * w40, v1 * w41); ws2.y = pk2(v2 * w42, v3 * w43); *(LAS u32x2*)(VS + (e0 + i) * ML_TP + vso) = ws2;
            }
          }
        }
      }
    }
    const u32x4 og0 = pf.og[0], og1 = pf.og[1];
    if (ci + 1 < nchunk) { int tidp = tid0; asm volatile("" : "+v"(tidp)); ml_prefetch<MODE>(p, l, seq, hd, grp, ci + 1, tidp, pf); }
    __syncthreads();
    if (MODE == 1) {
      {
        const int it = wave >> 1, jt0 = (wave & 1) * 2;
        float rs = 0.f;
#pragma unroll
        for (int jj = 0; jj < 2; ++jj) {
          const int jt = jt0 + jj, i = 16 * it + fr, j0 = 16 * jt + 4 * fq;
          f32x4 sc = (f32x4){0.f, 0.f, 0.f, 0.f};
          if (jt <= it) {
            sc = mma_nt<128>(Qs + 16 * it * ML_QP, ML_QP, Ks + 16 * jt * ML_QP, ML_QP, lane, sc);
            const f32x4 a4 = *(const LAS f32x4*)(aj + j0); const float Ai = At[i];
#pragma unroll
            for (int u = 0; u < 4; ++u) { sc[u] = (j0 + u <= i) ? sc[u] * __expf(a4[u] - Ai) : 0.f; rs += sc[u]; }
          }
          *(LAS u32x2*)(Sb + i * LDB + j0) = pack4(sc);
        }
        rs += __shfl_xor(rs, 16); rs += __shfl_xor(rs, 32);
        if (fq == 0) rsum[(16 * it + fr) * 4 + (wave & 1)] = rs;
      }
      {
        const int t = tid >> 3, d0 = (tid & 7) * 16;
        float s = 0.f;
#pragma unroll
        for (int u = 0; u < 2; ++u) {
          float qv[8]; unpack8(*(const LAS u32x4*)(Qs + t * ML_QP + d0 + 8 * u), qv);
          { const f32x4 n0 = *(const LAS f32x4*)(nvec + d0 + 8 * u), n1 = *(const LAS f32x4*)(nvec + d0 + 8 * u + 4);
            s += qv[0] * n0[0] + qv[1] * n0[1] + qv[2] * n0[2] + qv[3] * n0[3] + qv[4] * n1[0] + qv[5] * n1[1] + qv[6] * n1[2] + qv[7] * n1[3]; }
        }
        s += __shfl_xor(s, 1); s += __shfl_xor(s, 2); s += __shfl_xor(s, 4);
        if ((tid & 7) == 0) qn[t] = s;
      }
      __syncthreads();
      {
        bf16x8 cf[4];
#pragma unroll
        for (int s = 0; s < 4; ++s) { const u32x2 lo = pack4(C[2 * s]), hi = pack4(C[2 * s + 1]); u32x4 w; w.x = lo.x; w.y = lo.y; w.z = hi.x; w.w = hi.y; cf[s] = __builtin_bit_cast(bf16x8, w); }
        float p2[4][4];
#pragma unroll
        for (int it = 0; it < 4; ++it) {
          f32x4 acc = (f32x4){0.f, 0.f, 0.f, 0.f};
#pragma unroll
          for (int s = 0; s < 4; ++s) acc = __builtin_amdgcn_mfma_f32_16x16x32_bf16(ldfrag(Qs + (16 * it + fr) * ML_QP + 32 * s + 8 * fq), cf[s], acc, 0, 0, 0);
          const f32x4 w4 = *(const LAS f32x4*)(wo + 16 * it + 4 * fq);
          acc = acc * w4;
#pragma unroll
          for (int s = 0; s < 2; ++s) acc = __builtin_amdgcn_mfma_f32_16x16x32_bf16(ldfrag(Sb + (16 * it + fr) * LDB + 32 * s + 8 * fq), ldfrag(VT + (16 * wave + fr) * ML_TP + 8 * ((4 * s + fq) ^ ((2 * wave + (fr >> 3)) & 7))), acc, 0, 0, 0);
#pragma unroll
          for (int r = 0; r < 4; ++r) {
            const int t = 16 * it + 4 * fq + r;
            const float den = wo[t] * qn[t] + rsum[t * 4] + rsum[t * 4 + 1];
            const float hv = acc[r] * __builtin_amdgcn_rcpf(fmaxf(fabsf(den), emt[t]));
            Hf[t * ML_HP + 16 * wave + fr] = hv;
            float sq = hv * hv;
            sq += __shfl_xor(sq, 1); sq += __shfl_xor(sq, 2); sq += __shfl_xor(sq, 4); sq += __shfl_xor(sq, 8);
            p2[it][r] = sq;
          }
        }
        if (fr == 0) {
#pragma unroll
          for (int it = 0; it < 4; ++it)
#pragma unroll
            for (int r = 0; r < 4; ++r) part[(16 * it + 4 * fq + r) * 8 + wave] = p2[it][r];
        }
      }
    }
    {
#pragma unroll
      for (int i = 0; i < 8; ++i) {
        f32x4 acc = C[i] * dec;
#pragma unroll
        for (int s = 0; s < 2; ++s) acc = __builtin_amdgcn_mfma_f32_16x16x32_bf16(ldfrag(KT + (16 * i + fr) * ML_TP + 8 * ((4 * s + fq) ^ ((2 * i + (fr >> 3)) & 7))), ldfrag(VS + (16 * wave + fr) * ML_TP + 8 * ((4 * s + fq) ^ ((2 * wave + (fr >> 3)) & 7))), acc, 0, 0, 0);
        C[i] = acc;
      }
    }
    __syncthreads();
    {
      f32x4 acc = (f32x4){0.f, 0.f, 0.f, 0.f};
#pragma unroll
      for (int s2 = 0; s2 < 2; ++s2) {
        bf16x8 wb;
        { const f32x4 a0 = *(const LAS f32x4*)(wsv + 32 * s2 + 8 * fq), a1 = *(const LAS f32x4*)(wsv + 32 * s2 + 8 * fq + 4);
          u32x4 w; w.x = pk2(a0[0], a0[1]); w.y = pk2(a0[2], a0[3]); w.z = pk2(a1[0], a1[1]); w.w = pk2(a1[2], a1[3]);
          if (fr != 0) w = (u32x4){0u, 0u, 0u, 0u};
          wb = __builtin_bit_cast(bf16x8, w); }
        acc = __builtin_amdgcn_mfma_f32_16x16x32_bf16(ldfrag(KT + (16 * wave + fr) * ML_TP + 8 * ((4 * s2 + fq) ^ ((2 * wave + (fr >> 3)) & 7))), wb, acc, 0, 0, 0);
      }
      if (fr == 0) {
        LAS float* np = nvec + 32 * (wave >> 1) + 8 * fq + 4 * (wave & 1);
        const f32x4 old = *(const LAS f32x4*)np;
        *(LAS f32x4*)np = old * dec + acc;
      }
    }
    if (MODE == 1) {
      const int t = tid >> 3, e0 = (tid & 7) * 16;
      if (t < ntok) {
        float ps = 0.f;
#pragma unroll
        for (int w = 0; w < 8; ++w) ps += part[t * 8 + w];
        const float rs = rsqrtf(ps * (1.f / 128.f) + RMS_EPS);
        const size_t row = (size_t)ml_row(seq, tau0 + t);
        float og[16]; unpack8(og0, og); unpack8(og1, og + 8);
        float o[16];
#pragma unroll
        for (int i = 0; i < 16; ++i) o[i] = Hf[t * ML_HP + e0 + i] * rs * cwl[1280 + e0 + i] * sigmoidf_(og[i]);
        u32x4 w; w.x = pk2(o[0], o[1]); w.y = pk2(o[2], o[3]); w.z = pk2(o[4], o[5]); w.w = pk2(o[6], o[7]);
        GAS bf16_t* mx = (GAS bf16_t*)p.out + row * DM + 512 + hd * 128 + e0;
        *(u32x4*)mx = w;
        w.x = pk2(o[8], o[9]); w.y = pk2(o[10], o[11]); w.z = pk2(o[12], o[13]); w.w = pk2(o[14], o[15]);
        *(u32x4*)(mx + 8) = w;
      }
    }
    m = mnew;
    __syncthreads();
  }
  {
    const int tid = tid0, lane = tid & 63, wave = tid >> 6, fr = lane & 15, fq = lane >> 4;
    if (MODE == 0) {
      GAS unsigned char* rec = agg + ((size_t)((seq * BH + hd) * (ML_NG - 1) + grp)) * AGG_BYTES;
#pragma unroll
      for (int ip = 0; ip < 4; ++ip) { const u32x2 a = pack4(C[2 * ip]), b = pack4(C[2 * ip + 1]); u32x4 w; w.x = a.x; w.y = a.y; w.z = b.x; w.w = b.y; *(GAS u32x4*)((GAS bf16_t*)rec + (size_t)((wave * 4 + ip) * 64 + lane) * 8) = w; }
      if (tid < 128) ((GAS float*)(rec + 32768))[tid] = nvec[ml_pos(tid)];
      if (tid == 0) { ((GAS float*)(rec + 32768 + 512))[0] = asum; ((GAS float*)(rec + 32768 + 512))[1] = m; }
    } else if (samp || grp == ML_NG - 1) {
      const int nb_ = samp ? SBN : NB, bi = samp ? sb : seq;
      GAS float* co = p.out + (samp ? O_SC : O_PC) + (((size_t)l * nb_ + bi) * BH + hd) * 128 * 128;
#pragma unroll
      for (int i = 0; i < 8; ++i)
#pragma unroll
        for (int r = 0; r < 4; ++r) co[(size_t)(16 * i + 4 * fq + r) * 128 + 16 * wave + fr] = C[i][r];
      if (tid < 128) p.out[(samp ? O_SN : O_PN) + (((size_t)l * nb_ + bi) * BH + hd) * 128 + tid] = nvec[ml_pos(tid)];
      if (tid == 0) p.out[(samp ? O_SM : O_PM) + ((size_t)l * nb_ + bi) * BH + hd] = m;
      if (tid < 256) {
        const int cwi = (tid >> 7) * 512 + hd * 128 + (tid & 127);
        GAS float* cvo = p.out + (samp ? O_SCONV : O_PCONV) + ((size_t)l * nb_ + bi) * 3 * 1024;
        const int last = samp ? 15 : (TP - 1);
#pragma unroll
        for (int j = 0; j < 3; ++j) cvo[j * 1024 + cwi] = bf2f(P[(size_t)ml_row(seq, last - 2 + j) * PLD + MB + cwi]);
      }
    }
  }
  __syncthreads();
}


__device__ __forceinline__ void gates_pass(const Ctx p, int l, unsigned* flag, unsigned need) {
  const int tid = opaque_tid(p.wv), lane = tid & 63, wave = tid >> 6, fr = lane & 15, fq = lane >> 4;
  const int blk = p.bid * 8 + wave;
  if (blk >= R_TOT / 16) return;
  if (blk >= R_SAMP / 16 && need) {
    unsigned sp = 0;
    while ((unsigned)__builtin_amdgcn_readfirstlane(__hip_atomic_load(flag, __ATOMIC_RELAXED, __HIP_MEMORY_SCOPE_AGENT)) < need) { __builtin_amdgcn_s_sleep(2); if (++sp > (1u << 22)) break; }
    __builtin_amdgcn_fence(__ATOMIC_ACQUIRE, "agent");
  }
  const GAS bf16_t* X = (const GAS bf16_t*)(p.ws + WS_XB0) + (size_t)(16 * blk + fr) * DM + 8 * fq;
  const GAS bf16_t* W = (const GAS bf16_t*)(p.ws + WS_WIN) + ((size_t)l * NINP + 3840 + fr) * DM + 8 * fq;
  f32x4 acc = (f32x4){0.f, 0.f, 0.f, 0.f};
#pragma unroll 8
  for (int s = 0; s < DM / 32; ++s) acc = __builtin_amdgcn_mfma_f32_16x16x32_bf16(*(const GAS bf16x8*)(W + 32 * s), *(const GAS bf16x8*)(X + 32 * s), acc, 0, 0, 0);
  if (fq < 2) {
    const int row = 16 * blk + fr;
    const float rs = row_rstd((const GAS float*)(p.ws + WS_SS) + (size_t)(2 * l) * MPAD * 4, row);
    *(GAS u32x2*)((GAS bf16_t*)(p.ws + WS_BIG) + (size_t)row * PLD + 3840 + 4 * fq) = pack4(acc * rs);
  }
}


constexpr int XF_FLAG0 = 3520;
template <bool FINAL>
__device__ __forceinline__ void convert_special(const Ctx p, const GAS float* slab, int nsl, const GAS bf16_t* Xin, GAS bf16_t* Xout, GAS float* ssd, unsigned* flag, const GAS float* nf) {
  const int tid = opaque_tid(p.wv), lane = tid & 63, wave = tid >> 6;
  const int w16 = p.bid - (p.nblk - 16);
#pragma unroll 1
  for (int q = 0; q < 4; ++q) {
    const int r2 = 32 * w16 + 4 * wave + q, row = R_SAMP + r2, tm = r2 >> 8, rin = r2 & 255;
    f32x4 v[4]; float s = 0.f;
#pragma unroll
    for (int j = 0; j < 4; ++j) {
      const u32x2 xi = *(const GAS u32x2*)(Xin + (size_t)row * DM + 256 * j + 4 * lane);
      f32x4 a = (f32x4){bflo(xi.x), bfhi(xi.x), bflo(xi.y), bfhi(xi.y)};
      for (int sl = 0; sl < nsl; ++sl) a += *(const GAS f32x4*)(slab + ((size_t)((tm * 4 + j) * nsl + sl) * 256 + rin) * 256 + 4 * lane);
      v[j] = a; s += a[0] * a[0] + a[1] * a[1] + a[2] * a[2] + a[3] * a[3];
    }
    s = wave_sum(s);
    if (FINAL) {
      const float rs = rsqrtf(s * (1.f / DM) + RMS_EPS);
      if (row < R_META) {
        GAS float* y = p.out + (size_t)row * DM;
#pragma unroll
        for (int j = 0; j < 4; ++j) { const f32x4 g = *(const GAS f32x4*)(nf + 256 * j + 4 * lane); *(GAS f32x4*)(y + 256 * j + 4 * lane) = v[j] * rs * g; }
      }
    } else {
#pragma unroll
      for (int j = 0; j < 4; ++j) {
        u32x2 w; w.x = pk2(v[j][0], v[j][1]); w.y = pk2(v[j][2], v[j][3]);
        *(GAS u32x2*)(Xout + (size_t)row * DM + 256 * j + 4 * lane) = w;
      }
      if (lane == 0) *(GAS f32x4*)(ssd + (size_t)row * 4) = (f32x4){s, 0.f, 0.f, 0.f};
    }
  }
  if (!FINAL) {
    asm volatile("s_waitcnt vmcnt(0)" ::: "memory");
    __syncthreads();
    if (tid == 0) {
      __builtin_amdgcn_fence(__ATOMIC_RELEASE, "agent");
      asm volatile("s_waitcnt vmcnt(0)" ::: "memory");
      __hip_atomic_fetch_add(flag, 1u, __ATOMIC_RELAXED, __HIP_MEMORY_SCOPE_AGENT);
    }
  }
}

__device__ __forceinline__ int prev_row(int r, int d) {
  if (r < R_MAIN) { const int t = r & (SEQ - 1), b = r >> 12; return t >= d ? r - d : (R_META + 16 * b + 16 + (t - d)); }
  if (r < R_META) { const int t = (r - R_SAMP) & 15; return t >= d ? r - d : (-2 - (2 + (t - d))); }
  { const int t = (r - R_META) & 15; return t >= d ? r - d : -1; }
}
__device__ __forceinline__ void ffn_conv8(const float* u0, const float* u1, const float* u2, const float* gt, const GAS float* cw, const GAS float* cb, int ff, GAS bf16_t* dst) {
  float o[8];
#pragma unroll
  for (int i = 0; i < 8; ++i) { const float val = cw[ff + i] * u2[i] + cw[DFF + ff + i] * u1[i] + cw[2 * DFF + ff + i] * u0[i] + cb[ff + i]; o[i] = siluf_(val) * gt[i]; }
  u32x4 w; w.x = pk2(o[0], o[1]); w.y = pk2(o[2], o[3]); w.z = pk2(o[4], o[5]); w.w = pk2(o[6], o[7]);
  *(GAS u32x4*)dst = w;
}
__device__ __forceinline__ void phase_ffn_fixup(const Ctx p, int l) {
  GAS bf16_t* G = (GAS bf16_t*)(p.ws + WS_BIG);
  const GAS bf16_t* UH = G + pg8::FS_UH; const GAS bf16_t* UD = G + pg8::FS_UD; const GAS bf16_t* GD = G + pg8::FS_GD; const GAS bf16_t* US = G + pg8::FS_US; const GAS bf16_t* GS = G + pg8::FS_GS;
  const GAS float* cw = p.in[31] + (size_t)l * 3 * DFF; const GAS float* cb = p.in[32] + (size_t)l * DFF;
  constexpr int NA = 256 * 2 * 352, NBS = 320 * 352, NC = (NB + SBN) * 2 * 352;
  for (int idx = p.bid * 512 + opaque_tid(p.wv); idx < NA + NBS + NC; idx += p.nblk * 512) {
    float u0[8], u1[8], u2[8], gt[8];
    if (idx < NA) {
      const int s = idx / 704, rem = idx - s * 704, j = rem / 352, c0 = (rem - j * 352) * 8;
      load8(UD + ((size_t)s * 2 + j) * DFF + c0, u0); load8(GD + ((size_t)s * 2 + j) * DFF + c0, gt);
      const GAS bf16_t* h1; const GAS bf16_t* h2;
      if ((s & 63) == 0) { const int b = s >> 6; h1 = US + (size_t)(256 + 16 * b + 15) * DFF; h2 = US + (size_t)(256 + 16 * b + 14) * DFF; }
      else { h1 = UH + ((size_t)(s - 1) * 2 + 1) * DFF; h2 = UH + ((size_t)(s - 1) * 2) * DFF; }
      if (j == 0) { load8(h1 + c0, u1); load8(h2 + c0, u2); }
      else { load8(UD + ((size_t)s * 2) * DFF + c0, u1); load8(h1 + c0, u2); }
      ffn_conv8(u0, u1, u2, gt, cw, cb, c0, G + (size_t)(64 * s + j) * DFF + c0);
    } else if (idx < NA + NBS) {
      const int k = idx - NA, r2 = k / 352, c0 = (k - r2 * 352) * 8, t = r2 & 15;
      const bool samp = r2 < 256;
      load8(US + (size_t)r2 * DFF + c0, u0); load8(GS + (size_t)r2 * DFF + c0, gt);
#pragma unroll
      for (int d = 1; d <= 2; ++d) {
        float* dstv = d == 1 ? u1 : u2;
        if (t >= d) load8(US + (size_t)(r2 - d) * DFF + c0, dstv);
        else if (samp) { const GAS float* st = p.in[8] + (((size_t)l * SBN + (r2 >> 4)) * 2 + (2 + (t - d))) * DFF + c0;
#pragma unroll
          for (int i = 0; i < 8; ++i) dstv[i] = st[i]; }
        else {
#pragma unroll
          for (int i = 0; i < 8; ++i) dstv[i] = 0.f; }
      }
      ffn_conv8(u0, u1, u2, gt, cw, cb, c0, G + (size_t)(R_SAMP + r2) * DFF + c0);
    } else {
      const int k = idx - NA - NBS, q = k / 352, c0 = (k - q * 352) * 8, sq = q >> 1, j = q & 1;
      const bool samp = sq >= NB;
      const GAS bf16_t* src = samp ? (US + (size_t)(16 * (sq - NB) + 14 + j) * DFF) : (UH + ((size_t)(64 * sq + 63) * 2 + j) * DFF);
      load8(src + c0, u0);
      GAS float* dst = p.out + (samp ? O_SF : O_PF) + (((size_t)l * (samp ? SBN : NB) + (samp ? sq - NB : sq)) * 2 + j) * DFF + c0;
#pragma unroll
      for (int i = 0; i < 8; ++i) dst[i] = u0[i];
    }
  }
}

__device__ __forceinline__ void phase_final(const Ctx p) {
  const int tid = opaque_tid(p.wv), lane = tid & 63, wave = tid >> 6;
  const int gw = p.bid * 8 + wave, NGW = p.nblk * 8;
  const GAS float* nf = p.in[34];
  const GAS bf16_t* X = (const GAS bf16_t*)(p.ws + WS_XB0);
  for (int r = gw; r < R_MAIN; r += NGW) {
    f32x4 v[4]; float s = 0.f;
#pragma unroll
    for (int j = 0; j < 4; ++j) { const u32x2 xi = *(const GAS u32x2*)(X + (size_t)r * DM + 256 * j + 4 * lane); v[j] = (f32x4){bflo(xi.x), bfhi(xi.x), bflo(xi.y), bfhi(xi.y)}; s += v[j][0] * v[j][0] + v[j][1] * v[j][1] + v[j][2] * v[j][2] + v[j][3] * v[j][3]; }
    s = wave_sum(s);
    const float rs = rsqrtf(s * (1.f / DM) + RMS_EPS);
    GAS float* y = p.out + (size_t)r * DM;
#pragma unroll
    for (int j = 0; j < 4; ++j) { const f32x4 g = *(const GAS f32x4*)(nf + 256 * j + 4 * lane); *(GAS f32x4*)(y + 256 * j + 4 * lane) = v[j] * rs * g; }
  }
}

constexpr int kThreads = 512;
constexpr size_t kDynLds = 163840;

__global__ void __launch_bounds__(512, 2) fwd_megakernel(Params p) {
  extern __shared__ __attribute__((aligned(16))) unsigned char shm[];
  LAS unsigned char* lds = (LAS unsigned char*)shm;
  cg::grid_group grid = cg::this_grid();
#define GSYNC() do { xcd_barrier((unsigned*)cx0.ws, xb_st, opaque_tid(cx0.wv) == 0); if (PROBE_SYNC) xcd_barrier((unsigned*)cx0.ws, xb_st, opaque_tid(cx0.wv) == 0); } while (0)
#define PHASE_CTX() const Ctx cx = opaque_ctx(cx0); const int G = cx.nblk, c = cx.bid; (void)G; (void)c; GAS unsigned char* ws = cx.ws; GAS float* ss = (GAS float*)(ws + WS_SS); GAS float* xmeta = (GAS float*)(ws + WS_XMETA); \
    GAS bf16_t* Xb0 = (GAS bf16_t*)(ws + WS_XB0); GAS bf16_t* Xb1 = (GAS bf16_t*)(ws + WS_XB1); GAS bf16_t* BIG = (GAS bf16_t*)(ws + WS_BIG); (void)ss; (void)xmeta; (void)Xb0; (void)Xb1; (void)BIG;

  volatile LAS unsigned* xb_st = (volatile LAS unsigned*)(lds + 163824);
  if (threadIdx.x == 0) { xb_st[0] = 0u; xb_st[1] = 0u; (void)xb_add(&((unsigned*)p.ws)[XB_XCNT(xb_xcc_id())], 1u); }
#ifndef NO_PRO
  for (int rep = 0; rep < 1 + PROBE_PRO; ++rep) { phase_prologue(p, lds); __syncthreads(); }
#endif
  if (threadIdx.x < 35) ((const float**)(p.ws + WS_TAB))[threadIdx.x] = p.in[threadIdx.x];
  grid.sync();
  Ctx cx0; cx0.out = (GAS float*)p.out; cx0.ws = (GAS unsigned char*)p.ws; cx0.in = (const gcf_t GAS*)(p.ws + WS_TAB); cx0.wv = __builtin_amdgcn_readfirstlane(threadIdx.x >> 6); cx0.bid = blockIdx.x; cx0.nblk = gridDim.x; cx0.pad_ = 0;
#pragma unroll 1
  for (int l0 = 0; l0 < DEPTH; ++l0) {
    {
      PHASE_CTX(); int l = l0; asm volatile("" : "+s"(l));
      unsigned* flag = (unsigned*)ws + XF_FLAG0 + 64 * (2 * l);
      const unsigned need = l > 0 ? 16u : 0u;
      if (l > 0 && c >= G - 16) convert_special<false>(cx, (const GAS float*)(ws + WS_SLAB_OUT), 4, Xb1, Xb0, ss + (size_t)(2 * l) * MPAD * 4, flag, nullptr);
      pg8::Gemm g{(const bf16_t*)Xb0, (const bf16_t*)(ws + WS_WIN) + (size_t)l * NINP * DM, MPAD, 3840, DM, DM};
      pg8::WaitOrder S; S.init(MPAD, 3840, DM, G, c); S.flag = flag; S.need = need; S.wv = cx.wv;
      pg8::EpiScaleBf16 E{BIG, PLD, PLD, ss + (size_t)(2 * l) * MPAD * 4};
      for (int rep = 0; rep < 1 + PROBE_GEMM; ++rep)
      pg8::gemm_phase<pg8::EpiScaleBf16, pg8::WaitOrder>(lds, g, S, E, cx.wv);
      gates_pass(cx, l, flag, need);
    }
    GSYNC();
    {
      PHASE_CTX(); int l = l0; asm volatile("" : "+s"(l));
      if (c < ML_NP1) { for (int rep = 0; rep < 1 + PROBE_P1; ++rep) mlstm_group_item<0>(cx, l, c, lds); }
      rwkv_phase<0>(cx, l, lds, 1 + PROBE_MIXA);
    }
    GSYNC();
    {
      PHASE_CTX(); int l = l0; asm volatile("" : "+s"(l));
      const int tid = opaque_tid(cx.wv), wave = tid >> 6, lane = tid & 63;
      for (int rep = PROBE_SCAN; rep >= 0; --rep) {
        const int chain = c < 32 ? c : 32 + (c - 32) * 2 + (wave >> 2);
        if ((wave & 3) < 2 && (c < 32 ? wave < 2 : c < 96)) rwkv_scan_chain(cx, l, chain, wave & 1, lane, rep > 0);
      }
      if (c >= 32) {
        for (int rep = 0; rep < 1 + PROBE_P3; ++rep) {
          const int it = c - 32;
          const int grp = it % ML_NG, k = (it / ML_NG) * 4 + (grp - 9);
          const int n2 = (it < NB * BH * ML_NG) ? ((grp >= 9 && grp <= 12 && k < SBN * BH) ? 2 : 1) : 0;
          for (int q = 0; q < n2; ++q) mlstm_group_item<1>(cx, l, q == 0 ? it : NB * BH * ML_NG + k, lds);
        }
      }
    }
    GSYNC();
    {
      PHASE_CTX(); int l = l0; asm volatile("" : "+s"(l));
      for (int rep = 0; rep < 1 + PROBE_MIXC; ++rep) rwkv_phase_lite(cx, l, lds);
    }
    GSYNC();
    {
      PHASE_CTX(); int l = l0; asm volatile("" : "+s"(l));
      pg8::Gemm g{(const bf16_t*)cx.out, (const bf16_t*)(ws + WS_WOUT) + (size_t)l * DM * DM, MPAD, DM, DM, DM};
      pg8::TailOrder S; S.init(R_MAIN, DM, DM, G, c); S.nsl = 4;
      pg8::EpiRes E{Xb0, Xb1, ss + (size_t)(2 * l + 1) * MPAD * 4, 1, (GAS float*)(ws + WS_SLAB_OUT), 4, (LAS float*)(lds + 131072)};
      pg8::gemm_phase<pg8::EpiRes, pg8::TailOrder>(lds, g, S, E, cx.wv);
      if (PROBE_OUT) { pg8::EpiRes E2 = E; E2.write_ss = -1; pg8::gemm_phase<pg8::EpiRes, pg8::TailOrder>(lds, g, S, E2, cx.wv); }
    }
    GSYNC();
    {
      PHASE_CTX(); int l = l0; asm volatile("" : "+s"(l));
      unsigned* flag = (unsigned*)ws + XF_FLAG0 + 64 * (2 * l + 1);
      if (c >= G - 16) convert_special<false>(cx, (const GAS float*)(ws + WS_SLAB_OUT), 4, Xb0, Xb1, ss + (size_t)(2 * l + 1) * MPAD * 4, flag, nullptr);
      {
        constexpr int NUP = (MPAD / 256) * (2 * DFF / 256);
        const int lo = NUP % G;
        if (lo && c >= lo) {
          const int tidq = opaque_tid(cx.wv), waveq = tidq >> 6, laneq = tidq & 63, wq = (c - lo) * 8 + waveq, nwq = (G - lo) * 8;
          LAS float* scr = (LAS float*)(lds + waveq * 16384);
          convert_weights(cx.in[11], cx.in[10], cx.in[28], cx.in[30], cx.in[29], cx.in[33], ws, l, WI_IN + WI_OUT + WI_UP, WI_L, wq, nwq, scr, laneq);
          if (l + 1 < DEPTH) convert_weights(cx.in[11], cx.in[10], cx.in[28], cx.in[30], cx.in[29], cx.in[33], ws, l + 1, 0, WI_IN, wq, nwq, scr, laneq);
          __syncthreads();
        } else if (!lo) {
          const int tidq = opaque_tid(cx.wv), waveq = tidq >> 6, laneq = tidq & 63, wq = c * 8 + waveq, nwq = G * 8;
          LAS float* scr = (LAS float*)(lds + waveq * 16384);
          convert_weights(cx.in[11], cx.in[10], cx.in[28], cx.in[30], cx.in[29], cx.in[33], ws, l, WI_IN + WI_OUT + WI_UP, WI_L, wq, nwq, scr, laneq);
          if (l + 1 < DEPTH) convert_weights(cx.in[11], cx.in[10], cx.in[28], cx.in[30], cx.in[29], cx.in[33], ws, l + 1, 0, WI_IN, wq, nwq, scr, laneq);
          __syncthreads();
        }
      }
      pg8::Gemm g{(const bf16_t*)Xb1, (const bf16_t*)(ws + WS_WUP) + (size_t)l * 2 * DFF * DM, MPAD, 2 * DFF, DM, DM};
      pg8::WaitOrder S; S.init(MPAD, 2 * DFF, DM, G, c); S.flag = flag; S.need = 16u; S.wv = cx.wv;
      pg8::EpiUpConv E{BIG, ss + (size_t)(2 * l + 1) * MPAD * 4, cx.in[31] + (size_t)l * 3 * DFF, cx.in[32] + (size_t)l * DFF};
      for (int rep = 0; rep < 1 + PROBE_GEMM; ++rep)
      pg8::gemm_phase<pg8::EpiUpConv, pg8::WaitOrder>(lds, g, S, E, cx.wv);
    }
    GSYNC();
    { PHASE_CTX(); int l = l0; asm volatile("" : "+s"(l)); for (int rep = 0; rep < 1 + PROBE_FIX; ++rep) phase_ffn_fixup(cx, l); }
    GSYNC();
    {
      PHASE_CTX(); int l = l0; asm volatile("" : "+s"(l));
      pg8::Gemm g{(const bf16_t*)BIG, (const bf16_t*)(ws + WS_WDN) + (size_t)l * DM * DFF, MPAD, DM, DFF, DFF};
      pg8::TailOrder S; S.init(R_MAIN, DM, DFF, G, c); S.nsl = 4;
      const int wx = (l + 1 < DEPTH) ? 1 : 0;
      pg8::EpiRes E{Xb1, Xb0, ss + (size_t)(2 * l + 2) * MPAD * 4, wx, (GAS float*)(ws + WS_SLAB_OUT), 4, (LAS float*)(lds + 131072)};
      pg8::gemm_phase<pg8::EpiRes, pg8::TailOrder>(lds, g, S, E, cx.wv);
      if (PROBE_DOWN) { pg8::EpiRes E2 = E; E2.write_ss = -1; pg8::gemm_phase<pg8::EpiRes, pg8::TailOrder>(lds, g, S, E2, cx.wv); }
      if (l + 1 < DEPTH && c >= 32) {
        const int tidq = opaque_tid(cx.wv), waveq = tidq >> 6, laneq = tidq & 63, wq = (c - 32) * 8 + waveq, nwq = (G - 32) * 8;
        LAS float* scr = (LAS float*)(lds + waveq * 16384);
        convert_weights(cx.in[11], cx.in[10], cx.in[28], cx.in[30], cx.in[29], cx.in[33], ws, l + 1, WI_IN, WI_IN + WI_OUT + WI_UP, wq, nwq, scr, laneq);
      }
    }
    GSYNC();
  }
  {
    PHASE_CTX();
    if (c >= G - 16) convert_special<true>(cx, (const GAS float*)(ws + WS_SLAB_OUT), 4, Xb1, nullptr, nullptr, nullptr, cx.in[34]);
  }
  { PHASE_CTX(); phase_final(cx); }
}

extern "C" void kernel_launch(void* const* d_in, const int* in_sizes, int n_in, void* d_out, int out_size, void* d_ws,
                              size_t ws_size, hipStream_t stream) {
  static int grid_blocks = 0;
  if (!grid_blocks) {
    int dev = 0, cus = 0, per_cu = 0;
    (void)hipGetDevice(&dev);
    (void)hipDeviceGetAttribute(&cus, hipDeviceAttributeMultiprocessorCount, dev);
    (void)hipFuncSetAttribute((const void*)fwd_megakernel, hipFuncAttributeMaxDynamicSharedMemorySize, (int)kDynLds);
    (void)hipOccupancyMaxActiveBlocksPerMultiprocessor(&per_cu, fwd_megakernel, kThreads, kDynLds);
    grid_blocks = cus > 0 ? cus : 256;
    if (n_in != 35 || out_size != (int)O_END || ws_size < WS_END) fprintf(stderr, "kernel_launch: unexpected shapes n_in=%d out=%d ws=%zu\n", n_in, out_size, ws_size);
  }
  (void)hipMemsetAsync(d_ws, 0, 16384, stream);
  Params p{};
  for (int i = 0; i < 35; ++i) p.in[i] = (const float*)d_in[i];
  p.out = (float*)d_out;
  p.ws = (unsigned char*)d_ws;
  p.ph_lo = 0; p.ph_hi = 0;
  void* args[] = {&p};
  hipError_t e = hipLaunchCooperativeKernel((void*)fwd_megakernel, dim3(grid_blocks), dim3(kThreads), args, kDynLds, stream);
  if (e != hipSuccess) fprintf(stderr, "cooperative launch failed: %s (grid %d)\n", hipGetErrorString(e), grid_blocks);
}
```

```cpp
#define PROBE_SYNC 0
#define PROBE_MIXA 0
#define PROBE_MIXC 0
#define PROBE_GEMM 0
#define PROBE_ML 0
#define PROBE_PRO 0
#define PROBE_OUT 0
#define PROBE_DOWN 0
#define PROBE_FIX 0
#define PROBE_P1 0
#define PROBE_P3 0
#define PROBE_SCAN 0
#include <hip/hip_runtime.h>
#include <hip/hip_cooperative_groups.h>
#include <cstdio>
#include <cstdint>
namespace cg = cooperative_groups;

#define LAS __attribute__((address_space(3)))
#define GAS __attribute__((address_space(1)))
typedef unsigned short bf16_t;
typedef short bf16x8 __attribute__((ext_vector_type(8)));
typedef float f32x4 __attribute__((ext_vector_type(4)));
typedef unsigned u32x4 __attribute__((ext_vector_type(4)));
typedef unsigned u32x2 __attribute__((ext_vector_type(2)));

constexpr int DM = 1024, NB = 4, SEQ = 4096, NMETA = 16, TP = 4112, DEPTH = 2, SBN = 16, STN = 16;
constexpr int AH = 8, AD = 64, AW = 512, ACOLS = 1792, BH = 4, BD = 128, BCOLS = 2056, DIN = 3848, DFF = 2816, HFF = 1408;
constexpr int R_MAIN = 16384, R_SAMP = 16384, R_META = 16640, R_TOT = 16704, MPAD = 16896;
constexpr int PLD = 3856;
constexpr int NINP = 4096;
constexpr float RMS_EPS = 1e-6f, GN_EPS = 64e-5f;

constexpr size_t O_YP = 0, O_YS = O_YP + (size_t)NB * SEQ * DM, O_PSHIFT = O_YS + (size_t)SBN * STN * DM;
constexpr size_t O_PWKV = O_PSHIFT + (size_t)DEPTH * NB * ACOLS, O_PCONV = O_PWKV + (size_t)DEPTH * NB * AH * AD * AD;
constexpr size_t O_PC = O_PCONV + (size_t)DEPTH * NB * 3 * 1024, O_PN = O_PC + (size_t)DEPTH * NB * BH * BD * BD;
constexpr size_t O_PM = O_PN + (size_t)DEPTH * NB * BH * BD, O_PF = O_PM + (size_t)DEPTH * NB * BH;
constexpr size_t O_SSHIFT = O_PF + (size_t)DEPTH * NB * 2 * DFF;
constexpr size_t O_SWKV = O_SSHIFT + (size_t)DEPTH * SBN * ACOLS, O_SCONV = O_SWKV + (size_t)DEPTH * SBN * AH * AD * AD;
constexpr size_t O_SC = O_SCONV + (size_t)DEPTH * SBN * 3 * 1024, O_SN = O_SC + (size_t)DEPTH * SBN * BH * BD * BD;
constexpr size_t O_SM = O_SN + (size_t)DEPTH * SBN * BH * BD, O_SF = O_SM + (size_t)DEPTH * SBN * BH;
constexpr size_t O_END = O_SF + (size_t)DEPTH * SBN * 2 * DFF;
static_assert(O_END == 21412000, "output size");

constexpr size_t WS_TAB = 32768;
constexpr size_t WS_SS = 65536;
constexpr size_t WS_XMETA = WS_SS + 4 * (size_t)MPAD * 16 + 256;
constexpr size_t WS_LORA = (WS_XMETA + 255) / 256 * 256;
constexpr size_t WS_ZROW = WS_LORA + (size_t)DEPTH * AH * 16384 * 2;
constexpr size_t WS_SHIFTB = WS_ZROW + 8192;
constexpr size_t WS_CONVB = (WS_SHIFTB + (size_t)DEPTH * SBN * ACOLS * 2 + 255) / 256 * 256;
constexpr size_t WS_WIN = (WS_CONVB + (size_t)DEPTH * SBN * 3 * 1024 * 2 + 255) / 256 * 256;
constexpr size_t WS_WOUT = WS_WIN + 2 * (size_t)NINP * DM * 2;
constexpr size_t WS_WUP = WS_WOUT + 2 * (size_t)DM * DM * 2;
constexpr size_t WS_WDN = WS_WUP + 2 * (size_t)2 * DFF * DM * 2;
constexpr size_t WS_XB0 = WS_WDN + 2 * (size_t)2 * DM * HFF * 2;
constexpr size_t WS_BIG = WS_XB0 + (size_t)MPAD * DM * 2;
constexpr size_t WS_AUX = WS_BIG + (size_t)MPAD * PLD * 2;
constexpr size_t WS_XB1 = WS_AUX;
constexpr size_t WS_END = WS_AUX + (size_t)2208 * 16384 + (size_t)8 * 1024 * 1024;
static_assert(WS_END <= 268435456, "workspace");
constexpr size_t WS_SLAB_OUT = WS_AUX + (size_t)MPAD * DM * 2;
static_assert(WS_SLAB_OUT + (size_t)8 * 4 * 65536 * 4 <= 268435456, "slab_out");
constexpr size_t WS_BONUS = WS_AUX + (((size_t)2208 * 16384 + (size_t)208 * 33536 + 255) / 256) * 256;
static_assert(WS_BONUS + (size_t)2208 * 64 * 4 <= WS_END, "bonus scalars fit in AUX");

struct Params {
  const float* in[35];
  float* out;
  unsigned char* ws;
  int ph_lo, ph_hi;
};

typedef const GAS float* gcf_t;
struct Ctx { GAS float* out; GAS unsigned char* ws; const gcf_t GAS* in; int wv; int bid; int nblk; int pad_; };

__device__ __forceinline__ int opaque_tid(int wv) { unsigned z = 0u; asm volatile("" : "+v"(z)); int t = (wv << 6) | (int)__builtin_amdgcn_mbcnt_hi(~0u, __builtin_amdgcn_mbcnt_lo(~0u, z)); asm volatile("" : "+v"(t)); return t; }
__device__ __forceinline__ Ctx opaque_ctx(Ctx c) { asm volatile("" : "+s"(c.out), "+s"(c.ws), "+s"(c.in), "+s"(c.wv), "+s"(c.bid), "+s"(c.nblk)); return c; }

typedef float f32x2_t __attribute__((ext_vector_type(2)));
typedef __bf16 bf16x2_t __attribute__((ext_vector_type(2)));
__device__ __forceinline__ unsigned pk2(float lo, float hi) { const f32x2_t v = {lo, hi}; const bf16x2_t b = __builtin_convertvector(v, bf16x2_t); return __builtin_bit_cast(unsigned, b); }
__device__ __forceinline__ unsigned f2bf(float f) { return pk2(f, 0.f) & 0xffffu; }
__device__ __forceinline__ float bf2f(unsigned b) { return __builtin_bit_cast(float, b << 16); }
__device__ __forceinline__ float bflo(unsigned w) { return __builtin_bit_cast(float, w << 16); }
__device__ __forceinline__ float bfhi(unsigned w) { return __builtin_bit_cast(float, w & 0xffff0000u); }
__device__ __forceinline__ float wave_sum(float v) {
#pragma unroll
  for (int o = 1; o < 64; o <<= 1) v += __shfl_xor(v, o);
  return v;
}
__device__ __forceinline__ float sigmoidf_(float x) { return __builtin_amdgcn_rcpf(1.f + __expf(-x)); }
__device__ __forceinline__ float siluf_(float x) { return x * __builtin_amdgcn_rcpf(1.f + __expf(-x)); }
__device__ __forceinline__ float softplusf_(float x) { return fmaxf(x, 0.f) + __logf(1.f + __expf(-fabsf(x))); }
__device__ __forceinline__ void load8(const GAS bf16_t* p, float* o) {
  const u32x4 w = *(const GAS u32x4*)p;
  o[0] = bflo(w.x); o[1] = bfhi(w.x); o[2] = bflo(w.y); o[3] = bfhi(w.y); o[4] = bflo(w.z); o[5] = bfhi(w.z); o[6] = bflo(w.w); o[7] = bfhi(w.w);
}
__device__ __forceinline__ float row_rstd(const GAS float* ss4, int row) { const f32x4 p = *(const GAS f32x4*)(ss4 + (size_t)row * 4); return rsqrtf((((p[0] + p[1]) + p[2]) + p[3]) * (1.f / DM) + RMS_EPS); }
__device__ __forceinline__ GAS float* xrow_ptr(GAS float* out, GAS float* xmeta, int r) { return r < R_META ? out + (size_t)r * DM : xmeta + (size_t)(r - R_META) * DM; }

namespace pg8 {
constexpr int BM = 256, BK = 64, HALF = 128, HTB = HALF * BK * 2, STAGE_BYTES = 8 * HTB, NXCD = 8, WGM = 8;
__host__ __device__ __forceinline__ int lds_byte(int r, int c) { const int st = (r >> 4) * 2 + (c >> 5), rr = r & 15, cc = c & 31, ob = rr * 64 + cc * 2; return st * 1024 + (ob ^ (((ob >> 9) & 1) << 5)); }
__host__ __device__ __forceinline__ void stage_rc(int b, int& R, int& C) { const int st = b / 1024, sb = b % 1024, swz = sb ^ (((sb >> 9) & 1) << 5); R = (st >> 1) * 16 + swz / 64; C = (st & 1) * 32 + (swz % 64) / 2; }
__host__ __device__ __forceinline__ int perm32(int rho) { const int n = rho >> 4, i = rho & 15; return 8 * (i >> 2) + 4 * n + (i & 3); }
struct Unit { int pm, pn, kofs, nt, slice; };
struct Gemm { const bf16_t* A; const bf16_t* Bt; int M, N, K, lda; };
struct StaticOrder {
  int nM, nN, nwg, G, c, ntf;
  __device__ void init(int M, int N, int K, int G_, int c_) { nM = M / BM; nN = N / BM; nwg = nM * nN; G = G_; c = c_; ntf = K / BK; }
  __device__ bool next(int i, Unit& u) const {
    const long L = (long)i * G + c; if (L >= nwg) return false;
    int wgid = (int)L; { const int q = nwg / NXCD, r = nwg % NXCD, xcd = wgid % NXCD, off = wgid / NXCD; wgid = (xcd < r ? xcd * (q + 1) : r * (q + 1) + (xcd - r) * q) + off; }
    const int nig = WGM * nN, gid = wgid / nig, fm = gid * WGM, gsz = (nM - fm) < WGM ? (nM - fm) : WGM;
    u.pm = fm + ((wgid % nig) % gsz); u.pn = (wgid % nig) / gsz; u.kofs = 0; u.nt = ntf; u.slice = 0; return true;
  }
  __device__ __forceinline__ void a_ready(const Unit&) const {}
};
struct WaitOrder : StaticOrder {
  unsigned* flag; unsigned need; int wv;
  __device__ __forceinline__ void a_ready(const Unit& u) const {
    if (u.pm < 64) return;
    if (wv == 0) {
      unsigned sp = 0;
      while ((unsigned)__builtin_amdgcn_readfirstlane(__hip_atomic_load(flag, __ATOMIC_RELAXED, __HIP_MEMORY_SCOPE_AGENT)) < need) { __builtin_amdgcn_s_sleep(2); if (++sp > (1u << 22)) break; }
      __builtin_amdgcn_fence(__ATOMIC_ACQUIRE, "agent");
      asm volatile("s_waitcnt vmcnt(0)" ::: "memory");
    }
    asm volatile("" ::: "memory"); __builtin_amdgcn_s_barrier(); asm volatile("" ::: "memory");
  }
};
struct TailOrder : StaticOrder {
  int nsl;
  __device__ bool next(int i, Unit& u) const {
    if (i == 0) return StaticOrder::next(0, u);
    if (i == 1 && c < 8 * nsl) {
      const int tile = c & 7, sl = c >> 3;
      const int st = (ntf == 16) ? 4 * sl : (sl < 2 ? 12 * sl : 24 + 10 * (sl - 2)), n = (ntf == 16) ? 4 : (sl < 2 ? 12 : 10);
      u.pm = 64 + (tile >> 2); u.pn = tile & 3; u.kofs = st * BK * 2; u.nt = n; u.slice = 1 + sl; return true;
    }
    return false;
  }
};
__device__ __forceinline__ unsigned cvt_pk_bf16(float lo, float hi) { unsigned r; asm volatile("v_cvt_pk_bf16_f32 %0, %1, %2" : "=v"(r) : "v"(lo), "v"(hi)); return r; }

template <class Epi, class Sched, bool ALIGN_EPI = true>
__device__ __forceinline__ void gemm_phase(LAS unsigned char* lds, const Gemm g, const Sched& S, const Epi& E, int wv) {
  const int tid = opaque_tid(wv), wid = __builtin_amdgcn_readfirstlane(tid >> 6), lane = tid & 63, wr = wid >> 2, wc = wid & 3, fr = lane & 15, fq = lane >> 4;
  const int K = g.K, lda = g.lda;
  unsigned voffA[2], voffB[2];
#pragma unroll
  for (int i = 0; i < 2; ++i) { int R, C; stage_rc(tid * 16 + i * 8192, R, C); const int Rb = Epi::PERM ? ((R & ~31) + perm32(R & 31)) : R;
    voffA[i] = (unsigned)(R * lda + C) * 2u; voffB[i] = (unsigned)(Rb * K + C) * 2u; }
  const size_t kstep = (size_t)(BK * 2);
  const size_t hstepA = (size_t)HALF * lda * 2, hstepB = (size_t)HALF * K * 2;
  const size_t tstepA = 2 * hstepA, tstepB = 2 * hstepB;
  const unsigned ldsw = (unsigned)wid * 1024u;
  const int aoff = lds_byte(wr * 64 + fr, fq * 8), boff = lds_byte(wc * 32 + fr, fq * 8);
#define PG8_SA(b, h) (((b) * 2 + (h)) * HTB)
#define PG8_SB(b, h) ((4 + (b) * 2 + (h)) * HTB)
#define PG8_STAGE(bufoff, gbase, voff) do { _Pragma("unroll") for (int _i = 0; _i < 2; ++_i) \
    __builtin_amdgcn_global_load_lds((const unsigned*)((const char*)(gbase) + (voff)[_i]), (LAS unsigned*)(lds + (bufoff) + ldsw + _i * 8192), 16, 0, 0); } while (0)
#define PG8_LDA(dst, b, h) do { _Pragma("unroll") for (int m = 0; m < 4; ++m) _Pragma("unroll") for (int k = 0; k < 2; ++k) dst[m][k] = *(const LAS bf16x8*)(lds + PG8_SA(b, h) + aoff + m * 2048 + k * 1024); } while (0)
#define PG8_LDB(dst, b, h) do { _Pragma("unroll") for (int n = 0; n < 2; ++n) _Pragma("unroll") for (int k = 0; k < 2; ++k) dst[n][k] = *(const LAS bf16x8*)(lds + PG8_SB(b, h) + boff + n * 2048 + k * 1024); } while (0)
#define PG8_MMA(ai, bj, At, Bt) do { __builtin_amdgcn_s_setprio(1); _Pragma("unroll") for (int m = 0; m < 4; ++m) _Pragma("unroll") for (int n = 0; n < 2; ++n) _Pragma("unroll") for (int k = 0; k < 2; ++k) \
    acc[ai][bj][m][n] = __builtin_amdgcn_mfma_f32_16x16x32_bf16(Bt[n][k], At[m][k], acc[ai][bj][m][n], 0, 0, 0); __builtin_amdgcn_s_setprio(0); } while (0)
#define PG8_WAIT_V(n) asm volatile("s_waitcnt vmcnt(" #n ")" ::: "memory")
#define PG8_WAIT_L(n) asm volatile("s_waitcnt lgkmcnt(" #n ")" ::: "memory")
#define PG8_BAR __builtin_amdgcn_s_barrier()
#define PG8_SCHED __builtin_amdgcn_sched_barrier(0)
  Unit cur, nxt; int ui = 0;
  if (!S.next(0, cur)) return;
  f32x4 acc[2][2][4][2];
#pragma unroll
  for (int a = 0; a < 2; ++a)
#pragma unroll
    for (int b = 0; b < 2; ++b)
#pragma unroll
      for (int m = 0; m < 4; ++m)
#pragma unroll
        for (int n = 0; n < 2; ++n) acc[a][b][m][n] = (f32x4){0.f, 0.f, 0.f, 0.f};
  bf16x8 At[4][2], B0[2][2], B1[2][2];
  const char* cA = (const char*)g.A + (size_t)cur.pm * tstepA + cur.kofs; const char* cB = (const char*)g.Bt + (size_t)cur.pn * tstepB + cur.kofs;
  S.a_ready(cur);
  PG8_STAGE(PG8_SB(0, 0), cB, voffB); PG8_STAGE(PG8_SB(0, 1), cB + hstepB, voffB); PG8_STAGE(PG8_SA(0, 0), cA, voffA); PG8_STAGE(PG8_SA(0, 1), cA + hstepA, voffA);
  if (wr == 1) PG8_BAR;
  PG8_WAIT_V(2); PG8_BAR;
  PG8_STAGE(PG8_SB(1, 0), cB + kstep, voffB); PG8_STAGE(PG8_SA(1, 0), cA + kstep, voffA); PG8_STAGE(PG8_SB(1, 1), cB + hstepB + kstep, voffB);
  PG8_WAIT_V(6); PG8_BAR;
  for (;;) {
    const bool has_next = S.next(ui + 1, nxt);
    const char* nA = has_next ? (const char*)g.A + (size_t)nxt.pm * tstepA + nxt.kofs : cA; const char* nB = has_next ? (const char*)g.Bt + (size_t)nxt.pn * tstepB + nxt.kofs : cB;
    const int nt = cur.nt;
    for (int t = 0; t < nt; t += 2) {
      const bool last = (t == nt - 2);
      if (last && has_next) S.a_ready(nxt);
      const char* a1 = cA + (size_t)(t + 1) * kstep;
      const char* a2 = last ? nA : cA + (size_t)(t + 2) * kstep; const char* b2 = last ? nB : cB + (size_t)(t + 2) * kstep;
      const char* a3 = a2 + kstep; const char* b3 = b2 + kstep;
      PG8_LDB(B0, 0, 0); PG8_LDB(B1, 0, 1); PG8_SCHED; PG8_LDA(At, 0, 0); PG8_STAGE(PG8_SA(1, 1), a1 + hstepA, voffA);
      PG8_WAIT_V(8); PG8_WAIT_L(0); PG8_BAR; PG8_MMA(0, 0, At, B0); PG8_MMA(0, 1, At, B1); PG8_BAR; PG8_SCHED;
      PG8_LDA(At, 0, 1); PG8_STAGE(PG8_SB(0, 0), b2, voffB); PG8_STAGE(PG8_SB(0, 1), b2 + hstepB, voffB); PG8_STAGE(PG8_SA(0, 0), a2, voffA);
      PG8_WAIT_V(8); PG8_WAIT_L(0); PG8_BAR; PG8_MMA(1, 0, At, B0); PG8_MMA(1, 1, At, B1); PG8_BAR; PG8_SCHED;
      PG8_LDB(B0, 1, 0); PG8_LDB(B1, 1, 1); PG8_SCHED; PG8_LDA(At, 1, 0); PG8_STAGE(PG8_SA(0, 1), a2 + hstepA, voffA);
      PG8_WAIT_V(8); PG8_WAIT_L(0); PG8_BAR; PG8_MMA(0, 0, At, B0); PG8_MMA(0, 1, At, B1); PG8_BAR; PG8_SCHED;
      PG8_LDA(At, 1, 1); PG8_STAGE(PG8_SB(1, 0), b3, voffB); PG8_STAGE(PG8_SB(1, 1), b3 + hstepB, voffB); PG8_STAGE(PG8_SA(1, 0), a3, voffA);
      PG8_WAIT_V(8); PG8_WAIT_L(0); PG8_BAR; PG8_MMA(1, 0, At, B0); PG8_MMA(1, 1, At, B1); PG8_BAR; PG8_SCHED;
    }
    if constexpr (ALIGN_EPI) { if (wr == 0) PG8_BAR; }
    E(acc, cur, wr, wc, fr, fq);
    if (!has_next) break;
#pragma unroll
    for (int a = 0; a < 2; ++a)
#pragma unroll
      for (int b = 0; b < 2; ++b)
#pragma unroll
        for (int m = 0; m < 4; ++m)
#pragma unroll
          for (int n = 0; n < 2; ++n) acc[a][b][m][n] = (f32x4){0.f, 0.f, 0.f, 0.f};
    cur = nxt; cA = nA; cB = nB; ++ui;
    if constexpr (ALIGN_EPI) { if (wr == 1) PG8_BAR; }
  }
  PG8_WAIT_V(0);
  if constexpr (!ALIGN_EPI) { if (wr == 0) PG8_BAR; }
  PG8_BAR;
#undef PG8_SA
#undef PG8_SB
#undef PG8_STAGE
#undef PG8_LDA
#undef PG8_LDB
#undef PG8_MMA
#undef PG8_WAIT_V
#undef PG8_WAIT_L
#undef PG8_BAR
#undef PG8_SCHED
}

struct EpiScaleBf16 {
  static constexpr bool PERM = true;
  GAS bf16_t* O; int ldo; int ncols; const GAS float* ss;
  __device__ __forceinline__ void operator()(const f32x4 (&acc)[2][2][4][2], const Unit& u, int wr, int wc, int fr, int fq) const {
    const int row0 = u.pm * BM + wr * 64 + fr, col0 = u.pn * BM + wc * 32 + 8 * fq;
#pragma unroll
    for (int ai = 0; ai < 2; ++ai)
#pragma unroll
      for (int m = 0; m < 4; ++m) {
        const int row = row0 + ai * HALF + m * 16;
        const float rs = row_rstd(ss, row);
        GAS bf16_t* rowp = O + (size_t)row * ldo + col0;
#pragma unroll
        for (int bj = 0; bj < 2; ++bj) {
          if (col0 + bj * HALF < ncols) {
            const f32x4 v0 = acc[ai][bj][m][0] * rs, v1 = acc[ai][bj][m][1] * rs;
            u32x4 w; w.x = cvt_pk_bf16(v0[0], v0[1]); w.y = cvt_pk_bf16(v0[2], v0[3]); w.z = cvt_pk_bf16(v1[0], v1[1]); w.w = cvt_pk_bf16(v1[2], v1[3]);
            *(GAS u32x4*)(rowp + bj * HALF) = w;
          }
        }
      }
  }
};
struct EpiRes {
  static constexpr bool PERM = true;
  const GAS bf16_t* Xin; GAS bf16_t* Xout; GAS float* ssn; int write_ss; GAS float* slab; int nsl; LAS float* red;
  __device__ __forceinline__ void operator()(const f32x4 (&acc)[2][2][4][2], const Unit& u, int wr, int wc, int fr, int fq) const {
    if (write_ss < 0) return;
    if (u.slice) {
      GAS float* sb = slab + ((size_t)(((u.pm - 64) * 4 + u.pn) * nsl + (u.slice - 1)) * 256 + wr * 64 + fr) * 256 + wc * 32 + 8 * fq;
#pragma unroll
      for (int ai = 0; ai < 2; ++ai)
#pragma unroll
        for (int m = 0; m < 4; ++m)
#pragma unroll
          for (int bj = 0; bj < 2; ++bj)
#pragma unroll
            for (int n = 0; n < 2; ++n) *(GAS f32x4*)(sb + (size_t)(ai * HALF + m * 16) * 256 + bj * HALF + n * 4) = acc[ai][bj][m][n];
      return;
    }
    const int row0 = u.pm * BM + wr * 64 + fr, col0 = u.pn * BM + wc * 32 + 8 * fq;
#pragma unroll
    for (int ai = 0; ai < 2; ++ai)
#pragma unroll
      for (int m = 0; m < 4; ++m) {
        const int row = row0 + ai * HALF + m * 16;
        const size_t ro = (size_t)row * DM + col0;
        float sq = 0.f;
#pragma unroll
        for (int bj = 0; bj < 2; ++bj) {
          const u32x4 xi = *(const GAS u32x4*)(Xin + ro + bj * HALF);
          const f32x4 x0 = (f32x4){__builtin_bit_cast(float, xi.x << 16), __builtin_bit_cast(float, xi.x & 0xffff0000u), __builtin_bit_cast(float, xi.y << 16), __builtin_bit_cast(float, xi.y & 0xffff0000u)} + acc[ai][bj][m][0];
          const f32x4 x1 = (f32x4){__builtin_bit_cast(float, xi.z << 16), __builtin_bit_cast(float, xi.z & 0xffff0000u), __builtin_bit_cast(float, xi.w << 16), __builtin_bit_cast(float, xi.w & 0xffff0000u)} + acc[ai][bj][m][1];
          u32x4 w; w.x = cvt_pk_bf16(x0[0], x0[1]); w.y = cvt_pk_bf16(x0[2], x0[3]); w.z = cvt_pk_bf16(x1[0], x1[1]); w.w = cvt_pk_bf16(x1[2], x1[3]);
          *(GAS u32x4*)(Xout + ro + bj * HALF) = w;
          sq += x0[0] * x0[0] + x0[1] * x0[1] + x0[2] * x0[2] + x0[3] * x0[3] + x1[0] * x1[0] + x1[1] * x1[1] + x1[2] * x1[2] + x1[3] * x1[3];
        }
        if (write_ss) {
          sq += __shfl_xor(sq, 16); sq += __shfl_xor(sq, 32);
          if (fq == 0) red[(ai * HALF + wr * 64 + m * 16 + fr) * 4 + wc] = sq;
        }
      }
    if (write_ss) {
      asm volatile("s_waitcnt lgkmcnt(0)" ::: "memory"); __builtin_amdgcn_s_barrier(); asm volatile("" ::: "memory");
      const int t2 = wr * 256 + wc * 64 + fq * 16 + fr;
      if (t2 < 256) { const f32x4 q = *(const LAS f32x4*)(red + t2 * 4); ssn[(size_t)(u.pm * BM + t2) * 4 + u.pn] = ((q[0] + q[1]) + q[2]) + q[3]; }
    }
  }
};
constexpr size_t FS_G = (size_t)MPAD * DFF;
constexpr size_t FS_UH = FS_G, FS_UD = FS_UH + (size_t)256 * 2 * DFF, FS_GD = FS_UD + (size_t)256 * 2 * DFF, FS_US = FS_GD + (size_t)256 * 2 * DFF, FS_GS = FS_US + (size_t)512 * DFF;
static_assert((FS_GS + (size_t)512 * DFF) * 2 <= (size_t)MPAD * PLD * 2, "FFN side buffers fit in BIG");
__device__ __forceinline__ float dpp_prev(float prv, float cur, int sh) {
  const int pr = __builtin_bit_cast(int, prv), cu = __builtin_bit_cast(int, cur);
  int r;
  if (sh == 1) { const int o = __builtin_amdgcn_update_dpp(0, pr, 0x121, 0xf, 0xf, false); r = __builtin_amdgcn_update_dpp(o, cu, 0x111, 0xf, 0xf, false); }
  else { const int o = __builtin_amdgcn_update_dpp(0, pr, 0x122, 0xf, 0xf, false); r = __builtin_amdgcn_update_dpp(o, cu, 0x112, 0xf, 0xf, false); }
  return __builtin_bit_cast(float, r);
}
struct EpiUpConv {
  static constexpr bool PERM = true;
  GAS bf16_t* G; const GAS float* ss; const GAS float* cw; const GAS float* cb;
  __device__ __forceinline__ void operator()(const f32x4 (&acc)[2][2][4][2], const Unit& u, int wr, int wc, int fr, int fq) const {
    const int row0 = u.pm * BM + wr * 64 + fr, ff0 = u.pn * 128 + wc * 32 + 8 * fq;
    const bool spec = u.pm >= 64;
    f32x4 w0[2], w1[2], w2[2], bb[2];
#pragma unroll
    for (int n = 0; n < 2; ++n) { w0[n] = *(const GAS f32x4*)(cw + ff0 + 4 * n); w1[n] = *(const GAS f32x4*)(cw + DFF + ff0 + 4 * n); w2[n] = *(const GAS f32x4*)(cw + 2 * DFF + ff0 + 4 * n); bb[n] = *(const GAS f32x4*)(cb + ff0 + 4 * n); }
#pragma unroll
    for (int ai = 0; ai < 2; ++ai) {
      f32x4 prv[2] = {(f32x4){0.f, 0.f, 0.f, 0.f}, (f32x4){0.f, 0.f, 0.f, 0.f}};
      const int stripe = u.pm * 4 + ai * 2 + wr;
#pragma unroll
      for (int m = 0; m < 4; ++m) {
        const int row = row0 + ai * HALF + m * 16;
        const float rs = row_rstd(ss, row);
        f32x4 cur[2], gt[2], o[2];
#pragma unroll
        for (int n = 0; n < 2; ++n) {
          cur[n] = acc[ai][0][m][n] * rs; gt[n] = acc[ai][1][m][n] * rs;
#pragma unroll
          for (int uu = 0; uu < 4; ++uu) {
            const float p1 = dpp_prev(prv[n][uu], cur[n][uu], 1), p2 = dpp_prev(prv[n][uu], cur[n][uu], 2);
            const float val = w0[n][uu] * p2 + w1[n][uu] * p1 + w2[n][uu] * cur[n][uu] + bb[n][uu];
            o[n][uu] = val * __builtin_amdgcn_rcpf(1.f + __expf(-val)) * gt[n][uu];
          }
          prv[n] = cur[n];
        }
        u32x4 w; w.x = cvt_pk_bf16(o[0][0], o[0][1]); w.y = cvt_pk_bf16(o[0][2], o[0][3]); w.z = cvt_pk_bf16(o[1][0], o[1][1]); w.w = cvt_pk_bf16(o[1][2], o[1][3]);
        *(GAS u32x4*)(G + (size_t)row * DFF + ff0) = w;
        const bool needu = spec || (m == 0 && fr < 2) || (m == 3 && fr >= 14);
        if (needu) {
          u32x4 wu; wu.x = cvt_pk_bf16(cur[0][0], cur[0][1]); wu.y = cvt_pk_bf16(cur[0][2], cur[0][3]); wu.z = cvt_pk_bf16(cur[1][0], cur[1][1]); wu.w = cvt_pk_bf16(cur[1][2], cur[1][3]);
          u32x4 wg; wg.x = cvt_pk_bf16(gt[0][0], gt[0][1]); wg.y = cvt_pk_bf16(gt[0][2], gt[0][3]); wg.z = cvt_pk_bf16(gt[1][0], gt[1][1]); wg.w = cvt_pk_bf16(gt[1][2], gt[1][3]);
          if (spec) { *(GAS u32x4*)(G + FS_US + (size_t)(row - R_SAMP) * DFF + ff0) = wu; *(GAS u32x4*)(G + FS_GS + (size_t)(row - R_SAMP) * DFF + ff0) = wg; }
          else if (m == 0) { *(GAS u32x4*)(G + FS_UD + ((size_t)stripe * 2 + fr) * DFF + ff0) = wu; *(GAS u32x4*)(G + FS_GD + ((size_t)stripe * 2 + fr) * DFF + ff0) = wg; }
          else *(GAS u32x4*)(G + FS_UH + ((size_t)stripe * 2 + (fr - 14)) * DFF + ff0) = wu;
        }
      }
    }
  }
};
}


#define XB_TMO      128
#define XB_XCNT(j)  (256  + 64 * (j))
#define XB_XSUB(j)  (1280 + 64 * (j))
#define XB_XGEN(j)  (2304 + 64 * (j))
#define XB_TOP      3328
#define XB_TOPGEN   3392
#define XCD_BAR_WORDS 3456
#define XB_SPIN_CAP (1u << 20)
__device__ __forceinline__ unsigned xb_ld(unsigned* p)              { return __hip_atomic_load(p, __ATOMIC_RELAXED, __HIP_MEMORY_SCOPE_AGENT); }
__device__ __forceinline__ unsigned xb_add(unsigned* p, unsigned v) { return __hip_atomic_fetch_add(p, v, __ATOMIC_RELAXED, __HIP_MEMORY_SCOPE_AGENT); }
__device__ __forceinline__ unsigned xb_xcc_id() { return (unsigned)__builtin_amdgcn_s_getreg((3 << 11) | 20) & 0xFu; }
#define XB_SPIN(cond, bar) do { unsigned _sp = 0; while (cond) { __builtin_amdgcn_s_sleep(1); \
    if ((++_sp & 255u) == 0u) { if (xb_ld(&(bar)[XB_TMO])) break; if (_sp > XB_SPIN_CAP) { atomicAdd(&(bar)[XB_TMO], 1u); break; } } } } while (0)
__device__ __forceinline__ void xcd_barrier_complete(unsigned* bar, unsigned x, unsigned& nloc, unsigned& nx) {
  const unsigned G = gridDim.x * gridDim.y * gridDim.z;
  unsigned sum, cnt, mine, sp = 0u;
  for (;;) {
    sum = 0u; cnt = 0u; mine = 0u;
#pragma unroll
    for (unsigned j = 0; j < 16; ++j) { const unsigned c = xb_ld(&bar[XB_XCNT(j)]); sum += c; cnt += (c > 0u) ? 1u : 0u; mine = (j == x) ? c : mine; }
    if (sum == G) break;
    __builtin_amdgcn_s_sleep(1);
    if ((++sp & 255u) == 0u) { if (xb_ld(&bar[XB_TMO])) break; if (sp > XB_SPIN_CAP) { atomicAdd(&bar[XB_TMO], 1u); break; } }
  }
  nloc = mine > 0u ? mine : 1u; nx = cnt > 0u ? cnt : 1u;
}
__device__ __forceinline__ void xcd_barrier(unsigned* bar, volatile LAS unsigned* st, bool tid0) {
  asm volatile("s_waitcnt vmcnt(0)" ::: "memory");
  __syncthreads();
  if (tid0) {
    __builtin_amdgcn_s_waitcnt(0);
    const unsigned x = xb_xcc_id();
    unsigned nloc = st[0], nx = st[1];
    if (nloc == 0u) { xcd_barrier_complete(bar, x, nloc, nx); st[0] = nloc; st[1] = nx; }
    const unsigned old = xb_add(&bar[XB_XSUB(x)], 1u);
    const unsigned gen = old / nloc;
    if (old + 1u == (gen + 1u) * nloc) {
      __builtin_amdgcn_fence(__ATOMIC_RELEASE, "agent");
      asm volatile("s_waitcnt vmcnt(0)" ::: "memory");
      const unsigned og = xb_add(&bar[XB_TOP], 1u);
      const unsigned tg = og / nx;
      if (og + 1u == (tg + 1u) * nx) xb_add(&bar[XB_TOPGEN], 1u);
      else XB_SPIN(xb_ld(&bar[XB_TOPGEN]) == tg, bar);
      __builtin_amdgcn_fence(__ATOMIC_ACQUIRE, "agent");
      xb_add(&bar[XB_XGEN(x)], 1u);
      asm volatile("s_waitcnt vmcnt(0)" ::: "memory");
    } else {
      XB_SPIN(xb_ld(&bar[XB_XGEN(x)]) == gen, bar);
      __builtin_amdgcn_fence(__ATOMIC_ACQUIRE, "agent");
      asm volatile("s_waitcnt vmcnt(0)" ::: "memory");
    }
  }
  __syncthreads();
}

__device__ __forceinline__ void transpose_item(const GAS float* W, int N, int k0, int n0, int nvalid, const GAS float* scale, GAS bf16_t* WT, int ldt, int dst_row0, int dst_k0, LAS float* scr, int lane) {
  {
    const int n4 = 4 * (lane & 7);
    f32x4 v[8];
#pragma unroll
    for (int i = 0; i < 8; ++i) {
      const int kk = (lane >> 3) + 8 * i;
      v[i] = (n0 + n4 < nvalid) ? *(const GAS f32x4*)(W + (size_t)(k0 + kk) * N + n0 + n4) : (f32x4){0.f, 0.f, 0.f, 0.f};
    }
#pragma unroll
    for (int i = 0; i < 8; ++i) {
      const int kk = (lane >> 3) + 8 * i;
      const float sc = scale ? scale[k0 + kk] : 1.f;
      scr[kk * 33 + n4] = v[i][0] * sc; scr[kk * 33 + n4 + 1] = v[i][1] * sc; scr[kk * 33 + n4 + 2] = v[i][2] * sc; scr[kk * 33 + n4 + 3] = v[i][3] * sc;
    }
  }
  asm volatile("s_waitcnt lgkmcnt(0)" ::: "memory");
  const int c = lane & 7;
#pragma unroll
  for (int j = 0; j < 4; ++j) {
    const int n = (lane >> 3) + 8 * j; const LAS float* s = scr + (8 * c) * 33 + n;
    u32x4 o; o.x = pk2(s[0 * 33], s[1 * 33]); o.y = pk2(s[2 * 33], s[3 * 33]); o.z = pk2(s[4 * 33], s[5 * 33]); o.w = pk2(s[6 * 33], s[7 * 33]);
    *(GAS u32x4*)(WT + (size_t)(dst_row0 + n) * ldt + dst_k0 + 8 * c) = o;
  }
  asm volatile("s_waitcnt lgkmcnt(0)" ::: "memory");
}

constexpr int WI_IN = 16 * 128, WI_OUT = 16 * 32, WI_UP = 16 * 176, WI_DN = 44 * 32, WI_L = WI_IN + WI_OUT + WI_UP + WI_DN;
__device__ __forceinline__ void convert_weights(const GAS float* w_in, const GAS float* nmix, const GAS float* w_out, const GAS float* w_up, const GAS float* nffn, const GAS float* w_dn,
                                                GAS unsigned char* ws, int l, int r_lo, int r_hi, int widx, int nw, LAS float* scr, int lane) {
  for (int r0 = r_lo + widx; r0 < r_hi; r0 += nw) {
    int r = r0;
    if (r < WI_IN) {
      const int kb = r / 128, nb = r % 128;
      transpose_item(w_in + (size_t)l * DM * DIN, DIN, kb * 64, nb * 32, DIN, nmix + l * DM, (GAS bf16_t*)(ws + WS_WIN) + (size_t)l * NINP * DM, DM, nb * 32, kb * 64, scr, lane);
      continue; }
    r -= WI_IN;
    if (r < WI_OUT) {
      const int kb = r / 32, nb = r % 32;
      transpose_item(w_out + (size_t)l * DM * DM, DM, kb * 64, nb * 32, DM, nullptr, (GAS bf16_t*)(ws + WS_WOUT) + (size_t)l * DM * DM, DM, nb * 32, kb * 64, scr, lane);
      continue; }
    r -= WI_OUT;
    if (r < WI_UP) {
      const int kb = r / 176, nb = r % 176;
      const int drow = nb * 32, pn = drow >> 8, j = drow & 255;
      const int src = (j < 128) ? (128 * pn + j) : (DFF + 128 * pn + (j - 128));
      transpose_item(w_up + (size_t)l * DM * 2 * DFF, 2 * DFF, kb * 64, src, 2 * DFF, nffn + l * DM, (GAS bf16_t*)(ws + WS_WUP) + (size_t)l * 2 * DFF * DM, DM, drow, kb * 64, scr, lane);
      continue; }
    r -= WI_UP;
    {
      const int kb = r / 32, nb = r % 32;
      transpose_item(w_dn + (size_t)l * DFF * DM, DM, kb * 64, nb * 32, DM, nullptr, (GAS bf16_t*)(ws + WS_WDN) + (size_t)l * DM * DFF, DFF, nb * 32, kb * 64, scr, lane);
    }
  }
}

__device__ __forceinline__ void phase_prologue(const Params& p, LAS unsigned char* lds) {
  const int tid = threadIdx.x, lane = tid & 63, wave = tid >> 6;
  const int gw = blockIdx.x * 8 + wave, NGW = gridDim.x * 8;
  LAS float* scr = (LAS float*)(lds + wave * 16384);
  unsigned char* ws = p.ws;
  convert_weights((const GAS float*)p.in[11], (const GAS float*)p.in[10], (const GAS float*)p.in[28], (const GAS float*)p.in[30], (const GAS float*)p.in[29], (const GAS float*)p.in[33], (GAS unsigned char*)ws, 0, 0, WI_IN + WI_OUT + WI_UP, gw, NGW, scr, lane);
  {
    bf16_t* lo = (bf16_t*)(ws + WS_LORA);
    for (int idx = blockIdx.x * 512 + tid; idx < DEPTH * AH * 16384; idx += gridDim.x * 512) {
      const int l = idx / (AH * 16384), h = (idx / 16384) % AH, e = idx % 16384;
      float v;
      if (e < 4096) v = p.in[14][((size_t)l * 64 + (e & 63)) * AW + h * 64 + (e >> 6)];
      else if (e < 8192) v = p.in[16][((size_t)l * 64 + (e & 63)) * AW + h * 64 + ((e - 4096) >> 6)];
      else v = p.in[17][((size_t)l * 128 + ((e - 8192) & 127)) * AW + h * 64 + ((e - 8192) >> 7)];
      lo[idx] = (bf16_t)f2bf(v);
    }
  }
  {
    bf16_t* zr = (bf16_t*)(ws + WS_ZROW); bf16_t* shb = (bf16_t*)(ws + WS_SHIFTB);
    for (int idx = blockIdx.x * 512 + tid; idx < 4096 + DEPTH * SBN * ACOLS; idx += gridDim.x * 512) {
      if (idx < 4096) zr[idx] = 0; else shb[idx - 4096] = (bf16_t)f2bf(p.in[2][idx - 4096]);
    }
    bf16_t* cvb = (bf16_t*)(ws + WS_CONVB);
    for (int idx = blockIdx.x * 512 + tid; idx < DEPTH * SBN * 3 * 1024; idx += gridDim.x * 512) cvb[idx] = (bf16_t)f2bf(p.in[4][idx]);
  }
  float* ss = (float*)(ws + WS_SS);
  bf16_t* Xb0 = (bf16_t*)(ws + WS_XB0);
  for (int r = gw; r < MPAD; r += NGW) {
    const float* src = nullptr;
    if (r < R_SAMP) src = p.in[0] + (size_t)r * DM;
    else if (r < R_META) src = p.in[1] + (size_t)(r - R_SAMP) * DM;
    else if (r < R_TOT) src = p.in[9] + (size_t)((r - R_META) & 15) * DM;
    float s = 0.f;
#pragma unroll
    for (int j = 0; j < 4; ++j) {
      f32x4 v = src ? *(const GAS f32x4*)((const GAS float*)src + 256 * j + 4 * lane) : (f32x4){0.f, 0.f, 0.f, 0.f};
      u32x2 w; w.x = pk2(v[0], v[1]); w.y = pk2(v[2], v[3]);
      *(GAS u32x2*)((GAS bf16_t*)Xb0 + (size_t)r * DM + 256 * j + 4 * lane) = w;
      s += v[0] * v[0] + v[1] * v[1] + v[2] * v[2] + v[3] * v[3];
    }
    s = wave_sum(s);
    if (lane == 0) *(GAS f32x4*)((GAS float*)ss + (size_t)r * 4) = (f32x4){s, 0.f, 0.f, 0.f};
  }
}

constexpr int RW_NPROMPT = NB * AH * 65, RW_NITEMS = RW_NPROMPT + SBN * AH;
constexpr int LDB = 72;
constexpr int ARRB = 64 * LDB * 2;
constexpr int LDF = 68;
constexpr int LDT = 65;
constexpr int L_R1 = 0;
constexpr int L_R2 = L_R1 + 8 * ARRB;
constexpr int L_R3 = L_R2 + 4 * ARRB;
constexpr int L_R4 = L_R3 + 2 * 64 * LDF * 4;
constexpr int L_R5 = L_R4 + ARRB;
constexpr int L_RWEND = L_R5 + (8 * 64 + 64 + 64) * 4;
static_assert(2 * 64 * LDT * 4 <= 2 * 64 * LDF * 4, "Tf + Zf fit in R3");
static_assert(L_RWEND <= 163840, "rwkv LDS");

__device__ __forceinline__ void rw_decode(int item, int& seq, int& h, int& chunk) {
  if (item < RW_NPROMPT) { chunk = item % 65; const int sh = item / 65; h = sh & 7; seq = sh >> 3; }
  else { const int r = item - RW_NPROMPT; chunk = 0; h = r & 7; seq = NB + (r >> 3); }
}
__device__ __forceinline__ int rw_row(int seq, int chunk, int t) {
  if (seq < NB) return chunk == 0 ? (R_META + 16 * seq + t) : (SEQ * seq + 64 * (chunk - 1) + t);
  return R_SAMP + 16 * (seq - NB) + t;
}
__device__ __forceinline__ bf16x8 ldfrag(const LAS bf16_t* p) { return *(const LAS bf16x8*)p; }
__device__ __forceinline__ bf16x8 ldfrag(const GAS bf16_t* p) { return *(const GAS bf16x8*)p; }
template <int K, class PX, class PY>
__device__ __forceinline__ f32x4 mma_nt(PX X, int ldx, PY Y, int ldy, int lane, f32x4 acc) {
  const int r = lane & 15, q = lane >> 4;
#pragma unroll
  for (int s = 0; s < K / 32; ++s) {
    const bf16x8 xb = ldfrag(X + r * ldx + 32 * s + 8 * q);
    const bf16x8 ya = ldfrag(Y + r * ldy + 32 * s + 8 * q);
    acc = __builtin_amdgcn_mfma_f32_16x16x32_bf16(ya, xb, acc, 0, 0, 0);
  }
  return acc;
}
template <int K, bool SWX, bool SWY, class PX, class PY>
__device__ __forceinline__ f32x4 mma_sw(PX X, int ldx, int xt, PY Y, int ldy, int yt, int lane, f32x4 acc) {
  const int r = lane & 15, q = lane >> 4;
  const int sx = SWX ? ((2 * xt + (r >> 3)) & 7) : 0, sy = SWY ? ((2 * yt + (r >> 3)) & 7) : 0;
#pragma unroll
  for (int s = 0; s < K / 32; ++s) {
    const bf16x8 xb = ldfrag(X + r * ldx + 8 * ((4 * s + q) ^ sx));
    const bf16x8 ya = ldfrag(Y + r * ldy + 8 * ((4 * s + q) ^ sy));
    acc = __builtin_amdgcn_mfma_f32_16x16x32_bf16(ya, xb, acc, 0, 0, 0);
  }
  return acc;
}
__device__ __forceinline__ u32x2 pack4(f32x4 v) { u32x2 w; w.x = pk2(v[0], v[1]); w.y = pk2(v[2], v[3]); return w; }

__device__ __forceinline__ const GAS bf16_t* rw_prev_row(const Ctx p, int l, int seq, int chunk, int t) {
  const GAS bf16_t* P = (const GAS bf16_t*)(p.ws + WS_BIG);
  if (t > 0) return P + (size_t)rw_row(seq, chunk, t - 1) * PLD;
  if (seq >= NB) return (const GAS bf16_t*)(p.ws + WS_SHIFTB) + ((size_t)l * SBN + (seq - NB)) * ACOLS;
  if (chunk == 0) return (const GAS bf16_t*)(p.ws + WS_ZROW);
  return P + (size_t)(chunk == 1 ? (R_META + 16 * seq + 15) : (rw_row(seq, chunk, 0) - 1)) * PLD;
}
__device__ __forceinline__ GAS bf16_t* rw_trec(GAS unsigned char* ws, int l, int item) {
  const int lo = 1 - l;
  if (item < 1408) return (GAS bf16_t*)(ws + WS_WUP + (size_t)lo * 2 * DFF * DM * 2) + (size_t)item * 4096;
  if (item < 2112) return (GAS bf16_t*)(ws + WS_WDN + (size_t)lo * DM * DFF * 2) + (size_t)(item - 1408) * 4096;
  return (GAS bf16_t*)(ws + WS_WOUT + (size_t)lo * DM * DM * 2) + (size_t)(item - 2112) * 4096;
}
static_assert(DEPTH == 2 && RW_NITEMS == 2208, "T record placement");
constexpr int RW_LC = 62;
constexpr int RW_NLITE = 1984;
static_assert((size_t)MPAD * DM * 2 + (size_t)RW_NLITE * 16384 <= (size_t)NB * SEQ * DM * 4, "Qh / Yhat records fit behind MIX in d_out");
__device__ __forceinline__ GAS bf16_t* rw_qrec(const Ctx p, int l, int seq, int h, int chunk) {
  if (seq < NB && chunk < RW_LC) return (GAS bf16_t*)p.out + (size_t)MPAD * DM + (size_t)((seq * 8 + h) * RW_LC + chunk) * 8192;
  const int hidx = seq < NB ? (seq * 8 + h) * 3 + (chunk - RW_LC) : NB * 8 * 3 + (seq - NB) * 8 + h;
  return (GAS bf16_t*)(p.ws + WS_WUP + (size_t)(1 - l) * 2 * DFF * DM * 2) + (size_t)hidx * 8192;
}
struct RwPref { u32x4 lc[4], lp[4], rc[3], rp[3]; };
template <int LIST>
__device__ __forceinline__ void rw_item_ids(int h, int k, int& seq, int& chunk, int& item) {
  if (LIST == 0) {
    if (k < NB * 65) { seq = k / 65; chunk = k - seq * 65; } else { seq = NB + (k - NB * 65); chunk = 0; }
  } else if (LIST == 1) {
    if (k < NB * 3) { seq = k / 3; chunk = RW_LC + (k - seq * 3); } else { seq = NB + (k - NB * 3); chunk = 0; }
  } else { seq = k / RW_LC; chunk = k - seq * RW_LC; }
  item = seq < NB ? (seq * 8 + h) * 65 + chunk : RW_NPROMPT + (seq - NB) * 8 + h;
}
template <int MODE, int LIST>
__device__ __forceinline__ void rw_prefetch(const Ctx p, int l, int h, int k, int tid, RwPref& pf) {
  int seq, chunk, item; rw_item_ids<LIST>(h, k, seq, chunk, item);
  const int ntok = (chunk == 0) ? 16 : 64;
  const GAS bf16_t* P = (const GAS bf16_t*)(p.ws + WS_BIG);
  const u32x4 z = (u32x4){0u, 0u, 0u, 0u};
  const int grp = MODE == 1 ? (tid & 31) : (tid & 15), colL = 1536 + 8 * grp;
#pragma unroll
  for (int u = 0; u < (MODE == 1 ? 4 : 2); ++u) {
    const int t = MODE == 1 ? ((tid >> 5) + 16 * u) : ((tid >> 4) + 32 * u);
    if (t < ntok) { pf.lc[u] = *(const u32x4*)(P + (size_t)rw_row(seq, chunk, t) * PLD + colL); pf.lp[u] = *(const u32x4*)(rw_prev_row(p, l, seq, chunk, t) + colL); }
    else { pf.lc[u] = z; pf.lp[u] = z; }
  }
  const int t2 = tid >> 3, hc0 = h * 64 + 8 * (tid & 7);
  if (t2 < ntok) {
    const GAS bf16_t* rb = P + (size_t)rw_row(seq, chunk, t2) * PLD; const GAS bf16_t* pb = rw_prev_row(p, l, seq, chunk, t2);
#pragma unroll
    for (int part = 0; part < 3; ++part) { pf.rc[part] = *(const u32x4*)(rb + part * 512 + hc0); pf.rp[part] = *(const u32x4*)(pb + part * 512 + hc0); }
  } else {
#pragma unroll
    for (int part = 0; part < 3; ++part) { pf.rc[part] = z; pf.rp[part] = z; }
  }
}
__device__ __forceinline__ void unpack8(const u32x4 w, float* o) { o[0] = bflo(w.x); o[1] = bfhi(w.x); o[2] = bflo(w.y); o[3] = bfhi(w.y); o[4] = bflo(w.z); o[5] = bfhi(w.z); o[6] = bflo(w.w); o[7] = bfhi(w.w); }

typedef short s16x4_t __attribute__((ext_vector_type(4)));
__device__ __forceinline__ bf16x8 ldfrag_tr(const LAS bf16_t* ARR, int ct, int s, int lane) {
  const int g = lane >> 4, i = lane & 15;
  const LAS bf16_t* p = ARR + (32 * s + 8 * g + (i >> 2)) * LDB + 16 * ct + 4 * (i & 3);
  const s16x4_t lo = __builtin_amdgcn_ds_read_tr16_b64_v4i16((LAS s16x4_t*)p), hi = __builtin_amdgcn_ds_read_tr16_b64_v4i16((LAS s16x4_t*)(p + 4 * LDB));
  u32x4 w; w.x = __builtin_bit_cast(u32x2, lo).x; w.y = __builtin_bit_cast(u32x2, lo).y; w.z = __builtin_bit_cast(u32x2, hi).x; w.w = __builtin_bit_cast(u32x2, hi).y;
  return __builtin_bit_cast(bf16x8, w);
}
template <bool TX, bool TY>
__device__ __forceinline__ f32x4 mma_tt(const LAS bf16_t* X, int xt, const LAS bf16_t* Y, int yt, int lane, f32x4 acc) {
  const int r = lane & 15, q = lane >> 4;
#pragma unroll
  for (int s = 0; s < 2; ++s) {
    const bf16x8 xb = TX ? ldfrag_tr(X, xt, s, lane) : ldfrag(X + (16 * xt + r) * LDB + 32 * s + 8 * q);
    const bf16x8 ya = TY ? ldfrag_tr(Y, yt, s, lane) : ldfrag(Y + (16 * yt + r) * LDB + 32 * s + 8 * q);
    acc = __builtin_amdgcn_mfma_f32_16x16x32_bf16(ya, xb, acc, 0, 0, 0);
  }
  return acc;
}

constexpr int L_PRM = L_RWEND;
static_assert(L_PRM + 640 * 4 <= 163824, "rwkv params LDS");

template <int MODE>
__device__ __forceinline__ void rwkv_phase(const Ctx p, int l, LAS unsigned char* lds, int rep) {
  const int tid0 = opaque_tid(p.wv);
  const int h = p.bid & 7, slot = p.bid >> 3, nslot = p.nblk >> 3;
  constexpr int LIST = MODE;
  constexpr int NK = MODE == 0 ? NB * 65 + SBN : NB * 3 + SBN;
  LAS bf16_t* A_row = (LAS bf16_t*)(lds + L_R1);            LAS bf16_t* B_row = A_row + 64 * LDB;  LAS bf16_t* K_row = B_row + 64 * LDB;  LAS bf16_t* R_row = K_row + 64 * LDB;
  LAS bf16_t* AT = R_row + 64 * LDB;  LAS bf16_t* VT = AT + 64 * LDB;  LAS bf16_t* BCT = VT + 64 * LDB;  LAS bf16_t* KCT = BCT + 64 * LDB;
  static_assert(MODE == 0, "only the state pass is kept up to date (token-major operand arrays + transposed reads); the output side is rwkv_phase_lite");
  LAS bf16_t* WT = AT; LAS bf16_t* X1T = B_row; LAS bf16_t* UT = K_row;
  LAS bf16_t* V_row = VT; LAS bf16_t* BC_row = BCT; LAS bf16_t* KC_row = KCT;
  LAS bf16_t* XW = (LAS bf16_t*)(lds + L_R2); LAS bf16_t* XA = XW + 64 * LDB; LAS bf16_t* XG = XA + 64 * LDB;
  LAS bf16_t* Aak = (LAS bf16_t*)(lds + L_R2); LAS bf16_t* Arb = Aak + 64 * LDB; LAS bf16_t* Ark = Arb + 64 * LDB; LAS bf16_t* Tb = Ark + 64 * LDB;
  LAS float* F0 = (LAS float*)(lds + L_R3); LAS float* F1 = F0 + 64 * LDF;
  LAS float* Tf = (LAS float*)(lds + L_R3); LAS float* Zf = Tf + 64 * LDT;
  LAS bf16_t* Gb = (LAS bf16_t*)(lds + L_R4);
  LAS float* segsum = (LAS float*)(lds + L_R5); LAS float* cumC = segsum + 512; LAS float* bonS = cumC + 64;
  LAS float* prm = (LAS float*)(lds + L_PRM);
  constexpr int LDG = 136;
  const GAS bf16_t* P = (const GAS bf16_t*)(p.ws + WS_BIG);

  if (tid0 < 192) prm[tid0] = p.in[12][(size_t)l * ACOLS + (tid0 >> 6) * 512 + h * 64 + (tid0 & 63)];
  else if (tid0 < 256) {
    const int c = tid0 - 192, hc = l * AW + h * 64 + c;
    prm[192 + c] = p.in[13][hc]; prm[256 + c] = p.in[15][hc]; prm[320 + c] = p.in[18][hc]; prm[384 + c] = p.in[19][hc]; prm[448 + c] = p.in[20][hc];
    prm[512 + c] = p.in[21][hc]; prm[576 + c] = p.in[22][hc];
  }
  float muL[8];
  { const GAS float* mu = p.in[12] + (size_t)l * ACOLS + 1536 + 8 * (MODE == 1 ? (tid0 & 31) : (tid0 & 15));
#pragma unroll
    for (int i = 0; i < 8; ++i) muL[i] = mu[i]; }
  const GAS bf16_t* w2T = (const GAS bf16_t*)(p.ws + WS_LORA) + ((size_t)l * AH + h) * 16384;
  const GAS bf16_t* a2T = w2T + 4096; const GAS bf16_t* g2T = w2T + 8192;

  const bool bal = (MODE == 0) && (nslot == 32);
  int xk = -1;
  if (bal && slot < 26 && (p.bid % 13) >= 9) { int rank = 0; for (int s2 = 0; s2 < slot; ++s2) rank += ((h + 8 * s2) % 13) >= 9 ? 1 : 0; if (rank < 8) xk = 256 + rank; }
  const int nmine = bal ? (slot < 26 ? (xk >= 0 ? 9 : 8) : 10) : (MODE == 1 ? (NK - (nslot - 1 - slot) + nslot - 1) / nslot : (NK - slot + nslot - 1) / nslot);
#define RW_KTH(j) (MODE == 1 ? (nslot - 1 - slot) + (j) * nslot : bal ? ((j) < 8 ? (j) * 32 + slot : (slot < 26 ? xk : 264 + ((j) - 8) * 6 + (slot - 26))) : (slot + (j) * nslot))
  const int lane_h = tid0 & 63, fr = lane_h & 15, fq = lane_h >> 4, jt0_ = ((tid0 >> 6) & 1) * 2;
    bf16x8 fw[2][2], fa[2][2], fg[2][4];
#pragma unroll
    for (int jj = 0; jj < 2; ++jj) {
#pragma unroll
      for (int s = 0; s < 2; ++s) { fw[jj][s] = *(const bf16x8*)(w2T + (16 * (jt0_ + jj) + fr) * 64 + 32 * s + 8 * fq); fa[jj][s] = *(const bf16x8*)(a2T + (16 * (jt0_ + jj) + fr) * 64 + 32 * s + 8 * fq); }
      if (MODE == 1) {
#pragma unroll
        for (int s = 0; s < 4; ++s) fg[jj][s] = *(const bf16x8*)(g2T + (16 * (jt0_ + jj) + fr) * 128 + 32 * s + 8 * fq);
      }
    }
  RwPref pf;
  int jj = 0;
  if (jj < nmine * rep) rw_prefetch<MODE, LIST>(p, l, h, RW_KTH(jj % nmine), tid0, pf);
  __syncthreads();
#pragma unroll 1
  for (; jj < nmine * rep; ++jj) {
    const int k = RW_KTH(jj % nmine);
    int tid = tid0; asm volatile("" : "+v"(tid));
    const int lane = tid & 63, wave = tid >> 6, fr = lane & 15, fq = lane >> 4, t = tid >> 3, cg = tid & 7, c0 = 8 * cg, hc0 = h * 64 + c0;
    int seq, chunk, item; rw_item_ids<LIST>(h, k, seq, chunk, item);
    const bool samp = seq >= NB; const int sb = seq - NB;
    const int ntok = (chunk == 0) ? 16 : 64;
    const int it_ = wave >> 1, jt0_ = (wave & 1) * 2;
    const bool sto = (MODE == 0);
    {
      const int grp = MODE == 1 ? (tid & 31) : (tid & 15);
#pragma unroll
      for (int u = 0; u < (MODE == 1 ? 4 : 2); ++u) {
        const int tt = MODE == 1 ? ((tid >> 5) + 16 * u) : ((tid >> 4) + 32 * u);
        float cur[8], prv[8], o[8];
        unpack8(pf.lc[u], cur); unpack8(pf.lp[u], prv);
        const bool valid = tt < ntok;
#pragma unroll
        for (int i = 0; i < 8; ++i) {
          const float pm = cur[i] + (prv[i] - cur[i]) * muL[i];
          const float sg = __builtin_amdgcn_rcpf(1.f + __expf(grp < 8 ? -2.f * pm : -pm));
          o[i] = grp < 8 ? 2.f * sg - 1.f : (grp < 16 ? pm : sg);
          if (!valid) o[i] = 0.f;
        }
        u32x4 w; w.x = pk2(o[0], o[1]); w.y = pk2(o[2], o[3]); w.z = pk2(o[4], o[5]); w.w = pk2(o[6], o[7]);
        if (grp < 8) *(LAS u32x4*)(XW + tt * LDB + 8 * grp) = w;
        else if (grp < 16) *(LAS u32x4*)(XA + tt * LDB + 8 * (grp - 8)) = w;
        else if (MODE == 1) *(LAS u32x4*)(XG + tt * LDG + 8 * (grp - 16)) = w;
      }
    }
    __syncthreads();
    {
#pragma unroll
      for (int jj = 0; jj < 2; ++jj) {
        const int jt = jt0_ + jj;
        f32x4 aw = (f32x4){0.f, 0.f, 0.f, 0.f}, aa = aw;
#pragma unroll
        for (int s = 0; s < 2; ++s) {
          aw = __builtin_amdgcn_mfma_f32_16x16x32_bf16(fw[jj][s], ldfrag(XW + (16 * it_ + fr) * LDB + 32 * s + 8 * fq), aw, 0, 0, 0);
          aa = __builtin_amdgcn_mfma_f32_16x16x32_bf16(fa[jj][s], ldfrag(XA + (16 * it_ + fr) * LDB + 32 * s + 8 * fq), aa, 0, 0, 0);
        }
        *(LAS f32x4*)(F0 + (16 * it_ + fr) * LDF + 16 * jt + 4 * fq) = aw;
        *(LAS f32x4*)(F1 + (16 * it_ + fr) * LDF + 16 * jt + 4 * fq) = aa;
        if (MODE == 1) {
          f32x4 ag = (f32x4){0.f, 0.f, 0.f, 0.f};
#pragma unroll
          for (int s = 0; s < 4; ++s) ag = __builtin_amdgcn_mfma_f32_16x16x32_bf16(fg[jj][s], ldfrag(XG + (16 * it_ + fr) * LDG + 32 * s + 8 * fq), ag, 0, 0, 0);
          *(LAS u32x2*)(Gb + (16 * it_ + fr) * LDB + 16 * jt + 4 * fq) = pack4(ag);
        }
      }
    }
    __syncthreads();
    float rr[8], kb[8], k2[8], vv[8], lw[8], nk[8];
    {
      const bool valid = t < ntok;
      float kraw[8];
#pragma unroll
      for (int part = 0; part < 3; ++part) {
        float cur[8], prv[8];
        unpack8(pf.rc[part], cur); unpack8(pf.rp[part], prv);
#pragma unroll
        for (int i = 0; i < 8; ++i) { const float pm = cur[i] + (prv[i] - cur[i]) * prm[part * 64 + c0 + i]; if (part == 0) rr[i] = pm; else if (part == 1) kraw[i] = pm; else vv[i] = pm; }
      }
      const f32x4 dw0 = *(const LAS f32x4*)(F0 + t * LDF + c0), dw1 = *(const LAS f32x4*)(F0 + t * LDF + c0 + 4);
      const f32x4 da0 = *(const LAS f32x4*)(F1 + t * LDF + c0), da1 = *(const LAS f32x4*)(F1 + t * LDF + c0 + 4);
      float nrm = 0.f, bon = 0.f, av[8];
#pragma unroll
      for (int i = 0; i < 8; ++i) {
        const float dwv = i < 4 ? dw0[i & 3] : dw1[i & 3], dav = i < 4 ? da0[i & 3] : da1[i & 3];
        lw[i] = valid ? -0.60653065971263342f * sigmoidf_(prm[192 + c0 + i] + dwv) : 0.f;
        av[i] = sigmoidf_(prm[256 + c0 + i] + dav);
        nk[i] = kraw[i] * prm[320 + c0 + i];
        nrm += nk[i] * nk[i];
        k2[i] = kraw[i] * (1.f + (av[i] - 1.f) * prm[384 + c0 + i]);
        bon += rr[i] * k2[i] * prm[448 + c0 + i];
      }
      nrm += __shfl_xor(nrm, 1); nrm += __shfl_xor(nrm, 2); nrm += __shfl_xor(nrm, 4);
      bon += __shfl_xor(bon, 1); bon += __shfl_xor(bon, 2); bon += __shfl_xor(bon, 4);
      const float rn = rsqrtf(nrm + 1e-12f);
#pragma unroll
      for (int i = 0; i < 8; ++i) { nk[i] *= rn; kb[i] = nk[i] * av[i]; }
      if (MODE == 1 && cg == 0) bonS[t] = bon;
      if (MODE == 0 && cg == 0) ((GAS float*)(p.ws + WS_BONUS))[(size_t)item * 64 + t] = bon;
      *(LAS f32x4*)(F0 + t * LDF + c0) = (f32x4){lw[0], lw[1], lw[2], lw[3]};
      *(LAS f32x4*)(F0 + t * LDF + c0 + 4) = (f32x4){lw[4], lw[5], lw[6], lw[7]};
    }
    __syncthreads();
    {
      const int c = tid & 63, seg = tid >> 6;
      float s = 0.f;
#pragma unroll
      for (int i = 0; i < 8; ++i) { s += F0[(8 * seg + i) * LDF + c]; F0[(8 * seg + i) * LDF + c] = s; }
      segsum[seg * 64 + c] = s;
      __syncthreads();
      float off = 0.f;
      for (int s2 = 0; s2 < seg; ++s2) off += segsum[s2 * 64 + c];
#pragma unroll
      for (int i = 0; i < 8; ++i) F0[(8 * seg + i) * LDF + c] += off;
      if (seg == 7) cumC[c] = s + off;
    }
    __syncthreads();
    {
      const f32x4 cu0 = *(const LAS f32x4*)(F0 + t * LDF + c0), cu1 = *(const LAS f32x4*)(F0 + t * LDF + c0 + 4);
      float oa[8], ob[8], ok[8], orr[8], obc[8], okc[8];
#pragma unroll
      for (int i = 0; i < 8; ++i) {
        const float cu = i < 4 ? cu0[i & 3] : cu1[i & 3], cc = cumC[c0 + i];
        const float ec = __expf(cu), em1 = __expf(cu - lw[i]), ei = __expf(-cu), eC = __expf(cc - cu);
        oa[i] = -nk[i] * em1; ob[i] = kb[i] * ei; ok[i] = k2[i] * ei; orr[i] = rr[i] * ec; obc[i] = kb[i] * eC; okc[i] = k2[i] * eC;
      }
      u32x4 w;
      w.x = pk2(oa[0], oa[1]); w.y = pk2(oa[2], oa[3]); w.z = pk2(oa[4], oa[5]); w.w = pk2(oa[6], oa[7]); *(LAS u32x4*)(A_row + t * LDB + c0) = w;
      w.x = pk2(ob[0], ob[1]); w.y = pk2(ob[2], ob[3]); w.z = pk2(ob[4], ob[5]); w.w = pk2(ob[6], ob[7]); *(LAS u32x4*)(B_row + t * LDB + c0) = w;
      w.x = pk2(ok[0], ok[1]); w.y = pk2(ok[2], ok[3]); w.z = pk2(ok[4], ok[5]); w.w = pk2(ok[6], ok[7]); *(LAS u32x4*)(K_row + t * LDB + c0) = w;
      if (MODE == 1 || sto) { w.x = pk2(orr[0], orr[1]); w.y = pk2(orr[2], orr[3]); w.z = pk2(orr[4], orr[5]); w.w = pk2(orr[6], orr[7]); *(LAS u32x4*)(R_row + t * LDB + c0) = w; }
      w.x = pk2(vv[0], vv[1]); w.y = pk2(vv[2], vv[3]); w.z = pk2(vv[4], vv[5]); w.w = pk2(vv[6], vv[7]); *(LAS u32x4*)(V_row + t * LDB + c0) = w;
      w.x = pk2(obc[0], obc[1]); w.y = pk2(obc[2], obc[3]); w.z = pk2(obc[4], obc[5]); w.w = pk2(obc[6], obc[7]); *(LAS u32x4*)(BC_row + t * LDB + c0) = w;
      w.x = pk2(okc[0], okc[1]); w.y = pk2(okc[2], okc[3]); w.z = pk2(okc[4], okc[5]); w.w = pk2(okc[6], okc[7]); *(LAS u32x4*)(KC_row + t * LDB + c0) = w;
    }
    if (jj + 1 < nmine * rep) { int tidp = tid; asm volatile("" : "+v"(tidp)); rw_prefetch<MODE, LIST>(p, l, h, RW_KTH((jj + 1) % nmine), tidp, pf); }
    GAS bf16_t* MTg = (GAS bf16_t*)(p.ws + WS_AUX) + (size_t)item * 8192;
    u32x4 trec = (u32x4){0u, 0u, 0u, 0u};
    if (MODE == 1) trec = *(const GAS u32x4*)(rw_trec(p.ws, l, item) + t * 64 + c0);
    GAS bf16_t* Ng = MTg + 4096;
    __syncthreads();
    {
      const int it = wave >> 1, jt0 = (wave & 1) * 2;
#pragma unroll
      for (int jj = 0; jj < 2; ++jj) {
        const int jt = jt0 + jj, i = 16 * it + fr, j0 = 16 * jt + 4 * fq;
        f32x4 z = (f32x4){0.f, 0.f, 0.f, 0.f};
        f32x4 ab = z, ak = z;
        if (jt <= it) {
          if (MODE == 0) ab = mma_nt<64>(A_row + 16 * it * LDB, LDB, B_row + 16 * jt * LDB, LDB, lane, ab);
          ak = mma_nt<64>(A_row + 16 * it * LDB, LDB, K_row + 16 * jt * LDB, LDB, lane, ak);
        }
#pragma unroll
        for (int u = 0; u < 4; ++u) { if (j0 + u >= i) { ab[u] = 0.f; ak[u] = 0.f; } if (MODE == 0) Tf[i * LDT + j0 + u] = ab[u]; }
        *(LAS u32x2*)(Aak + i * LDB + j0) = pack4(ak);
        if (MODE == 1 || sto) {
          f32x4 rb = z, rk = z;
          if (jt <= it) {
            rb = mma_nt<64>(R_row + 16 * it * LDB, LDB, B_row + 16 * jt * LDB, LDB, lane, rb);
            rk = mma_nt<64>(R_row + 16 * it * LDB, LDB, K_row + 16 * jt * LDB, LDB, lane, rk);
          }
#pragma unroll
          for (int u = 0; u < 4; ++u) if (j0 + u > i) { rb[u] = 0.f; rk[u] = 0.f; }
          *(LAS u32x2*)(Arb + i * LDB + j0) = pack4(rb);
          *(LAS u32x2*)(Ark + i * LDB + j0) = pack4(rk);
        }
      }
    }
    if (MODE == 1) *(LAS u32x4*)(Tb + t * LDB + c0) = trec;
    __syncthreads();
    if (MODE == 0) {
    if (tid < 64) {
      const int b = tid >> 4, j = tid & 15; const LAS float* Ab = Tf + (16 * b) * LDT + 16 * b;
      float x[16];
#pragma unroll
      for (int i = 0; i < 16; ++i) {
        float s = (i == j) ? 1.f : 0.f;
#pragma unroll
        for (int m = 0; m < i; ++m) s += Ab[i * LDT + m] * x[m];
        x[i] = (i < j) ? 0.f : s;
      }
#pragma unroll
      for (int i = 0; i < 16; ++i) Tf[(16 * b + i) * LDT + 16 * b + j] = x[i];
    }
    __syncthreads();
    if (wave < 2) {
      const int r0 = 32 * wave + 16, cb = 32 * wave, lm = lane & 15, lk = lane >> 4;
      f32x4 z = (f32x4){0.f, 0.f, 0.f, 0.f};
#pragma unroll
      for (int ks = 0; ks < 4; ++ks) z = __builtin_amdgcn_mfma_f32_16x16x4f32(Tf[(r0 + lm) * LDT + cb + 4 * ks + lk], Tf[(cb + 4 * ks + lk) * LDT + cb + lm], z, 0, 0, 0);
#pragma unroll
      for (int r = 0; r < 4; ++r) Zf[(r0 + 4 * lk + r) * LDT + cb + lm] = z[r];
      asm volatile("s_waitcnt lgkmcnt(0)" ::: "memory");
      f32x4 o = (f32x4){0.f, 0.f, 0.f, 0.f};
#pragma unroll
      for (int ks = 0; ks < 4; ++ks) o = __builtin_amdgcn_mfma_f32_16x16x4f32(Tf[(r0 + lm) * LDT + r0 + 4 * ks + lk], Zf[(r0 + 4 * ks + lk) * LDT + cb + lm], o, 0, 0, 0);
#pragma unroll
      for (int r = 0; r < 4; ++r) Tf[(r0 + 4 * lk + r) * LDT + cb + lm] = o[r];
    }
    __syncthreads();
    if (wave < 4) {
      const int ti = wave >> 1, tj = wave & 1, lm = lane & 15, lk = lane >> 4;
      f32x4 z = (f32x4){0.f, 0.f, 0.f, 0.f};
#pragma unroll
      for (int ks = 0; ks < 8; ++ks) z = __builtin_amdgcn_mfma_f32_16x16x4f32(Tf[(32 + 16 * ti + lm) * LDT + 4 * ks + lk], Tf[(4 * ks + lk) * LDT + 16 * tj + lm], z, 0, 0, 0);
#pragma unroll
      for (int r = 0; r < 4; ++r) Zf[(32 + 16 * ti + 4 * lk + r) * LDT + 16 * tj + lm] = z[r];
    } else {
      const int w4 = tid - 256;
#pragma unroll
      for (int q = 0; q < 2; ++q) {
        const int idx = w4 + 256 * q;
        if (idx < 384) {
          const int row = idx < 256 ? (idx >> 3) : 32 + ((idx - 256) >> 2), ch = idx < 256 ? (idx & 7) : 4 + ((idx - 256) & 3);
          float o[8];
#pragma unroll
          for (int i = 0; i < 8; ++i) o[i] = Tf[row * LDT + 8 * ch + i];
          u32x4 w; w.x = pk2(o[0], o[1]); w.y = pk2(o[2], o[3]); w.z = pk2(o[4], o[5]); w.w = pk2(o[6], o[7]);
          *(LAS u32x4*)(Tb + row * LDB + 8 * ch) = w;
        }
      }
    }
    __syncthreads();
    if (wave < 4) {
      const int ti = wave >> 1, tj = wave & 1, lm = lane & 15, lk = lane >> 4;
      f32x4 o = (f32x4){0.f, 0.f, 0.f, 0.f};
#pragma unroll
      for (int ks = 0; ks < 8; ++ks) o = __builtin_amdgcn_mfma_f32_16x16x4f32(Tf[(32 + 16 * ti + lm) * LDT + 32 + 4 * ks + lk], Zf[(32 + 4 * ks + lk) * LDT + 16 * tj + lm], o, 0, 0, 0);
#pragma unroll
      for (int r = 0; r < 4; ++r) Tb[(32 + 16 * ti + 4 * lk + r) * LDB + 16 * tj + lm] = (bf16_t)f2bf(o[r]);
    }
    __syncthreads();
    }
    bf16x8 s0f[4][2];
    if (MODE == 1 && wave < 4) {
#pragma unroll
      for (int jt = 0; jt < 4; ++jt)
#pragma unroll
        for (int s = 0; s < 2; ++s) s0f[jt][s] = *(const bf16x8*)(Ng + (16 * jt + fr) * 64 + 32 * s + 8 * fq);
    }
    {
      const int it = wave >> 1, jt0 = (wave & 1) * 2;
#pragma unroll
      for (int jj = 0; jj < 2; ++jj) {
        const int jt = jt0 + jj, i = 16 * it + fr, j0 = 16 * jt + 4 * fq;
        f32x4 z = (f32x4){0.f, 0.f, 0.f, 0.f};
        const f32x4 wt = mma_tt<true, false>(A_row, it, Tb, jt, lane, z);
        const f32x4 x1 = mma_tt<true, false>(V_row, it, Aak, jt, lane, z);
        *(LAS u32x2*)(WT + i * LDB + j0) = pack4(wt);
        *(LAS u32x2*)(X1T + i * LDB + j0) = pack4(x1);
      }
    }
    __syncthreads();
    {
      const int it = wave >> 1, jt0 = (wave & 1) * 2;
#pragma unroll
      for (int jj = 0; jj < 2; ++jj) {
        const int jt = jt0 + jj, i = 16 * it + fr, j0 = 16 * jt + 4 * fq;
        const f32x4 ut = mma_nt<64>(X1T + 16 * it * LDB, LDB, Tb + 16 * jt * LDB, LDB, lane, (f32x4){0.f, 0.f, 0.f, 0.f});
        *(LAS u32x2*)(UT + i * LDB + j0) = pack4(ut);
      }
    }
    __syncthreads();
    if (MODE == 0) {
      const int it = wave >> 1, jt0 = (wave & 1) * 2;
      u32x2 recp[4][2];
#pragma unroll
      for (int a_ = 0; a_ < 4; ++a_) { recp[a_][0] = (u32x2){0u, 0u}; recp[a_][1] = (u32x2){0u, 0u}; }
#pragma unroll
      for (int jj = 0; jj < 2; ++jj) {
        const int jt = jt0 + jj, i = 16 * it + fr, j0 = 16 * jt + 4 * fq;
        f32x4 z = (f32x4){0.f, 0.f, 0.f, 0.f};
        f32x4 mt = mma_tt<true, false>(BC_row, it, WT, jt, lane, z);
#pragma unroll
        for (int u = 0; u < 4; ++u) if (j0 + u == i) mt[u] += __expf(cumC[i]);
        recp[0][jj] = pack4(mt);
        f32x4 nn = mma_tt<false, true>(UT, it, BC_row, jt, lane, z);
        nn = mma_tt<true, true>(V_row, it, KC_row, jt, lane, nn);
        recp[1][jj] = pack4(nn);
        if (sto) {
          f32x4 qh = mma_nt<64>(Arb + 16 * it * LDB, LDB, WT + 16 * jt * LDB, LDB, lane, z);
          const u32x2 rv = *(const LAS u32x2*)(R_row + i * LDB + j0);
          qh[0] += bflo(rv.x); qh[1] += bfhi(rv.x); qh[2] += bflo(rv.y); qh[3] += bfhi(rv.y);
          recp[2][jj] = pack4(qh);
          f32x4 yh = mma_nt<64>(Arb + 16 * it * LDB, LDB, UT + 16 * jt * LDB, LDB, lane, z);
          yh = mma_tt<false, true>(Ark, it, V_row, jt, lane, yh);
          recp[3][jj] = pack4(yh);
        }
      }
      {
        const int ro = (16 * it + fr) * 64 + 32 * (jt0 >> 1) + 8 * fq;
        GAS bf16_t* Qg = rw_qrec(p, l, seq, h, chunk);
        u32x4 w;
        w.x = recp[0][0].x; w.y = recp[0][0].y; w.z = recp[0][1].x; w.w = recp[0][1].y; *(GAS u32x4*)(MTg + ro) = w;
        w.x = recp[1][0].x; w.y = recp[1][0].y; w.z = recp[1][1].x; w.w = recp[1][1].y; *(GAS u32x4*)(Ng + ro) = w;
        if (sto) {
          w.x = recp[2][0].x; w.y = recp[2][0].y; w.z = recp[2][1].x; w.w = recp[2][1].y; *(GAS u32x4*)(Qg + ro) = w;
          w.x = recp[3][0].x; w.y = recp[3][0].y; w.z = recp[3][1].x; w.w = recp[3][1].y; *(GAS u32x4*)(Qg + 4096 + ro) = w;
        }
      }
      const bool lastc = samp ? true : (chunk == 64);
      if (h == 0 && lastc) {
        const int lastrow = samp ? (R_SAMP + 16 * sb + 15) : (SEQ * seq + SEQ - 1);
        GAS float* sh = p.out + (samp ? O_SSHIFT : O_PSHIFT) + ((size_t)l * (samp ? SBN : NB) + (samp ? sb : seq)) * ACOLS;
        for (int e = tid; e < ACOLS; e += 512) sh[e] = bf2f(P[(size_t)lastrow * PLD + e]);
      }
    } else {
      {
        const int it = wave >> 1, jt0 = (wave & 1) * 2;
#pragma unroll
        for (int jj = 0; jj < 2; ++jj) {
          const int jt = jt0 + jj, i = 16 * it + fr, j0 = 16 * jt + 4 * fq;
          f32x4 qh = mma_nt<64>(Arb + 16 * it * LDB, LDB, WT + 16 * jt * LDB, LDB, lane, (f32x4){0.f, 0.f, 0.f, 0.f});
          const u32x2 rv = *(const LAS u32x2*)(R_row + i * LDB + j0);
          qh[0] += bflo(rv.x); qh[1] += bfhi(rv.x); qh[2] += bflo(rv.y); qh[3] += bfhi(rv.y);
          *(LAS u32x2*)(R_row + i * LDB + j0) = pack4(qh);
        }
      }
      __syncthreads();
      LAS float* OUTf = F0;
      if (wave < 4) {
        const int it = wave, i = 16 * it + fr;
        f32x4 y[4];
        float s1 = 0.f, s2 = 0.f;
#pragma unroll
        for (int jt = 0; jt < 4; ++jt) {
          f32x4 a = (f32x4){0.f, 0.f, 0.f, 0.f};
#pragma unroll
          for (int s = 0; s < 2; ++s) a = __builtin_amdgcn_mfma_f32_16x16x32_bf16(s0f[jt][s], ldfrag(R_row + (16 * it + fr) * LDB + 32 * s + 8 * fq), a, 0, 0, 0);
          a = mma_nt<64>(Arb + 16 * it * LDB, LDB, UT + 16 * jt * LDB, LDB, lane, a);
          a = mma_sw<64, false, true>(Ark + 16 * it * LDB, LDB, it, VT + 16 * jt * LDB, LDB, jt, lane, a);
          y[jt] = a;
          s1 += a[0] + a[1] + a[2] + a[3];
        }
        s1 += __shfl_xor(s1, 16); s1 += __shfl_xor(s1, 32);
        const float mean = s1 * (1.f / 64.f);
#pragma unroll
        for (int jt = 0; jt < 4; ++jt) { y[jt] = y[jt] - mean; s2 += y[jt][0] * y[jt][0] + y[jt][1] * y[jt][1] + y[jt][2] * y[jt][2] + y[jt][3] * y[jt][3]; }
        s2 += __shfl_xor(s2, 16); s2 += __shfl_xor(s2, 32);
        const float rs = rsqrtf(s2 * (1.f / 64.f) + GN_EPS);
#pragma unroll
        for (int jt = 0; jt < 4; ++jt) *(LAS f32x4*)(OUTf + i * LDF + 16 * jt + 4 * fq) = y[jt] * rs;
      }
      __syncthreads();
      if (t < ntok) {
        const f32x4 y0 = *(const LAS f32x4*)(OUTf + t * LDF + c0), y1 = *(const LAS f32x4*)(OUTf + t * LDF + c0 + 4);
        const u32x4 gw = *(const LAS u32x4*)(Gb + t * LDB + c0);
        const float g[8] = {bflo(gw.x), bfhi(gw.x), bflo(gw.y), bfhi(gw.y), bflo(gw.z), bfhi(gw.z), bflo(gw.w), bfhi(gw.w)};
        const float bon = bonS[t];
        float o[8];
#pragma unroll
        for (int i = 0; i < 8; ++i) {
          const float yn = i < 4 ? y0[i & 3] : y1[i & 3];
          o[i] = (yn * prm[512 + c0 + i] + prm[576 + c0 + i] + bon * vv[i]) * g[i];
        }
        u32x4 w; w.x = pk2(o[0], o[1]); w.y = pk2(o[2], o[3]); w.z = pk2(o[4], o[5]); w.w = pk2(o[6], o[7]);
        *(GAS u32x4*)((GAS bf16_t*)p.out + (size_t)rw_row(seq, chunk, t) * DM + hc0) = w;
      }
    }
    __syncthreads();
  }
}

__device__ __forceinline__ void rwkv_phase_lite(const Ctx p, int l, LAS unsigned char* lds) {
  const int tid0 = opaque_tid(p.wv);
  const int h = p.bid & 7, slot = p.bid >> 3, nslot = p.nblk >> 3;
  constexpr int NK = NB * 65 + SBN;
  constexpr int LDG = 136;
  LAS bf16_t* XG = (LAS bf16_t*)(lds + L_R2) + 128 * LDB;
  LAS float* OUTl = (LAS float*)(lds + L_R3);
  LAS bf16_t* Gb = (LAS bf16_t*)(lds + L_R4);
  LAS float* prm = (LAS float*)(lds + L_PRM);
  if (tid0 < 64) prm[128 + tid0] = p.in[12][(size_t)l * ACOLS + 2 * 512 + h * 64 + tid0];
  else if (tid0 < 128) { const int c = tid0 - 64, hc = l * AW + h * 64 + c; prm[512 + c] = p.in[21][hc]; prm[576 + c] = p.in[22][hc]; }
  float muL[8];
  { const GAS float* mu = p.in[12] + (size_t)l * ACOLS + 1536 + 128 + 8 * (tid0 & 15);
#pragma unroll
    for (int i = 0; i < 8; ++i) muL[i] = mu[i]; }
  const GAS bf16_t* g2T = (const GAS bf16_t*)(p.ws + WS_LORA) + ((size_t)l * AH + h) * 16384 + 8192;
  const GAS bf16_t* P = (const GAS bf16_t*)(p.ws + WS_BIG);
  const GAS float* bonG = (const GAS float*)(p.ws + WS_BONUS);
  const int nmine = (NK - slot + nslot - 1) / nslot;
  u32x4 glc[2], glp[2], vc, vp; float bonp;
#define LITE_PREFETCH(kk, tidx) do { int seq_, chunk_, item_; rw_item_ids<0>(h, (kk), seq_, chunk_, item_); const int ntok_ = (chunk_ == 0) ? 16 : 64; const u32x4 z_ = (u32x4){0u, 0u, 0u, 0u}; \
    _Pragma("unroll") for (int u = 0; u < 2; ++u) { const int t_ = ((tidx) >> 4) + 32 * u; \
      if (t_ < ntok_) { glc[u] = *(const GAS u32x4*)(P + (size_t)rw_row(seq_, chunk_, t_) * PLD + 1536 + 128 + 8 * ((tidx) & 15)); glp[u] = *(const GAS u32x4*)(rw_prev_row(p, l, seq_, chunk_, t_) + 1536 + 128 + 8 * ((tidx) & 15)); } \
      else { glc[u] = z_; glp[u] = z_; } } \
    { const int t2_ = (tidx) >> 3, hc0_ = h * 64 + 8 * ((tidx) & 7); \
      if (t2_ < ntok_) { vc = *(const GAS u32x4*)(P + (size_t)rw_row(seq_, chunk_, t2_) * PLD + 1024 + hc0_); vp = *(const GAS u32x4*)(rw_prev_row(p, l, seq_, chunk_, t2_) + 1024 + hc0_); } else { vc = z_; vp = z_; } \
      bonp = bonG[(size_t)item_ * 64 + t2_]; } } while (0)
  glc[0] = glc[1] = glp[0] = glp[1] = vc = vp = (u32x4){0u, 0u, 0u, 0u}; bonp = 0.f;
  if (nmine > 0) LITE_PREFETCH(slot, tid0);
  bf16x8 fg2[2][4];
  { const int lane0 = tid0 & 63, wave0 = tid0 >> 6, fr0 = lane0 & 15, fq0 = lane0 >> 4, jt00 = (wave0 & 1) * 2;
#pragma unroll
    for (int jj = 0; jj < 2; ++jj)
#pragma unroll
      for (int s2 = 0; s2 < 4; ++s2) fg2[jj][s2] = *(const GAS bf16x8*)(g2T + (16 * (jt00 + jj) + fr0) * 128 + 32 * s2 + 8 * fq0);
  }
  __syncthreads();
#pragma unroll 1
  for (int jj = 0; jj < nmine; ++jj) {
    const int k = slot + jj * nslot;
    int tid = tid0; asm volatile("" : "+v"(tid));
    const int lane = tid & 63, wave = tid >> 6, fr = lane & 15, fq = lane >> 4, t = tid >> 3, c0 = 8 * (tid & 7), hc0 = h * 64 + c0;
    int seq, chunk, item; rw_item_ids<0>(h, k, seq, chunk, item);
    const int ntok = (chunk == 0) ? 16 : 64;
    const int it_ = wave >> 1, jt0_ = (wave & 1) * 2;
    const GAS bf16_t* Qg = rw_qrec(p, l, seq, h, chunk); const GAS bf16_t* Yg = Qg + 4096;
    const GAS bf16_t* S0g = (const GAS bf16_t*)(p.ws + WS_AUX) + (size_t)item * 8192 + 4096;
    bf16x8 s0l[4][2], qhl[2]; u32x2 yhl[4];
    if (wave < 4) {
#pragma unroll
      for (int jt = 0; jt < 4; ++jt)
#pragma unroll
        for (int s2 = 0; s2 < 2; ++s2) s0l[jt][s2] = *(const GAS bf16x8*)(S0g + (16 * jt + fr) * 64 + 32 * s2 + 8 * fq);
#pragma unroll
      for (int s2 = 0; s2 < 2; ++s2) qhl[s2] = *(const GAS bf16x8*)(Qg + (16 * wave + fr) * 64 + 32 * s2 + 8 * fq);
#pragma unroll
      for (int s2 = 0; s2 < 2; ++s2) { const u32x4 d = *(const GAS u32x4*)(Yg + (size_t)(16 * wave + fr) * 64 + 32 * s2 + 8 * fq); yhl[2 * s2].x = d.x; yhl[2 * s2].y = d.y; yhl[2 * s2 + 1].x = d.z; yhl[2 * s2 + 1].y = d.w; }
    }
#pragma unroll
    for (int u = 0; u < 2; ++u) {
      const int tt = (tid >> 4) + 32 * u;
      float cur[8], prv[8], o[8];
      unpack8(glc[u], cur); unpack8(glp[u], prv);
#pragma unroll
      for (int i = 0; i < 8; ++i) { const float pm = cur[i] + (prv[i] - cur[i]) * muL[i]; o[i] = (tt < ntok) ? sigmoidf_(pm) : 0.f; }
      u32x4 w; w.x = pk2(o[0], o[1]); w.y = pk2(o[2], o[3]); w.z = pk2(o[4], o[5]); w.w = pk2(o[6], o[7]);
      *(LAS u32x4*)(XG + tt * LDG + 8 * (tid & 15)) = w;
    }
    float vv2[8]; const float bon2 = bonp;
    {
      float cur[8], prv[8];
      unpack8(vc, cur); unpack8(vp, prv);
#pragma unroll
      for (int i = 0; i < 8; ++i) vv2[i] = cur[i] + (prv[i] - cur[i]) * prm[128 + c0 + i];
    }
    __syncthreads();
    if (jj + 1 < nmine) { int tidp = tid; asm volatile("" : "+v"(tidp)); LITE_PREFETCH(slot + (jj + 1) * nslot, tidp); }
#pragma unroll
    for (int j2 = 0; j2 < 2; ++j2) {
      const int jt = jt0_ + j2;
      f32x4 ag = (f32x4){0.f, 0.f, 0.f, 0.f};
#pragma unroll
      for (int s2 = 0; s2 < 4; ++s2) ag = __builtin_amdgcn_mfma_f32_16x16x32_bf16(fg2[j2][s2], ldfrag(XG + (16 * it_ + fr) * LDG + 32 * s2 + 8 * fq), ag, 0, 0, 0);
      *(LAS u32x2*)(Gb + (16 * it_ + fr) * LDB + 16 * jt + 4 * fq) = pack4(ag);
    }
    if (wave < 4) {
      const int i = 16 * wave + fr;
      f32x4 y[4];
      float s1 = 0.f, s2v = 0.f;
#pragma unroll
      for (int jt = 0; jt < 4; ++jt) {
        const u32x2 yh = yhl[jt];
        f32x4 a = (f32x4){bflo(yh.x), bfhi(yh.x), bflo(yh.y), bfhi(yh.y)};
#pragma unroll
        for (int s2 = 0; s2 < 2; ++s2) a = __builtin_amdgcn_mfma_f32_16x16x32_bf16(s0l[jt][s2], qhl[s2], a, 0, 0, 0);
        y[jt] = a;
        s1 += a[0] + a[1] + a[2] + a[3];
      }
      s1 += __shfl_xor(s1, 16); s1 += __shfl_xor(s1, 32);
      const float mean = s1 * (1.f / 64.f);
#pragma unroll
      for (int jt = 0; jt < 4; ++jt) { y[jt] = y[jt] - mean; s2v += y[jt][0] * y[jt][0] + y[jt][1] * y[jt][1] + y[jt][2] * y[jt][2] + y[jt][3] * y[jt][3]; }
      s2v += __shfl_xor(s2v, 16); s2v += __shfl_xor(s2v, 32);
      const float rs = rsqrtf(s2v * (1.f / 64.f) + GN_EPS);
#pragma unroll
      for (int jt = 0; jt < 4; ++jt) *(LAS f32x4*)(OUTl + i * LDF + 16 * jt + 4 * fq) = y[jt] * rs;
    }
    __syncthreads();
    if (t < ntok) {
      const f32x4 y0 = *(const LAS f32x4*)(OUTl + t * LDF + c0), y1 = *(const LAS f32x4*)(OUTl + t * LDF + c0 + 4);
      float g[8]; unpack8(*(const LAS u32x4*)(Gb + t * LDB + c0), g);
      float o[8];
#pragma unroll
      for (int i = 0; i < 8; ++i) { const float yn = i < 4 ? y0[i & 3] : y1[i & 3]; o[i] = (yn * prm[512 + c0 + i] + prm[576 + c0 + i] + bon2 * vv2[i]) * g[i]; }
      u32x4 w; w.x = pk2(o[0], o[1]); w.y = pk2(o[2], o[3]); w.z = pk2(o[4], o[5]); w.w = pk2(o[6], o[7]);
      *(GAS u32x4*)((GAS bf16_t*)p.out + (size_t)rw_row(seq, chunk, t) * DM + hc0) = w;
    }
    __syncthreads();
  }
#undef LITE_PREFETCH
}

__device__ __forceinline__ void rwkv_scan_chain(const Ctx p, int l, int chain, int vt, int lane, bool dry) {
  const int fr = lane & 15, fq = lane >> 4;
  const bool samp = chain >= 32;
  const int seq = samp ? NB + ((chain - 32) >> 3) : (chain >> 3), h = samp ? ((chain - 32) & 7) : (chain & 7);
  const int nstep = samp ? 1 : 65, item0 = samp ? (RW_NPROMPT + (chain - 32)) : chain * 65;
  f32x4 acc[2][4];
  if (samp) {
#pragma unroll
    for (int u = 0; u < 2; ++u) {
      const GAS float* s0 = p.in[3] + ((((size_t)l * SBN + (seq - NB)) * AH + h) * 64 + 16 * (2 * vt + u) + fr) * 64;
#pragma unroll
      for (int i = 0; i < 4; ++i) acc[u][i] = *(const GAS f32x4*)(s0 + 16 * i + 4 * fq);
    }
  } else {
#pragma unroll
    for (int u = 0; u < 2; ++u)
#pragma unroll
      for (int i = 0; i < 4; ++i) acc[u][i] = (f32x4){0.f, 0.f, 0.f, 0.f};
  }
  GAS bf16_t* base = (GAS bf16_t*)(p.ws + WS_AUX) + (size_t)item0 * 8192;
  bf16x8 am[4][2]; u32x2 nn[2][4];
#pragma unroll
  for (int i = 0; i < 4; ++i) {
#pragma unroll
    for (int s = 0; s < 2; ++s) am[i][s] = *(const GAS bf16x8*)(base + (16 * i + fr) * 64 + 32 * s + 8 * fq);
  }
#pragma unroll
  for (int u = 0; u < 2; ++u)
#pragma unroll
    for (int s = 0; s < 2; ++s) {
      const u32x4 d = *(const GAS u32x4*)(base + 4096 + (16 * (2 * vt + u) + fr) * 64 + 32 * s + 8 * fq);
      nn[u][2 * s].x = d.x; nn[u][2 * s].y = d.y; nn[u][2 * s + 1].x = d.z; nn[u][2 * s + 1].y = d.w;
    }
#pragma unroll 1
  for (int st = 0; st < nstep; ++st) {
    GAS bf16_t* cur = base + (size_t)st * 8192;
    bf16x8 bfr[2][2];
#pragma unroll
    for (int u = 0; u < 2; ++u) {
      u32x2 sp[4];
#pragma unroll
      for (int i = 0; i < 4; ++i) sp[i] = pack4(acc[u][i]);
#pragma unroll
      for (int s = 0; s < 2; ++s) { u32x4 w; w.x = sp[2 * s].x; w.y = sp[2 * s].y; w.z = sp[2 * s + 1].x; w.w = sp[2 * s + 1].y; bfr[u][s] = __builtin_bit_cast(bf16x8, w);
        if (!dry) *(GAS u32x4*)(cur + 4096 + (16 * (2 * vt + u) + fr) * 64 + 32 * s + 8 * fq) = w; }
    }
    f32x4 na[2][4];
#pragma unroll
    for (int u = 0; u < 2; ++u)
#pragma unroll
      for (int i = 0; i < 4; ++i) {
        na[u][i] = (f32x4){bflo(nn[u][i].x), bfhi(nn[u][i].x), bflo(nn[u][i].y), bfhi(nn[u][i].y)};
#pragma unroll
        for (int s = 0; s < 2; ++s) na[u][i] = __builtin_amdgcn_mfma_f32_16x16x32_bf16(am[i][s], bfr[u][s], na[u][i], 0, 0, 0);
      }
    if (st + 1 < nstep) {
      const GAS bf16_t* nx = cur + 8192;
#pragma unroll
      for (int i = 0; i < 4; ++i) {
#pragma unroll
        for (int s = 0; s < 2; ++s) am[i][s] = *(const GAS bf16x8*)(nx + (16 * i + fr) * 64 + 32 * s + 8 * fq);
      }
#pragma unroll
      for (int u = 0; u < 2; ++u)
#pragma unroll
        for (int s = 0; s < 2; ++s) {
          const u32x4 d = *(const GAS u32x4*)(nx + 4096 + (16 * (2 * vt + u) + fr) * 64 + 32 * s + 8 * fq);
          nn[u][2 * s].x = d.x; nn[u][2 * s].y = d.y; nn[u][2 * s + 1].x = d.z; nn[u][2 * s + 1].y = d.w;
        }
    }
#pragma unroll
    for (int u = 0; u < 2; ++u)
#pragma unroll
      for (int i = 0; i < 4; ++i) acc[u][i] = na[u][i];
  }
#pragma unroll
  for (int u = 0; u < 2; ++u) {
    GAS float* so = p.out + (samp ? O_SWKV : O_PWKV) + ((((size_t)l * (samp ? SBN : NB) + (samp ? seq - NB : seq)) * AH + h) * 64 + 16 * (2 * vt + u) + fr) * 64;
#pragma unroll
    for (int i = 0; i < 4; ++i) *(GAS f32x4*)(so + 16 * i + 4 * fq) = acc[u][i];
  }
}

constexpr int ML_QP = 136;
constexpr int ML_TP = 72;
constexpr int ML_HP = 132;
constexpr int M_Q = 0, M_K = M_Q + 64 * ML_QP * 2, M_KT = M_K + 64 * ML_QP * 2, M_VT = M_KT + 128 * ML_TP * 2, M_VS = M_VT + 128 * ML_TP * 2;
constexpr int M_S = M_VS + 128 * ML_TP * 2, M_H = M_S + 64 * LDB * 2, M_SC = M_H + 64 * ML_HP * 4;
constexpr int M_CW = M_SC + (64 * 6 + 256 + 512 + 128 + 16 + 128) * 4;
constexpr int M_END = M_CW + (5 * 256 + 128) * 4;
static_assert(M_END <= 163824, "mlstm LDS");
constexpr size_t AGG_BYTES = 128 * 128 * 2 + 128 * 4 + 256;
constexpr int ML_NG = 14;
__device__ __forceinline__ int ml_gstart(int g) { return g == 0 ? 0 : (g < 9 ? 4 + 5 * (g - 1) : 44 + 4 * (g - 9)); }
__device__ __forceinline__ int ml_glen(int g) { return (g >= 1 && g < 9) ? 5 : 4; }
constexpr size_t WS_AGG_OFF = (size_t)2208 * 16384;
static_assert(AGG_BYTES == 33536 && ML_NG == 14, "WS_BONUS assumes 208 aggregate records of 33536 bytes");
constexpr int ML_NP1 = NB * BH * (ML_NG - 1), ML_NP3 = NB * BH * ML_NG + SBN * BH;

__device__ __forceinline__ int ml_row(int seq, int tau) {
  if (seq < NB) return tau < 16 ? (R_META + 16 * seq + tau) : (SEQ * seq + tau - 16);
  return R_SAMP + 16 * (seq - NB) + tau;
}

struct MlPref { u32x4 xr[7]; u32x4 vq[4]; u32x4 og[2]; float gi, gf; };
__device__ __forceinline__ void ml_chunk_range(bool samp, int grp, int ci, int& tau0, int& ntok) {
  if (samp) { tau0 = 0; ntok = 16; }
  else if (grp == 0) { if (ci == 0) { tau0 = 0; ntok = 16; } else { tau0 = 16 + 64 * (ci - 1); ntok = 64; } }
  else { tau0 = 16 + 64 * (ml_gstart(grp) + ci); ntok = 64; }
}
template <int MODE>
__device__ __forceinline__ void ml_prefetch(const Ctx p, int l, int seq, int hd, int grp, int ci, int tid, MlPref& pf) {
  const bool samp = seq >= NB; const int sb = seq - NB;
  int tau0, ntok; ml_chunk_range(samp, grp, ci, tau0, ntok);
  const GAS bf16_t* P = (const GAS bf16_t*)(p.ws + WS_BIG);
  const int MB = ACOLS;
  const u32x4 z = (u32x4){0u, 0u, 0u, 0u};
  const int cgp = tid & 31, run = tid >> 5, part = cgp >> 4, cc = (cgp & 15) * 8;
  if (MODE == 1 || part == 1) {
    const int cwi = part * 512 + hd * 128 + cc, col = MB + cwi;
#pragma unroll
    for (int rr = 0; rr < 7; ++rr) {
      const int tl = 4 * run + rr - 3, tau = tau0 + tl;
      if (tl >= ntok) pf.xr[rr] = z;
      else if (tau >= 0) pf.xr[rr] = *(const u32x4*)(P + (size_t)ml_row(seq, tau) * PLD + col);
      else if (samp) pf.xr[rr] = *(const u32x4*)((const GAS bf16_t*)(p.ws + WS_CONVB) + (((size_t)l * SBN + sb) * 3 + (3 + tau)) * 1024 + cwi);
      else pf.xr[rr] = z;
    }
  }
  if (tid < 256) {
    const int eg = tid & 15, rn = tid >> 4, e0 = eg * 8;
#pragma unroll
    for (int tt = 0; tt < 4; ++tt) { const int tl = 4 * rn + tt; pf.vq[tt] = (tl < ntok) ? *(const u32x4*)(P + (size_t)ml_row(seq, tau0 + tl) * PLD + MB + 1024 + hd * 128 + e0) : z; }
  }
  if (MODE == 1) {
    const int t = tid >> 3, e0 = (tid & 7) * 16;
    if (t < ntok) { const GAS bf16_t* q = P + (size_t)ml_row(seq, tau0 + t) * PLD + MB + 1536 + hd * 128 + e0; pf.og[0] = *(const u32x4*)q; pf.og[1] = *(const u32x4*)(q + 8); }
    else { pf.og[0] = z; pf.og[1] = z; }
  }
  {
    const int t = tid & 63;
    if (t < ntok) { const size_t rb = (size_t)ml_row(seq, tau0 + t) * PLD + MB + 2048; pf.gi = bf2f(P[rb + hd]); pf.gf = bf2f(P[rb + 4 + hd]); }
    else { pf.gi = 0.f; pf.gf = 0.f; }
  }
}

__device__ __forceinline__ int ml_pos(int d) { return (d & ~31) + 8 * ((d & 15) >> 2) + 4 * ((d >> 4) & 1) + (d & 3); }
template <int MODE>
__device__ __forceinline__ void mlstm_group_item(const Ctx p, int l, int item, LAS unsigned char* lds) {
  const int tid0 = opaque_tid(p.wv);
  int seq, hd, grp;
  if (MODE == 0) { grp = item % (ML_NG - 1); const int sh = item / (ML_NG - 1); hd = sh & 3; seq = sh >> 2; }
  else if (item < NB * BH * ML_NG) { grp = item % ML_NG; const int sh = item / ML_NG; hd = sh & 3; seq = sh >> 2; }
  else { const int r = item - NB * BH * ML_NG; grp = 0; hd = r & 3; seq = NB + (r >> 2); }
  const bool samp = seq >= NB; const int sb = seq - NB;
  const GAS bf16_t* P = (const GAS bf16_t*)(p.ws + WS_BIG);
  LAS bf16_t* Qs = (LAS bf16_t*)(lds + M_Q); LAS bf16_t* Ks = (LAS bf16_t*)(lds + M_K); LAS bf16_t* KT = (LAS bf16_t*)(lds + M_KT);
  LAS bf16_t* VT = (LAS bf16_t*)(lds + M_VT); LAS bf16_t* VS = (LAS bf16_t*)(lds + M_VS); LAS bf16_t* Sb = (LAS bf16_t*)(lds + M_S);
  LAS float* Hf = (LAS float*)(lds + M_H);
  LAS float* aj = (LAS float*)(lds + M_SC); LAS float* At = aj + 64; LAS float* wo = At + 64; LAS float* wsv = wo + 64; LAS float* emt = wsv + 64; LAS float* qn = emt + 64;
  LAS float* rsum = qn + 64; LAS float* part = rsum + 256; LAS float* nvec = part + 512;
  LAS float* cwl = (LAS float*)(lds + M_CW);
  GAS unsigned char* agg = p.ws + WS_AUX + WS_AGG_OFF;
  const int MB = ACOLS;
  const float ib = p.in[25][l * BH + hd], fb = p.in[26][l * BH + hd];
  {
    const int wave0 = tid0 >> 6, lane0 = tid0 & 63, fr0 = lane0 & 15, fq0 = lane0 >> 4;
    (void)wave0; (void)fr0; (void)fq0;
    if (tid0 < 256) {
      const int cwi = (tid0 >> 7) * 512 + hd * 128 + (tid0 & 127);
      const GAS float* cw = p.in[23] + (size_t)l * 4 * 1024 + cwi;
      cwl[tid0] = cw[0]; cwl[256 + tid0] = cw[1024]; cwl[512 + tid0] = cw[2048]; cwl[768 + tid0] = cw[3072]; cwl[1024 + tid0] = p.in[24][(size_t)l * 1024 + cwi];
    }
    else if (MODE == 1 && tid0 < 384) cwl[1280 + (tid0 - 256)] = p.in[27][l * 512 + hd * 128 + (tid0 - 256)];
  }
  f32x4 C[8];
#pragma unroll
  for (int i = 0; i < 8; ++i) C[i] = (f32x4){0.f, 0.f, 0.f, 0.f};
  float m = 0.f;
  {
    const int wave = tid0 >> 6, lane = tid0 & 63, fr = lane & 15, fq = lane >> 4;
    if (MODE == 0) { m = -1e30f; if (tid0 < 128) nvec[tid0] = 0.f; }
    else if (samp) {
      const GAS float* c0 = p.in[5] + (((size_t)l * SBN + sb) * BH + hd) * 128 * 128;
#pragma unroll
      for (int i = 0; i < 8; ++i)
#pragma unroll
        for (int r = 0; r < 4; ++r) C[i][r] = c0[(size_t)(16 * i + 4 * fq + r) * 128 + 16 * wave + fr];
      if (tid0 < 128) nvec[ml_pos(tid0)] = p.in[6][(((size_t)l * SBN + sb) * BH + hd) * 128 + tid0];
      m = p.in[7][((size_t)l * SBN + sb) * BH + hd];
    } else {
      float wgt[ML_NG - 1]; float nreg = 0.f;
      {
        float fm = 0.f;
        float am[ML_NG - 1], bmv[ML_NG - 1];
#pragma unroll
        for (int g2 = 0; g2 < ML_NG - 1; ++g2) { const GAS float* sc = (const GAS float*)(agg + ((size_t)((seq * BH + hd) * (ML_NG - 1) + g2)) * AGG_BYTES + 32768 + 512); am[g2] = g2 < grp ? sc[0] : 0.f; bmv[g2] = g2 < grp ? sc[1] : -1e30f; }
#pragma unroll
        for (int g2 = 0; g2 < ML_NG - 1; ++g2) wgt[g2] = 0.f;
#pragma unroll
        for (int g2 = 0; g2 < ML_NG - 1; ++g2) {
          if (g2 < grp) {
            const float me = fmaxf(fm + am[g2], bmv[g2]), f1 = __expf(fm + am[g2] - me), f2 = __expf(bmv[g2] - me);
#pragma unroll
            for (int g3 = 0; g3 < ML_NG - 1; ++g3) if (g3 < g2) wgt[g3] *= f1;
            wgt[g2] = f2; fm = me;
          }
        }
        m = fm;
      }
#pragma unroll
      for (int g2 = 0; g2 < ML_NG - 1; ++g2) {
        if (g2 < grp) {
          const GAS unsigned char* rec = agg + ((size_t)((seq * BH + hd) * (ML_NG - 1) + g2)) * AGG_BYTES;
#pragma unroll
          for (int ip = 0; ip < 4; ++ip) {
            const u32x4 d = *(const GAS u32x4*)((const GAS bf16_t*)rec + (size_t)((wave * 4 + ip) * 64 + lane) * 8);
            C[2 * ip] += (f32x4){bflo(d.x), bfhi(d.x), bflo(d.y), bfhi(d.y)} * wgt[g2];
            C[2 * ip + 1] += (f32x4){bflo(d.z), bfhi(d.z), bflo(d.w), bfhi(d.w)} * wgt[g2];
          }
          if (tid0 < 128) nreg += ((const GAS float*)(rec + 32768))[tid0] * wgt[g2];
        }
      }
      if (tid0 < 128) nvec[ml_pos(tid0)] = nreg;
    }
  }
  float asum = 0.f;
  const int nchunk = samp ? 1 : ((grp == 0) ? 1 + ml_glen(0) : ml_glen(grp));
  MlPref pf;
  ml_prefetch<MODE>(p, l, seq, hd, grp, 0, tid0, pf);
  __syncthreads();
#pragma unroll 1
  for (int ci = 0; ci < nchunk; ++ci) {
    int tid = tid0; asm volatile("" : "+v"(tid));
    const int lane = tid & 63, wave = tid >> 6, fr = lane & 15, fq = lane >> 4;
    int tau0, ntok; ml_chunk_range(samp, grp, ci, tau0, ntok);
    float s_ws, dec, mnew;
    {
      const bool valid = lane < ntok;
      const float li = valid ? pf.gi + ib : -1e30f;
      const float lf = valid ? -softplusf_(-(pf.gf + fb)) : 0.f;
      float b = lf;
#pragma unroll
      for (int o = 1; o < 64; o <<= 1) { const float v = __shfl_up(b, o); if (lane >= o) b += v; }
      const float a = li - b;
      float A = fmaxf(a, m);
#pragma unroll
      for (int o = 1; o < 64; o <<= 1) { const float v = __shfl_up(A, o); if (lane >= o) A = fmaxf(A, v); }
      const float AL = __shfl(A, 63), bL = __shfl(b, 63);
      s_ws = __expf(a - AL);
      dec = __expf(m - AL); mnew = bL + AL; asum += bL;
      if (wave == 0) { aj[lane] = a; At[lane] = A; wo[lane] = __expf(m - A); wsv[lane] = s_ws; emt[lane] = __expf(-(b + A)); }
    }
    {
      const int cgp = tid & 31, run = tid >> 5, part2 = cgp >> 4, cc = (cgp & 15) * 8;
      if (MODE == 1 || part2 == 1) {
        unsigned wq[4][4];
#pragma unroll
        for (int i2 = 0; i2 < 4; ++i2) {
          float oc[2][4];
#pragma unroll
          for (int hlf = 0; hlf < 2; ++hlf) {
            const int i = 2 * i2 + hlf, wcol = part2 * 128 + cc + i;
            const float w0 = cwl[wcol], w1 = cwl[256 + wcol], w2 = cwl[512 + wcol], w3 = cwl[768 + wcol], bb = cwl[1024 + wcol];
            float xv[7];
#pragma unroll
            for (int rr = 0; rr < 7; ++rr) { const unsigned wd = pf.xr[rr][i2]; xv[rr] = hlf ? bfhi(wd) : bflo(wd); }
#pragma unroll
            for (int tt = 0; tt < 4; ++tt) {
              float val = w0 * xv[tt] + w1 * xv[tt + 1] + w2 * xv[tt + 2] + w3 * xv[tt + 3] + bb;
              val = siluf_(val);
              if (part2 == 1) val *= 0.08838834764831845f;
              if (4 * run + tt >= ntok) val = 0.f;
              oc[hlf][tt] = val;
            }
            if (part2 == 1) { u32x2 w; w.x = pk2(oc[hlf][0], oc[hlf][1]); w.y = pk2(oc[hlf][2], oc[hlf][3]); *(LAS u32x2*)(KT + (cc + i) * ML_TP + ((((run >> 1) ^ (cgp & 7)) << 3) | ((run & 1) << 2))) = w; }
          }
#pragma unroll
          for (int tt = 0; tt < 4; ++tt) wq[tt][i2] = pk2(oc[0][tt], oc[1][tt]);
        }
        const int s32 = cc >> 5, hh = (cc >> 4) & 1, qq = (cc & 15) >> 2;
        LAS bf16_t* dst = (part2 == 0 ? Qs : Ks);
#pragma unroll
        for (int tt = 0; tt < 4; ++tt) {
          u32x2 w0; w0.x = wq[tt][0]; w0.y = wq[tt][1];
          u32x2 w1; w1.x = wq[tt][2]; w1.y = wq[tt][3];
          *(LAS u32x2*)(dst + (4 * run + tt) * ML_QP + 32 * s32 + 8 * qq + 4 * hh) = w0;
          *(LAS u32x2*)(dst + (4 * run + tt) * ML_QP + 32 * s32 + 8 * (qq + 1) + 4 * hh) = w1;
        }
      }
      {
        const int eg = tid & 15, rn = (tid >> 4) & 15, e0 = eg * 8;
        const float w40 = __shfl(s_ws, 4 * rn), w41 = __shfl(s_ws, 4 * rn + 1), w42 = __shfl(s_ws, 4 * rn + 2), w43 = __shfl(s_ws, 4 * rn + 3);
        const int vso = (((rn >> 1) ^ (eg & 7)) << 3) | ((rn & 1) << 2);
        if (tid < 256) {
#pragma unroll
          for (int i2 = 0; i2 < 4; ++i2) {
#pragma unroll
            for (int hlf = 0; hlf < 2; ++hlf) {
              const int i = 2 * i2 + hlf;
              float v0 = hlf ? bfhi(pf.vq[0][i2]) : bflo(pf.vq[0][i2]), v1 = hlf ? bfhi(pf.vq[1][i2]) : bflo(pf.vq[1][i2]);
              float v2 = hlf ? bfhi(pf.vq[2][i2]) : bflo(pf.vq[2][i2]), v3 = hlf ? bfhi(pf.vq[3][i2]) : bflo(pf.vq[3][i2]);
              u32x2 w; w.x = pk2(v0, v1); w.y = pk2(v2, v3); *(LAS u32x2*)(VT + (e0 + i) * ML_TP + vso) = w;
              u32x2 ws2; ws2.x = pk2(v0 * w40, v1 * w41); ws2.y = pk2(v2 * w42, v3 * w43); *(LAS u32x2*)(VS + (e0 + i) * ML_TP + vso) = ws2;
            }
          }
        }
      }
    }
    const u32x4 og0 = pf.og[0], og1 = pf.og[1];
    if (ci + 1 < nchunk) { int tidp = tid0; asm volatile("" : "+v"(tidp)); ml_prefetch<MODE>(p, l, seq, hd, grp, ci + 1, tidp, pf); }
    __syncthreads();
    if (MODE == 1) {
      {
        const int it = wave >> 1, jt0 = (wave & 1) * 2;
        float rs = 0.f;
#pragma unroll
        for (int jj = 0; jj < 2; ++jj) {
          const int jt = jt0 + jj, i = 16 * it + fr, j0 = 16 * jt + 4 * fq;
          f32x4 sc = (f32x4){0.f, 0.f, 0.f, 0.f};
          if (jt <= it) {
            sc = mma_nt<128>(Qs + 16 * it * ML_QP, ML_QP, Ks + 16 * jt * ML_QP, ML_QP, lane, sc);
            const f32x4 a4 = *(const LAS f32x4*)(aj + j0); const float Ai = At[i];
#pragma unroll
            for (int u = 0; u < 4; ++u) { sc[u] = (j0 + u <= i) ? sc[u] * __expf(a4[u] - Ai) : 0.f; rs += sc[u]; }
          }
          *(LAS u32x2*)(Sb + i * LDB + j0) = pack4(sc);
        }
        rs += __shfl_xor(rs, 16); rs += __shfl_xor(rs, 32);
        if (fq == 0) rsum[(16 * it + fr) * 4 + (wave & 1)] = rs;
      }
      {
        const int t = tid >> 3, d0 = (tid & 7) * 16;
        float s = 0.f;
#pragma unroll
        for (int u = 0; u < 2; ++u) {
          float qv[8]; unpack8(*(const LAS u32x4*)(Qs + t * ML_QP + d0 + 8 * u), qv);
          { const f32x4 n0 = *(const LAS f32x4*)(nvec + d0 + 8 * u), n1 = *(const LAS f32x4*)(nvec + d0 + 8 * u + 4);
            s += qv[0] * n0[0] + qv[1] * n0[1] + qv[2] * n0[2] + qv[3] * n0[3] + qv[4] * n1[0] + qv[5] * n1[1] + qv[6] * n1[2] + qv[7] * n1[3]; }
        }
        s += __shfl_xor(s, 1); s += __shfl_xor(s, 2); s += __shfl_xor(s, 4);
        if ((tid & 7) == 0) qn[t] = s;
      }
      __syncthreads();
      {
        bf16x8 cf[4];
#pragma unroll
        for (int s = 0; s < 4; ++s) { const u32x2 lo = pack4(C[2 * s]), hi = pack4(C[2 * s + 1]); u32x4 w; w.x = lo.x; w.y = lo.y; w.z = hi.x; w.w = hi.y; cf[s] = __builtin_bit_cast(bf16x8, w); }
        float p2[4][4];
#pragma unroll
        for (int it = 0; it < 4; ++it) {
          f32x4 acc = (f32x4){0.f, 0.f, 0.f, 0.f};
#pragma unroll
          for (int s = 0; s < 4; ++s) acc = __builtin_amdgcn_mfma_f32_16x16x32_bf16(ldfrag(Qs + (16 * it + fr) * ML_QP + 32 * s + 8 * fq), cf[s], acc, 0, 0, 0);
          const f32x4 w4 = *(const LAS f32x4*)(wo + 16 * it + 4 * fq);
          acc = acc * w4;
#pragma unroll
          for (int s = 0; s < 2; ++s) acc = __builtin_amdgcn_mfma_f32_16x16x32_bf16(ldfrag(Sb + (16 * it + fr) * LDB + 32 * s + 8 * fq), ldfrag(VT + (16 * wave + fr) * ML_TP + 8 * ((4 * s + fq) ^ ((2 * wave + (fr >> 3)) & 7))), acc, 0, 0, 0);
#pragma unroll
          for (int r = 0; r < 4; ++r) {
            const int t = 16 * it + 4 * fq + r;
            const float den = wo[t] * qn[t] + rsum[t * 4] + rsum[t * 4 + 1];
            const float hv = acc[r] * __builtin_amdgcn_rcpf(fmaxf(fabsf(den), emt[t]));
            Hf[t * ML_HP + 16 * wave + fr] = hv;
            float sq = hv * hv;
            sq += __shfl_xor(sq, 1); sq += __shfl_xor(sq, 2); sq += __shfl_xor(sq, 4); sq += __shfl_xor(sq, 8);
            p2[it][r] = sq;
          }
        }
        if (fr == 0) {
#pragma unroll
          for (int it = 0; it < 4; ++it)
#pragma unroll
            for (int r = 0; r < 4; ++r) part[(16 * it + 4 * fq + r) * 8 + wave] = p2[it][r];
        }
      }
    }
    {
#pragma unroll
      for (int i = 0; i < 8; ++i) {
        f32x4 acc = C[i] * dec;
#pragma unroll
        for (int s = 0; s < 2; ++s) acc = __builtin_amdgcn_mfma_f32_16x16x32_bf16(ldfrag(KT + (16 * i + fr) * ML_TP + 8 * ((4 * s + fq) ^ ((2 * i + (fr >> 3)) & 7))), ldfrag(VS + (16 * wave + fr) * ML_TP + 8 * ((4 * s + fq) ^ ((2 * wave + (fr >> 3)) & 7))), acc, 0, 0, 0);
        C[i] = acc;
      }
    }
    __syncthreads();
    {
      f32x4 acc = (f32x4){0.f, 0.f, 0.f, 0.f};
#pragma unroll
      for (int s2 = 0; s2 < 2; ++s2) {
        bf16x8 wb;
        { const f32x4 a0 = *(const LAS f32x4*)(wsv + 32 * s2 + 8 * fq), a1 = *(const LAS f32x4*)(wsv + 32 * s2 + 8 * fq + 4);
          u32x4 w; w.x = pk2(a0[0], a0[1]); w.y = pk2(a0[2], a0[3]); w.z = pk2(a1[0], a1[1]); w.w = pk2(a1[2], a1[3]);
          if (fr != 0) w = (u32x4){0u, 0u, 0u, 0u};
          wb = __builtin_bit_cast(bf16x8, w); }
        acc = __builtin_amdgcn_mfma_f32_16x16x32_bf16(ldfrag(KT + (16 * wave + fr) * ML_TP + 8 * ((4 * s2 + fq) ^ ((2 * wave + (fr >> 3)) & 7))), wb, acc, 0, 0, 0);
      }
      if (fr == 0) {
        LAS float* np = nvec + 32 * (wave >> 1) + 8 * fq + 4 * (wave & 1);
        const f32x4 old = *(const LAS f32x4*)np;
        *(LAS f32x4*)np = old * dec + acc;
      }
    }
    if (MODE == 1) {
      const int t = tid >> 3, e0 = (tid & 7) * 16;
      if (t < ntok) {
        float ps = 0.f;
#pragma unroll
        for (int w = 0; w < 8; ++w) ps += part[t * 8 + w];
        const float rs = rsqrtf(ps * (1.f / 128.f) + RMS_EPS);
        const size_t row = (size_t)ml_row(seq, tau0 + t);
        float og[16]; unpack8(og0, og); unpack8(og1, og + 8);
        float o[16];
#pragma unroll
        for (int i = 0; i < 16; ++i) o[i] = Hf[t * ML_HP + e0 + i] * rs * cwl[1280 + e0 + i] * sigmoidf_(og[i]);
        u32x4 w; w.x = pk2(o[0], o[1]); w.y = pk2(o[2], o[3]); w.z = pk2(o[4], o[5]); w.w = pk2(o[6], o[7]);
        GAS bf16_t* mx = (GAS bf16_t*)p.out + row * DM + 512 + hd * 128 + e0;
        *(u32x4*)mx = w;
        w.x = pk2(o[8], o[9]); w.y = pk2(o[10], o[11]); w.z = pk2(o[12], o[13]); w.w = pk2(o[14], o[15]);
        *(u32x4*)(mx + 8) = w;
      }
    }
    m = mnew;
    __syncthreads();
  }
  {
    const int tid = tid0, lane = tid & 63, wave = tid >> 6, fr = lane & 15, fq = lane >> 4;
    if (MODE == 0) {
      GAS unsigned char* rec = agg + ((size_t)((seq * BH + hd) * (ML_NG - 1) + grp)) * AGG_BYTES;
#pragma unroll
      for (int ip = 0; ip < 4; ++ip) { const u32x2 a = pack4(C[2 * ip]), b = pack4(C[2 * ip + 1]); u32x4 w; w.x = a.x; w.y = a.y; w.z = b.x; w.w = b.y; *(GAS u32x4*)((GAS bf16_t*)rec + (size_t)((wave * 4 + ip) * 64 + lane) * 8) = w; }
      if (tid < 128) ((GAS float*)(rec + 32768))[tid] = nvec[ml_pos(tid)];
      if (tid == 0) { ((GAS float*)(rec + 32768 + 512))[0] = asum; ((GAS float*)(rec + 32768 + 512))[1] = m; }
    } else if (samp || grp == ML_NG - 1) {
      const int nb_ = samp ? SBN : NB, bi = samp ? sb : seq;
      GAS float* co = p.out + (samp ? O_SC : O_PC) + (((size_t)l * nb_ + bi) * BH + hd) * 128 * 128;
#pragma unroll
      for (int i = 0; i < 8; ++i)
#pragma unroll
        for (int r = 0; r < 4; ++r) co[(size_t)(16 * i + 4 * fq + r) * 128 + 16 * wave + fr] = C[i][r];
      if (tid < 128) p.out[(samp ? O_SN : O_PN) + (((size_t)l * nb_ + bi) * BH + hd) * 128 + tid] = nvec[ml_pos(tid)];
      if (tid == 0) p.out[(samp ? O_SM : O_PM) + ((size_t)l * nb_ + bi) * BH + hd] = m;
      if (tid < 256) {
        const int cwi = (tid >> 7) * 512 + hd * 128 + (tid & 127);
        GAS float* cvo = p.out + (samp ? O_SCONV : O_PCONV) + ((size_t)l * nb_ + bi) * 3 * 1024;
        const int last = samp ? 15 : (TP - 1);
#pragma unroll
        for (int j = 0; j < 3; ++j) cvo[j * 1024 + cwi] = bf2f(P[(size_t)ml_row(seq, last - 2 + j) * PLD + MB + cwi]);
      }
    }
  }
  __syncthreads();
}


__device__ __forceinline__ void gates_pass(const Ctx p, int l, unsigned* flag, unsigned need) {
  const int tid = opaque_tid(p.wv), lane = tid & 63, wave = tid >> 6, fr = lane & 15, fq = lane >> 4;
  const int blk = p.bid * 8 + wave;
  if (blk >= R_TOT / 16) return;
  if (blk >= R_SAMP / 16 && need) {
    unsigned sp = 0;
    while ((unsigned)__builtin_amdgcn_readfirstlane(__hip_atomic_load(flag, __ATOMIC_RELAXED, __HIP_MEMORY_SCOPE_AGENT)) < need) { __builtin_amdgcn_s_sleep(2); if (++sp > (1u << 22)) break; }
    __builtin_amdgcn_fence(__ATOMIC_ACQUIRE, "agent");
  }
  const GAS bf16_t* X = (const GAS bf16_t*)(p.ws + WS_XB0) + (size_t)(16 * blk + fr) * DM + 8 * fq;
  const GAS bf16_t* W = (const GAS bf16_t*)(p.ws + WS_WIN) + ((size_t)l * NINP + 3840 + fr) * DM + 8 * fq;
  f32x4 acc = (f32x4){0.f, 0.f, 0.f, 0.f};
#pragma unroll 8
  for (int s = 0; s < DM / 32; ++s) acc = __builtin_amdgcn_mfma_f32_16x16x32_bf16(*(const GAS bf16x8*)(W + 32 * s), *(const GAS bf16x8*)(X + 32 * s), acc, 0, 0, 0);
  if (fq < 2) {
    const int row = 16 * blk + fr;
    const float rs = row_rstd((const GAS float*)(p.ws + WS_SS) + (size_t)(2 * l) * MPAD * 4, row);
    *(GAS u32x2*)((GAS bf16_t*)(p.ws + WS_BIG) + (size_t)row * PLD + 3840 + 4 * fq) = pack4(acc * rs);
  }
}


constexpr int XF_FLAG0 = 3520;
template <bool FINAL>
__device__ __forceinline__ void convert_special(const Ctx p, const GAS float* slab, int nsl, const GAS bf16_t* Xin, GAS bf16_t* Xout, GAS float* ssd, unsigned* flag, const GAS float* nf) {
  const int tid = opaque_tid(p.wv), lane = tid & 63, wave = tid >> 6;
  const int w16 = p.bid - (p.nblk - 16);
#pragma unroll 1
  for (int q = 0; q < 4; ++q) {
    const int r2 = 32 * w16 + 4 * wave + q, row = R_SAMP + r2, tm = r2 >> 8, rin = r2 & 255;
    f32x4 v[4]; float s = 0.f;
#pragma unroll
    for (int j = 0; j < 4; ++j) {
      const u32x2 xi = *(const GAS u32x2*)(Xin + (size_t)row * DM + 256 * j + 4 * lane);
      f32x4 a = (f32x4){bflo(xi.x), bfhi(xi.x), bflo(xi.y), bfhi(xi.y)};
      for (int sl = 0; sl < nsl; ++sl) a += *(const GAS f32x4*)(slab + ((size_t)((tm * 4 + j) * nsl + sl) * 256 + rin) * 256 + 4 * lane);
      v[j] = a; s += a[0] * a[0] + a[1] * a[1] + a[2] * a[2] + a[3] * a[3];
    }
    s = wave_sum(s);
    if (FINAL) {
      const float rs = rsqrtf(s * (1.f / DM) + RMS_EPS);
      if (row < R_META) {
        GAS float* y = p.out + (size_t)row * DM;
#pragma unroll
        for (int j = 0; j < 4; ++j) { const f32x4 g = *(const GAS f32x4*)(nf + 256 * j + 4 * lane); *(GAS f32x4*)(y + 256 * j + 4 * lane) = v[j] * rs * g; }
      }
    } else {
#pragma unroll
      for (int j = 0; j < 4; ++j) {
        u32x2 w; w.x = pk2(v[j][0], v[j][1]); w.y = pk2(v[j][2], v[j][3]);
        *(GAS u32x2*)(Xout + (size_t)row * DM + 256 * j + 4 * lane) = w;
      }
      if (lane == 0) *(GAS f32x4*)(ssd + (size_t)row * 4) = (f32x4){s, 0.f, 0.f, 0.f};
    }
  }
  if (!FINAL) {
    asm volatile("s_waitcnt vmcnt(0)" ::: "memory");
    __syncthreads();
    if (tid == 0) {
      __builtin_amdgcn_fence(__ATOMIC_RELEASE, "agent");
      asm volatile("s_waitcnt vmcnt(0)" ::: "memory");
      __hip_atomic_fetch_add(flag, 1u, __ATOMIC_RELAXED, __HIP_MEMORY_SCOPE_AGENT);
    }
  }
}

__device__ __forceinline__ int prev_row(int r, int d) {
  if (r < R_MAIN) { const int t = r & (SEQ - 1), b = r >> 12; return t >= d ? r - d : (R_META + 16 * b + 16 + (t - d)); }
  if (r < R_META) { const int t = (r - R_SAMP) & 15; return t >= d ? r - d : (-2 - (2 + (t - d))); }
  { const int t = (r - R_META) & 15; return t >= d ? r - d : -1; }
}
__device__ __forceinline__ void ffn_conv8(const float* u0, const float* u1, const float* u2, const float* gt, const GAS float* cw, const GAS float* cb, int ff, GAS bf16_t* dst) {
  float o[8];
#pragma unroll
  for (int i = 0; i < 8; ++i) { const float val = cw[ff + i] * u2[i] + cw[DFF + ff + i] * u1[i] + cw[2 * DFF + ff + i] * u0[i] + cb[ff + i]; o[i] = siluf_(val) * gt[i]; }
  u32x4 w; w.x = pk2(o[0], o[1]); w.y = pk2(o[2], o[3]); w.z = pk2(o[4], o[5]); w.w = pk2(o[6], o[7]);
  *(GAS u32x4*)dst = w;
}
__device__ __forceinline__ void phase_ffn_fixup(const Ctx p, int l) {
  GAS bf16_t* G = (GAS bf16_t*)(p.ws + WS_BIG);
  const GAS bf16_t* UH = G + pg8::FS_UH; const GAS bf16_t* UD = G + pg8::FS_UD; const GAS bf16_t* GD = G + pg8::FS_GD; const GAS bf16_t* US = G + pg8::FS_US; const GAS bf16_t* GS = G + pg8::FS_GS;
  const GAS float* cw = p.in[31] + (size_t)l * 3 * DFF; const GAS float* cb = p.in[32] + (size_t)l * DFF;
  constexpr int NA = 256 * 2 * 352, NBS = 320 * 352, NC = (NB + SBN) * 2 * 352;
  for (int idx = p.bid * 512 + opaque_tid(p.wv); idx < NA + NBS + NC; idx += p.nblk * 512) {
    float u0[8], u1[8], u2[8], gt[8];
    if (idx < NA) {
      const int s = idx / 704, rem = idx - s * 704, j = rem / 352, c0 = (rem - j * 352) * 8;
      load8(UD + ((size_t)s * 2 + j) * DFF + c0, u0); load8(GD + ((size_t)s * 2 + j) * DFF + c0, gt);
      const GAS bf16_t* h1; const GAS bf16_t* h2;
      if ((s & 63) == 0) { const int b = s >> 6; h1 = US + (size_t)(256 + 16 * b + 15) * DFF; h2 = US + (size_t)(256 + 16 * b + 14) * DFF; }
      else { h1 = UH + ((size_t)(s - 1) * 2 + 1) * DFF; h2 = UH + ((size_t)(s - 1) * 2) * DFF; }
      if (j == 0) { load8(h1 + c0, u1); load8(h2 + c0, u2); }
      else { load8(UD + ((size_t)s * 2) * DFF + c0, u1); load8(h1 + c0, u2); }
      ffn_conv8(u0, u1, u2, gt, cw, cb, c0, G + (size_t)(64 * s + j) * DFF + c0);
    } else if (idx < NA + NBS) {
      const int k = idx - NA, r2 = k / 352, c0 = (k - r2 * 352) * 8, t = r2 & 15;
      const bool samp = r2 < 256;
      load8(US + (size_t)r2 * DFF + c0, u0); load8(GS + (size_t)r2 * DFF + c0, gt);
#pragma unroll
      for (int d = 1; d <= 2; ++d) {
        float* dstv = d == 1 ? u1 : u2;
        if (t >= d) load8(US + (size_t)(r2 - d) * DFF + c0, dstv);
        else if (samp) { const GAS float* st = p.in[8] + (((size_t)l * SBN + (r2 >> 4)) * 2 + (2 + (t - d))) * DFF + c0;
#pragma unroll
          for (int i = 0; i < 8; ++i) dstv[i] = st[i]; }
        else {
#pragma unroll
          for (int i = 0; i < 8; ++i) dstv[i] = 0.f; }
      }
      ffn_conv8(u0, u1, u2, gt, cw, cb, c0, G + (size_t)(R_SAMP + r2) * DFF + c0);
    } else {
      const int k = idx - NA - NBS, q = k / 352, c0 = (k - q * 352) * 8, sq = q >> 1, j = q & 1;
      const bool samp = sq >= NB;
      const GAS bf16_t* src = samp ? (US + (size_t)(16 * (sq - NB) + 14 + j) * DFF) : (UH + ((size_t)(64 * sq + 63) * 2 + j) * DFF);
      load8(src + c0, u0);
      GAS float* dst = p.out + (samp ? O_SF : O_PF) + (((size_t)l * (samp ? SBN : NB) + (samp ? sq - NB : sq)) * 2 + j) * DFF + c0;
#pragma unroll
      for (int i = 0; i < 8; ++i) dst[i] = u0[i];
    }
  }
}

__device__ __forceinline__ void phase_final(const Ctx p) {
  const int tid = opaque_tid(p.wv), lane = tid & 63, wave = tid >> 6;
  const int gw = p.bid * 8 + wave, NGW = p.nblk * 8;
  const GAS float* nf = p.in[34];
  const GAS bf16_t* X = (const GAS bf16_t*)(p.ws + WS_XB0);
  for (int r = gw; r < R_MAIN; r += NGW) {
    f32x4 v[4]; float s = 0.f;
#pragma unroll
    for (int j = 0; j < 4; ++j) { const u32x2 xi = *(const GAS u32x2*)(X + (size_t)r * DM + 256 * j + 4 * lane); v[j] = (f32x4){bflo(xi.x), bfhi(xi.x), bflo(xi.y), bfhi(xi.y)}; s += v[j][0] * v[j][0] + v[j][1] * v[j][1] + v[j][2] * v[j][2] + v[j][3] * v[j][3]; }
    s = wave_sum(s);
    const float rs = rsqrtf(s * (1.f / DM) + RMS_EPS);
    GAS float* y = p.out + (size_t)r * DM;
#pragma unroll
    for (int j = 0; j < 4; ++j) { const f32x4 g = *(const GAS f32x4*)(nf + 256 * j + 4 * lane); *(GAS f32x4*)(y + 256 * j + 4 * lane) = v[j] * rs * g; }
  }
}

constexpr int kThreads = 512;
constexpr size_t kDynLds = 163840;

__global__ void __launch_bounds__(512, 2) fwd_megakernel(Params p) {
  extern __shared__ __attribute__((aligned(16))) unsigned char shm[];
  LAS unsigned char* lds = (LAS unsigned char*)shm;
  cg::grid_group grid = cg::this_grid();
#define GSYNC() do { xcd_barrier((unsigned*)cx0.ws, xb_st, opaque_tid(cx0.wv) == 0); if (PROBE_SYNC) xcd_barrier((unsigned*)cx0.ws, xb_st, opaque_tid(cx0.wv) == 0); } while (0)
#define PHASE_CTX() const Ctx cx = opaque_ctx(cx0); const int G = cx.nblk, c = cx.bid; (void)G; (void)c; GAS unsigned char* ws = cx.ws; GAS float* ss = (GAS float*)(ws + WS_SS); GAS float* xmeta = (GAS float*)(ws + WS_XMETA); \
    GAS bf16_t* Xb0 = (GAS bf16_t*)(ws + WS_XB0); GAS bf16_t* Xb1 = (GAS bf16_t*)(ws + WS_XB1); GAS bf16_t* BIG = (GAS bf16_t*)(ws + WS_BIG); (void)ss; (void)xmeta; (void)Xb0; (void)Xb1; (void)BIG;

  volatile LAS unsigned* xb_st = (volatile LAS unsigned*)(lds + 163824);
  if (threadIdx.x == 0) { xb_st[0] = 0u; xb_st[1] = 0u; (void)xb_add(&((unsigned*)p.ws)[XB_XCNT(xb_xcc_id())], 1u); }
#ifndef NO_PRO
  for (int rep = 0; rep < 1 + PROBE_PRO; ++rep) { phase_prologue(p, lds); __syncthreads(); }
#endif
  if (threadIdx.x < 35) ((const float**)(p.ws + WS_TAB))[threadIdx.x] = p.in[threadIdx.x];
  grid.sync();
  Ctx cx0; cx0.out = (GAS float*)p.out; cx0.ws = (GAS unsigned char*)p.ws; cx0.in = (const gcf_t GAS*)(p.ws + WS_TAB); cx0.wv = __builtin_amdgcn_readfirstlane(threadIdx.x >> 6); cx0.bid = blockIdx.x; cx0.nblk = gridDim.x; cx0.pad_ = 0;
#pragma unroll 1
  for (int l0 = 0; l0 < DEPTH; ++l0) {
    {
      PHASE_CTX(); int l = l0; asm volatile("" : "+s"(l));
      unsigned* flag = (unsigned*)ws + XF_FLAG0 + 64 * (2 * l);
      const unsigned need = l > 0 ? 16u : 0u;
      if (l > 0 && c >= G - 16) convert_special<false>(cx, (const GAS float*)(ws + WS_SLAB_OUT), 4, Xb1, Xb0, ss + (size_t)(2 * l) * MPAD * 4, flag, nullptr);
      pg8::Gemm g{(const bf16_t*)Xb0, (const bf16_t*)(ws + WS_WIN) + (size_t)l * NINP * DM, MPAD, 3840, DM, DM};
      pg8::WaitOrder S; S.init(MPAD, 3840, DM, G, c); S.flag = flag; S.need = need; S.wv = cx.wv;
      pg8::EpiScaleBf16 E{BIG, PLD, PLD, ss + (size_t)(2 * l) * MPAD * 4};
      for (int rep = 0; rep < 1 + PROBE_GEMM; ++rep)
      pg8::gemm_phase<pg8::EpiScaleBf16, pg8::WaitOrder>(lds, g, S, E, cx.wv);
      gates_pass(cx, l, flag, need);
    }
    GSYNC();
    {
      PHASE_CTX(); int l = l0; asm volatile("" : "+s"(l));
      if (c < ML_NP1) { for (int rep = 0; rep < 1 + PROBE_P1; ++rep) mlstm_group_item<0>(cx, l, c, lds); }
      rwkv_phase<0>(cx, l, lds, 1 + PROBE_MIXA);
    }
    GSYNC();
    {
      PHASE_CTX(); int l = l0; asm volatile("" : "+s"(l));
      const int tid = opaque_tid(cx.wv), wave = tid >> 6, lane = tid & 63;
      for (int rep = PROBE_SCAN; rep >= 0; --rep) {
        const int chain = c < 32 ? c : 32 + (c - 32) * 2 + (wave >> 2);
        if ((wave & 3) < 2 && (c < 32 ? wave < 2 : c < 96)) rwkv_scan_chain(cx, l, chain, wave & 1, lane, rep > 0);
      }
      if (c >= 32) {
        for (int rep = 0; rep < 1 + PROBE_P3; ++rep) {
          const int it = c - 32;
          const int grp = it % ML_NG, k = (it / ML_NG) * 4 + (grp - 9);
          const int n2 = (it < NB * BH * ML_NG) ? ((grp >= 9 && grp <= 12 && k < SBN * BH) ? 2 : 1) : 0;
          for (int q = 0; q < n2; ++q) mlstm_group_item<1>(cx, l, q == 0 ? it : NB * BH * ML_NG + k, lds);
        }
      }
    }
    GSYNC();
    {
      PHASE_CTX(); int l = l0; asm volatile("" : "+s"(l));
      for (int rep = 0; rep < 1 + PROBE_MIXC; ++rep) rwkv_phase_lite(cx, l, lds);
    }
    GSYNC();
    {
      PHASE_CTX(); int l = l0; asm volatile("" : "+s"(l));
      pg8::Gemm g{(const bf16_t*)cx.out, (const bf16_t*)(ws + WS_WOUT) + (size_t)l * DM * DM, MPAD, DM, DM, DM};
      pg8::TailOrder S; S.init(R_MAIN, DM, DM, G, c); S.nsl = 4;
      pg8::EpiRes E{Xb0, Xb1, ss + (size_t)(2 * l + 1) * MPAD * 4, 1, (GAS float*)(ws + WS_SLAB_OUT), 4, (LAS float*)(lds + 131072)};
      pg8::gemm_phase<pg8::EpiRes, pg8::TailOrder>(lds, g, S, E, cx.wv);
      if (PROBE_OUT) { pg8::EpiRes E2 = E; E2.write_ss = -1; pg8::gemm_phase<pg8::EpiRes, pg8::TailOrder>(lds, g, S, E2, cx.wv); }
    }
    GSYNC();
    {
      PHASE_CTX(); int l = l0; asm volatile("" : "+s"(l));
      unsigned* flag = (unsigned*)ws + XF_FLAG0 + 64 * (2 * l + 1);
      if (c >= G - 16) convert_special<false>(cx, (const GAS float*)(ws + WS_SLAB_OUT), 4, Xb0, Xb1, ss + (size_t)(2 * l + 1) * MPAD * 4, flag, nullptr);
      {
        constexpr int NUP = (MPAD / 256) * (2 * DFF / 256);
        const int lo = NUP % G;
        if (lo && c >= lo) {
          const int tidq = opaque_tid(cx.wv), waveq = tidq >> 6, laneq = tidq & 63, wq = (c - lo) * 8 + waveq, nwq = (G - lo) * 8;
          LAS float* scr = (LAS float*)(lds + waveq * 16384);
          convert_weights(cx.in[11], cx.in[10], cx.in[28], cx.in[30], cx.in[29], cx.in[33], ws, l, WI_IN + WI_OUT + WI_UP, WI_L, wq, nwq, scr, laneq);
          if (l + 1 < DEPTH) convert_weights(cx.in[11], cx.in[10], cx.in[28], cx.in[30], cx.in[29], cx.in[33], ws, l + 1, 0, WI_IN, wq, nwq, scr, laneq);
          __syncthreads();
        } else if (!lo) {
          const int tidq = opaque_tid(cx.wv), waveq = tidq >> 6, laneq = tidq & 63, wq = c * 8 + waveq, nwq = G * 8;
          LAS float* scr = (LAS float*)(lds + waveq * 16384);
          convert_weights(cx.in[11], cx.in[10], cx.in[28], cx.in[30], cx.in[29], cx.in[33], ws, l, WI_IN + WI_OUT + WI_UP, WI_L, wq, nwq, scr, laneq);
          if (l + 1 < DEPTH) convert_weights(cx.in[11], cx.in[10], cx.in[28], cx.in[30], cx.in[29], cx.in[33], ws, l + 1, 0, WI_IN, wq, nwq, scr, laneq);
          __syncthreads();
        }
      }
      pg8::Gemm g{(const bf16_t*)Xb1, (const bf16_t*)(ws + WS_WUP) + (size_t)l * 2 * DFF * DM, MPAD, 2 * DFF, DM, DM};
      pg8::WaitOrder S; S.init(MPAD, 2 * DFF, DM, G, c); S.flag = flag; S.need = 16u; S.wv = cx.wv;
      pg8::EpiUpConv E{BIG, ss + (size_t)(2 * l + 1) * MPAD * 4, cx.in[31] + (size_t)l * 3 * DFF, cx.in[32] + (size_t)l * DFF};
      for (int rep = 0; rep < 1 + PROBE_GEMM; ++rep)
      pg8::gemm_phase<pg8::EpiUpConv, pg8::WaitOrder>(lds, g, S, E, cx.wv);
    }
    GSYNC();
    { PHASE_CTX(); int l = l0; asm volatile("" : "+s"(l)); for (int rep = 0; rep < 1 + PROBE_FIX; ++rep) phase_ffn_fixup(cx, l); }
    GSYNC();
    {
      PHASE_CTX(); int l = l0; asm volatile("" : "+s"(l));
      pg8::Gemm g{(const bf16_t*)BIG, (const bf16_t*)(ws + WS_WDN) + (size_t)l * DM * DFF, MPAD, DM, DFF, DFF};
      pg8::TailOrder S; S.init(R_MAIN, DM, DFF, G, c); S.nsl = 4;
      const int wx = (l + 1 < DEPTH) ? 1 : 0;
      pg8::EpiRes E{Xb1, Xb0, ss + (size_t)(2 * l + 2) * MPAD * 4, wx, (GAS float*)(ws + WS_SLAB_OUT), 4, (LAS float*)(lds + 131072)};
      pg8::gemm_phase<pg8::EpiRes, pg8::TailOrder>(lds, g, S, E, cx.wv);
      if (PROBE_DOWN) { pg8::EpiRes E2 = E; E2.write_ss = -1; pg8::gemm_phase<pg8::EpiRes, pg8::TailOrder>(lds, g, S, E2, cx.wv); }
      if (l + 1 < DEPTH && c >= 32) {
        const int tidq = opaque_tid(cx.wv), waveq = tidq >> 6, laneq = tidq & 63, wq = (c - 32) * 8 + waveq, nwq = (G - 32) * 8;
        LAS float* scr = (LAS float*)(lds + waveq * 16384);
        convert_weights(cx.in[11], cx.in[10], cx.in[28], cx.in[30], cx.in[29], cx.in[33], ws, l + 1, WI_IN, WI_IN + WI_OUT + WI_UP, wq, nwq, scr, laneq);
      }
    }
    GSYNC();
  }
  {
    PHASE_CTX();
    if (c >= G - 16) convert_special<true>(cx, (const GAS float*)(ws + WS_SLAB_OUT), 4, Xb1, nullptr, nullptr, nullptr, cx.in[34]);
  }
  { PHASE_CTX(); phase_final(cx); }
}

extern "C" void kernel_launch(void* const* d_in, const int* in_sizes, int n_in, void* d_out, int out_size, void* d_ws,
                              size_t ws_size, hipStream_t stream) {
  static int grid_blocks = 0;
  if (!grid_blocks) {
    int dev = 0, cus = 0, per_cu = 0;
    (void)hipGetDevice(&dev);
    (void)hipDeviceGetAttribute(&cus, hipDeviceAttributeMultiprocessorCount, dev);
    (void)hipFuncSetAttribute((const void*)fwd_megakernel, hipFuncAttributeMaxDynamicSharedMemorySize, (int)kDynLds);
    (void)hipOccupancyMaxActiveBlocksPerMultiprocessor(&per_cu, fwd_megakernel, kThreads, kDynLds);
    grid_blocks = cus > 0 ? cus : 256;
    if (n_in != 35 || out_size != (int)O_END || ws_size < WS_END) fprintf(stderr, "kernel_launch: unexpected shapes n_in=%d out=%d ws=%zu\n", n_in, out_size, ws_size);
  }
  (void)hipMemsetAsync(d_ws, 0, 16384, stream);
  Params p{};
  for (int i = 0; i < 35; ++i) p.in[i] = (const float*)d_in[i];
  p.out = (float*)d_out;
  p.ws = (unsigned char*)d_ws;
  p.ph_lo = 0; p.ph_hi = 0;
  void* args[] = {&p};
  hipError_t e = hipLaunchCooperativeKernel((void*)fwd_megakernel, dim3(grid_blocks), dim3(kThreads), args, kDynLds, stream);
  if (e != hipSuccess) fprintf(stderr, "cooperative launch failed: %s (grid %d)\n", hipGetErrorString(e), grid_blocks);
}
```

```cpp
#define PROBE_SYNC 0
#define PROBE_MIXA 0
#define PROBE_MIXC 0
#define PROBE_GEMM 0
#define PROBE_ML 0
#define PROBE_PRO 0
#define PROBE_OUT 0
#define PROBE_DOWN 0
#define PROBE_FIX 0
#define PROBE_P1 0
#define PROBE_P3 0
#define PROBE_SCAN 0
#include <hip/hip_runtime.h>
#include <hip/hip_cooperative_groups.h>
#include <cstdio>
#include <cstdint>
namespace cg = cooperative_groups;

#define LAS __attribute__((address_space(3)))
#define GAS __attribute__((address_space(1)))
typedef unsigned short bf16_t;
typedef short bf16x8 __attribute__((ext_vector_type(8)));
typedef float f32x4 __attribute__((ext_vector_type(4)));
typedef unsigned u32x4 __attribute__((ext_vector_type(4)));
typedef unsigned u32x2 __attribute__((ext_vector_type(2)));

constexpr int DM = 1024, NB = 4, SEQ = 4096, NMETA = 16, TP = 4112, DEPTH = 2, SBN = 16, STN = 16;
constexpr int AH = 8, AD = 64, AW = 512, ACOLS = 1792, BH = 4, BD = 128, BCOLS = 2056, DIN = 3848, DFF = 2816, HFF = 1408;
constexpr int R_MAIN = 16384, R_SAMP = 16384, R_META = 16640, R_TOT = 16704, MPAD = 16896;
constexpr int PLD = 3856;
constexpr int NINP = 4096;
constexpr float RMS_EPS = 1e-6f, GN_EPS = 64e-5f;

constexpr size_t O_YP = 0, O_YS = O_YP + (size_t)NB * SEQ * DM, O_PSHIFT = O_YS + (size_t)SBN * STN * DM;
constexpr size_t O_PWKV = O_PSHIFT + (size_t)DEPTH * NB * ACOLS, O_PCONV = O_PWKV + (size_t)DEPTH * NB * AH * AD * AD;
constexpr size_t O_PC = O_PCONV + (size_t)DEPTH * NB * 3 * 1024, O_PN = O_PC + (size_t)DEPTH * NB * BH * BD * BD;
constexpr size_t O_PM = O_PN + (size_t)DEPTH * NB * BH * BD, O_PF = O_PM + (size_t)DEPTH * NB * BH;
constexpr size_t O_SSHIFT = O_PF + (size_t)DEPTH * NB * 2 * DFF;
constexpr size_t O_SWKV = O_SSHIFT + (size_t)DEPTH * SBN * ACOLS, O_SCONV = O_SWKV + (size_t)DEPTH * SBN * AH * AD * AD;
constexpr size_t O_SC = O_SCONV + (size_t)DEPTH * SBN * 3 * 1024, O_SN = O_SC + (size_t)DEPTH * SBN * BH * BD * BD;
constexpr size_t O_SM = O_SN + (size_t)DEPTH * SBN * BH * BD, O_SF = O_SM + (size_t)DEPTH * SBN * BH;
constexpr size_t O_END = O_SF + (size_t)DEPTH * SBN * 2 * DFF;
static_assert(O_END == 21412000, "output size");

constexpr size_t WS_TAB = 32768;
constexpr size_t WS_SS = 65536;
constexpr size_t WS_XMETA = WS_SS + 4 * (size_t)MPAD * 16 + 256;
constexpr size_t WS_LORA = (WS_XMETA + 255) / 256 * 256;
constexpr size_t WS_ZROW = WS_LORA + (size_t)DEPTH * AH * 16384 * 2;
constexpr size_t WS_SHIFTB = WS_ZROW + 8192;
constexpr size_t WS_CONVB = (WS_SHIFTB + (size_t)DEPTH * SBN * ACOLS * 2 + 255) / 256 * 256;
constexpr size_t WS_WIN = (WS_CONVB + (size_t)DEPTH * SBN * 3 * 1024 * 2 + 255) / 256 * 256;
constexpr size_t WS_WOUT = WS_WIN + 2 * (size_t)NINP * DM * 2;
constexpr size_t WS_WUP = WS_WOUT + 2 * (size_t)DM * DM * 2;
constexpr size_t WS_WDN = WS_WUP + 2 * (size_t)2 * DFF * DM * 2;
constexpr size_t WS_XB0 = WS_WDN + 2 * (size_t)2 * DM * HFF * 2;
constexpr size_t WS_BIG = WS_XB0 + (size_t)MPAD * DM * 2;
constexpr size_t WS_AUX = WS_BIG + (size_t)MPAD * PLD * 2;
constexpr size_t WS_XB1 = WS_AUX;
constexpr size_t WS_END = WS_AUX + (size_t)2208 * 16384 + (size_t)8 * 1024 * 1024;
static_assert(WS_END <= 268435456, "workspace");
constexpr size_t WS_SLAB_OUT = WS_AUX + (size_t)MPAD * DM * 2;
static_assert(WS_SLAB_OUT + (size_t)8 * 4 * 65536 * 4 <= 268435456, "slab_out");
constexpr size_t WS_BONUS = WS_AUX + (((size_t)2208 * 16384 + (size_t)208 * 33536 + 255) / 256) * 256;
static_assert(WS_BONUS + (size_t)2208 * 64 * 4 <= WS_END, "bonus scalars fit in AUX");

struct Params {
  const float* in[35];
  float* out;
  unsigned char* ws;
  int ph_lo, ph_hi;
};

typedef const GAS float* gcf_t;
struct Ctx { GAS float* out; GAS unsigned char* ws; const gcf_t GAS* in; int wv; int bid; int nblk; int pad_; };

__device__ __forceinline__ int opaque_tid(int wv) { unsigned z = 0u; asm volatile("" : "+v"(z)); int t = (wv << 6) | (int)__builtin_amdgcn_mbcnt_hi(~0u, __builtin_amdgcn_mbcnt_lo(~0u, z)); asm volatile("" : "+v"(t)); return t; }
__device__ __forceinline__ Ctx opaque_ctx(Ctx c) { asm volatile("" : "+s"(c.out), "+s"(c.ws), "+s"(c.in), "+s"(c.wv), "+s"(c.bid), "+s"(c.nblk)); return c; }

typedef float f32x2_t __attribute__((ext_vector_type(2)));
typedef __bf16 bf16x2_t __attribute__((ext_vector_type(2)));
__device__ __forceinline__ unsigned pk2(float lo, float hi) { const f32x2_t v = {lo, hi}; const bf16x2_t b = __builtin_convertvector(v, bf16x2_t); return __builtin_bit_cast(unsigned, b); }
__device__ __forceinline__ unsigned f2bf(float f) { return pk2(f, 0.f) & 0xffffu; }
__device__ __forceinline__ float bf2f(unsigned b) { return __builtin_bit_cast(float, b << 16); }
__device__ __forceinline__ float bflo(unsigned w) { return __builtin_bit_cast(float, w << 16); }
__device__ __forceinline__ float bfhi(unsigned w) { return __builtin_bit_cast(float, w & 0xffff0000u); }
#define DPP_ADD(x, ctrl) ((x) + __builtin_bit_cast(float, __builtin_amdgcn_update_dpp(0, __builtin_bit_cast(int, (float)(x)), (ctrl), 0xf, 0xf, false)))
__device__ __forceinline__ float add_xor16(float x) { const unsigned b = __builtin_bit_cast(unsigned, x); const auto r = __builtin_amdgcn_permlane16_swap(b, b, false, false); return __builtin_bit_cast(float, (unsigned)r[0]) + __builtin_bit_cast(float, (unsigned)r[1]); }
__device__ __forceinline__ float add_xor32(float x) { const unsigned b = __builtin_bit_cast(unsigned, x); const auto r = __builtin_amdgcn_permlane32_swap(b, b, false, false); return __builtin_bit_cast(float, (unsigned)r[0]) + __builtin_bit_cast(float, (unsigned)r[1]); }
#define DPP_F(idv, x, ctrl, rmask) __builtin_bit_cast(float, __builtin_amdgcn_update_dpp(__builtin_bit_cast(int, (float)(idv)), __builtin_bit_cast(int, (float)(x)), (ctrl), (rmask), 0xf, false))
__device__ __forceinline__ float wave_scan_add(float x) {
  x += DPP_F(0.f, x, 0x111, 0xf); x += DPP_F(0.f, x, 0x112, 0xf); x += DPP_F(0.f, x, 0x114, 0xf); x += DPP_F(0.f, x, 0x118, 0xf);
  x += DPP_F(0.f, x, 0x142, 0xa); x += DPP_F(0.f, x, 0x143, 0xc);
  return x;
}
__device__ __forceinline__ float wave_scan_max(float x) {
  const float ninf = -3.0e38f;
  x = fmaxf(x, DPP_F(ninf, x, 0x111, 0xf)); x = fmaxf(x, DPP_F(ninf, x, 0x112, 0xf)); x = fmaxf(x, DPP_F(ninf, x, 0x114, 0xf)); x = fmaxf(x, DPP_F(ninf, x, 0x118, 0xf));
  x = fmaxf(x, DPP_F(ninf, x, 0x142, 0xa)); x = fmaxf(x, DPP_F(ninf, x, 0x143, 0xc));
  return x;
}
__device__ __forceinline__ float sum8_all(float v) { v = DPP_ADD(v, 0x141); v = DPP_ADD(v, 0xB1); v = DPP_ADD(v, 0x4E); return v; }
__device__ __forceinline__ float wave_sum(float v) { v = DPP_ADD(v, 0x140); v = DPP_ADD(v, 0x141); v = DPP_ADD(v, 0xB1); v = DPP_ADD(v, 0x4E); return add_xor32(add_xor16(v)); }
__device__ __forceinline__ float sum8_first(float v) { v = DPP_ADD(v, 0x104); v = DPP_ADD(v, 0x102); v = DPP_ADD(v, 0x101); return v; }
__device__ __forceinline__ float sum16_first(float v) { v = DPP_ADD(v, 0x108); v = DPP_ADD(v, 0x104); v = DPP_ADD(v, 0x102); v = DPP_ADD(v, 0x101); return v; }
__device__ __forceinline__ float sigmoidf_(float x) { return __builtin_amdgcn_rcpf(1.f + __expf(-x)); }
__device__ __forceinline__ float siluf_(float x) { return x * __builtin_amdgcn_rcpf(1.f + __expf(-x)); }
__device__ __forceinline__ float softplusf_(float x) { return fmaxf(x, 0.f) + __logf(1.f + __expf(-fabsf(x))); }
__device__ __forceinline__ void load8(const GAS bf16_t* p, float* o) {
  const u32x4 w = *(const GAS u32x4*)p;
  o[0] = bflo(w.x); o[1] = bfhi(w.x); o[2] = bflo(w.y); o[3] = bfhi(w.y); o[4] = bflo(w.z); o[5] = bfhi(w.z); o[6] = bflo(w.w); o[7] = bfhi(w.w);
}
__device__ __forceinline__ float row_rstd(const GAS float* ss4, int row) { const f32x4 p = *(const GAS f32x4*)(ss4 + (size_t)row * 4); return rsqrtf((((p[0] + p[1]) + p[2]) + p[3]) * (1.f / DM) + RMS_EPS); }
__device__ __forceinline__ GAS float* xrow_ptr(GAS float* out, GAS float* xmeta, int r) { return r < R_META ? out + (size_t)r * DM : xmeta + (size_t)(r - R_META) * DM; }

namespace pg8 {
constexpr int BM = 256, BK = 64, HALF = 128, HTB = HALF * BK * 2, STAGE_BYTES = 8 * HTB, NXCD = 8, WGM = 8;
__host__ __device__ __forceinline__ int lds_byte(int r, int c) { const int st = (r >> 4) * 2 + (c >> 5), rr = r & 15, cc = c & 31, ob = rr * 64 + cc * 2; return st * 1024 + (ob ^ (((ob >> 9) & 1) << 5)); }
__host__ __device__ __forceinline__ void stage_rc(int b, int& R, int& C) { const int st = b / 1024, sb = b % 1024, swz = sb ^ (((sb >> 9) & 1) << 5); R = (st >> 1) * 16 + swz / 64; C = (st & 1) * 32 + (swz % 64) / 2; }
__host__ __device__ __forceinline__ int perm32(int rho) { const int n = rho >> 4, i = rho & 15; return 8 * (i >> 2) + 4 * n + (i & 3); }
struct Unit { int pm, pn, kofs, nt, slice; };
struct Gemm { const bf16_t* A; const bf16_t* Bt; int M, N, K, lda; };
struct StaticOrder {
  int nM, nN, nwg, G, c, ntf;
  __device__ void init(int M, int N, int K, int G_, int c_) { nM = M / BM; nN = N / BM; nwg = nM * nN; G = G_; c = c_; ntf = K / BK; }
  __device__ bool next(int i, Unit& u) const {
    const long L = (long)i * G + c; if (L >= nwg) return false;
    int wgid = (int)L; { const int q = nwg / NXCD, r = nwg % NXCD, xcd = wgid % NXCD, off = wgid / NXCD; wgid = (xcd < r ? xcd * (q + 1) : r * (q + 1) + (xcd - r) * q) + off; }
    const int nig = WGM * nN, gid = wgid / nig, fm = gid * WGM, gsz = (nM - fm) < WGM ? (nM - fm) : WGM;
    u.pm = fm + ((wgid % nig) % gsz); u.pn = (wgid % nig) / gsz; u.kofs = 0; u.nt = ntf; u.slice = 0; return true;
  }
  __device__ __forceinline__ void a_ready(const Unit&) const {}
};
struct WaitOrder : StaticOrder {
  unsigned* flag; unsigned need; int wv;
  __device__ __forceinline__ void a_ready(const Unit& u) const {
    if (u.pm < 64) return;
    if (wv == 0) {
      unsigned sp = 0;
      while ((unsigned)__builtin_amdgcn_readfirstlane(__hip_atomic_load(flag, __ATOMIC_RELAXED, __HIP_MEMORY_SCOPE_AGENT)) < need) { __builtin_amdgcn_s_sleep(2); if (++sp > (1u << 22)) break; }
      __builtin_amdgcn_fence(__ATOMIC_ACQUIRE, "agent");
      asm volatile("s_waitcnt vmcnt(0)" ::: "memory");
    }
    asm volatile("" ::: "memory"); __builtin_amdgcn_s_barrier(); asm volatile("" ::: "memory");
  }
};
struct TailOrder : StaticOrder {
  int nsl;
  __device__ bool next(int i, Unit& u) const {
    if (i == 0) return StaticOrder::next(0, u);
    if (i == 1 && c < 8 * nsl) {
      const int tile = c & 7, sl = c >> 3;
      const int st = (ntf == 16) ? 4 * sl : (sl < 2 ? 12 * sl : 24 + 10 * (sl - 2)), n = (ntf == 16) ? 4 : (sl < 2 ? 12 : 10);
      u.pm = 64 + (tile >> 2); u.pn = tile & 3; u.kofs = st * BK * 2; u.nt = n; u.slice = 1 + sl; return true;
    }
    return false;
  }
};
__device__ __forceinline__ unsigned cvt_pk_bf16(float lo, float hi) { unsigned r; asm volatile("v_cvt_pk_bf16_f32 %0, %1, %2" : "=v"(r) : "v"(lo), "v"(hi)); return r; }

template <class Epi, class Sched, bool ALIGN_EPI = true>
__device__ __forceinline__ void gemm_phase(LAS unsigned char* lds, const Gemm g, const Sched& S, const Epi& E, int wv) {
  const int tid = opaque_tid(wv), wid = __builtin_amdgcn_readfirstlane(tid >> 6), lane = tid & 63, wr = wid >> 2, wc = wid & 3, fr = lane & 15, fq = lane >> 4;
  const int K = g.K, lda = g.lda;
  unsigned voffA[2], voffB[2];
#pragma unroll
  for (int i = 0; i < 2; ++i) { int R, C; stage_rc(tid * 16 + i * 8192, R, C); const int Rb = Epi::PERM ? ((R & ~31) + perm32(R & 31)) : R;
    voffA[i] = (unsigned)(R * lda + C) * 2u; voffB[i] = (unsigned)(Rb * K + C) * 2u; }
  const size_t kstep = (size_t)(BK * 2);
  const size_t hstepA = (size_t)HALF * lda * 2, hstepB = (size_t)HALF * K * 2;
  const size_t tstepA = 2 * hstepA, tstepB = 2 * hstepB;
  const unsigned ldsw = (unsigned)wid * 1024u;
  const int aoff = lds_byte(wr * 64 + fr, fq * 8), boff = lds_byte(wc * 32 + fr, fq * 8);
#define PG8_SA(b, h) (((b) * 2 + (h)) * HTB)
#define PG8_SB(b, h) ((4 + (b) * 2 + (h)) * HTB)
#define PG8_STAGE(bufoff, gbase, voff) do { _Pragma("unroll") for (int _i = 0; _i < 2; ++_i) \
    __builtin_amdgcn_global_load_lds((const unsigned*)((const char*)(gbase) + (voff)[_i]), (LAS unsigned*)(lds + (bufoff) + ldsw + _i * 8192), 16, 0, 0); } while (0)
#define PG8_LDA(dst, b, h) do { _Pragma("unroll") for (int m = 0; m < 4; ++m) _Pragma("unroll") for (int k = 0; k < 2; ++k) dst[m][k] = *(const LAS bf16x8*)(lds + PG8_SA(b, h) + aoff + m * 2048 + k * 1024); } while (0)
#define PG8_LDB(dst, b, h) do { _Pragma("unroll") for (int n = 0; n < 2; ++n) _Pragma("unroll") for (int k = 0; k < 2; ++k) dst[n][k] = *(const LAS bf16x8*)(lds + PG8_SB(b, h) + boff + n * 2048 + k * 1024); } while (0)
#define PG8_MMA(ai, bj, At, Bt) do { __builtin_amdgcn_s_setprio(1); _Pragma("unroll") for (int m = 0; m < 4; ++m) _Pragma("unroll") for (int n = 0; n < 2; ++n) _Pragma("unroll") for (int k = 0; k < 2; ++k) \
    acc[ai][bj][m][n] = __builtin_amdgcn_mfma_f32_16x16x32_bf16(Bt[n][k], At[m][k], acc[ai][bj][m][n], 0, 0, 0); __builtin_amdgcn_s_setprio(0); } while (0)
#define PG8_WAIT_V(n) asm volatile("s_waitcnt vmcnt(" #n ")" ::: "memory")
#define PG8_WAIT_L(n) asm volatile("s_waitcnt lgkmcnt(" #n ")" ::: "memory")
#define PG8_BAR __builtin_amdgcn_s_barrier()
#define PG8_SCHED __builtin_amdgcn_sched_barrier(0)
  Unit cur, nxt; int ui = 0;
  if (!S.next(0, cur)) return;
  f32x4 acc[2][2][4][2];
#pragma unroll
  for (int a = 0; a < 2; ++a)
#pragma unroll
    for (int b = 0; b < 2; ++b)
#pragma unroll
      for (int m = 0; m < 4; ++m)
#pragma unroll
        for (int n = 0; n < 2; ++n) acc[a][b][m][n] = (f32x4){0.f, 0.f, 0.f, 0.f};
  bf16x8 At[4][2], B0[2][2], B1[2][2];
  const char* cA = (const char*)g.A + (size_t)cur.pm * tstepA + cur.kofs; const char* cB = (const char*)g.Bt + (size_t)cur.pn * tstepB + cur.kofs;
  S.a_ready(cur);
  PG8_STAGE(PG8_SB(0, 0), cB, voffB); PG8_STAGE(PG8_SB(0, 1), cB + hstepB, voffB); PG8_STAGE(PG8_SA(0, 0), cA, voffA); PG8_STAGE(PG8_SA(0, 1), cA + hstepA, voffA);
  if (wr == 1) PG8_BAR;
  PG8_WAIT_V(2); PG8_BAR;
  PG8_STAGE(PG8_SB(1, 0), cB + kstep, voffB); PG8_STAGE(PG8_SA(1, 0), cA + kstep, voffA); PG8_STAGE(PG8_SB(1, 1), cB + hstepB + kstep, voffB);
  PG8_WAIT_V(6); PG8_BAR;
  for (;;) {
    const bool has_next = S.next(ui + 1, nxt);
    const char* nA = has_next ? (const char*)g.A + (size_t)nxt.pm * tstepA + nxt.kofs : cA; const char* nB = has_next ? (const char*)g.Bt + (size_t)nxt.pn * tstepB + nxt.kofs : cB;
    const int nt = cur.nt;
    E.prefetch(lds, cur, ui, wid, lane);
    for (int t = 0; t < nt; t += 2) {
      const bool last = (t == nt - 2);
      if (last && has_next) S.a_ready(nxt);
      const char* a1 = cA + (size_t)(t + 1) * kstep;
      const char* a2 = last ? nA : cA + (size_t)(t + 2) * kstep; const char* b2 = last ? nB : cB + (size_t)(t + 2) * kstep;
      const char* a3 = a2 + kstep; const char* b3 = b2 + kstep;
      PG8_LDB(B0, 0, 0); PG8_LDB(B1, 0, 1); PG8_SCHED; PG8_LDA(At, 0, 0); PG8_STAGE(PG8_SA(1, 1), a1 + hstepA, voffA);
      PG8_WAIT_V(8); PG8_WAIT_L(0); PG8_BAR; PG8_MMA(0, 0, At, B0); PG8_MMA(0, 1, At, B1); PG8_BAR; PG8_SCHED;
      PG8_LDA(At, 0, 1); PG8_STAGE(PG8_SB(0, 0), b2, voffB); PG8_STAGE(PG8_SB(0, 1), b2 + hstepB, voffB); PG8_STAGE(PG8_SA(0, 0), a2, voffA);
      PG8_WAIT_V(8); PG8_WAIT_L(0); PG8_BAR; PG8_MMA(1, 0, At, B0); PG8_MMA(1, 1, At, B1); PG8_BAR; PG8_SCHED;
      PG8_LDB(B0, 1, 0); PG8_LDB(B1, 1, 1); PG8_SCHED; PG8_LDA(At, 1, 0); PG8_STAGE(PG8_SA(0, 1), a2 + hstepA, voffA);
      PG8_WAIT_V(8); PG8_WAIT_L(0); PG8_BAR; PG8_MMA(0, 0, At, B0); PG8_MMA(0, 1, At, B1); PG8_BAR; PG8_SCHED;
      PG8_LDA(At, 1, 1); PG8_STAGE(PG8_SB(1, 0), b3, voffB); PG8_STAGE(PG8_SB(1, 1), b3 + hstepB, voffB); PG8_STAGE(PG8_SA(1, 0), a3, voffA);
      PG8_WAIT_V(8); PG8_WAIT_L(0); PG8_BAR; PG8_MMA(1, 0, At, B0); PG8_MMA(1, 1, At, B1); PG8_BAR; PG8_SCHED;
    }
    if constexpr (ALIGN_EPI) { if (wr == 0) PG8_BAR; }
    E(acc, cur, wr, wc, fr, fq, lds, ui);
    if (!has_next) break;
#pragma unroll
    for (int a = 0; a < 2; ++a)
#pragma unroll
      for (int b = 0; b < 2; ++b)
#pragma unroll
        for (int m = 0; m < 4; ++m)
#pragma unroll
          for (int n = 0; n < 2; ++n) acc[a][b][m][n] = (f32x4){0.f, 0.f, 0.f, 0.f};
    cur = nxt; cA = nA; cB = nB; ++ui;
    if constexpr (ALIGN_EPI) { if (wr == 1) PG8_BAR; }
  }
  PG8_WAIT_V(0);
  if constexpr (!ALIGN_EPI) { if (wr == 0) PG8_BAR; }
  PG8_BAR;
#undef PG8_SA
#undef PG8_SB
#undef PG8_STAGE
#undef PG8_LDA
#undef PG8_LDB
#undef PG8_MMA
#undef PG8_WAIT_V
#undef PG8_WAIT_L
#undef PG8_BAR
#undef PG8_SCHED
}

constexpr int EPI_LDS = 135168, EPI_SLOT = 4096 + 2048;
static_assert(EPI_LDS + 2 * EPI_SLOT <= 163824, "epilogue staging LDS");
__device__ __forceinline__ void epi_stage_ss(LAS unsigned char* lds, const GAS float* ss, const Unit& u, int ui, int wid, int lane) {
  if (wid < 4) __builtin_amdgcn_global_load_lds((const unsigned*)(ss + ((size_t)u.pm * BM + wid * 64 + lane) * 4), (LAS unsigned*)(lds + EPI_LDS + (ui & 1) * EPI_SLOT + wid * 1024), 16, 0, 0);
}
__device__ __forceinline__ float epi_rstd(const LAS unsigned char* lds, int ui, int lrow) { const f32x4 p = *(const LAS f32x4*)(lds + EPI_LDS + (ui & 1) * EPI_SLOT + lrow * 16); return rsqrtf((((p[0] + p[1]) + p[2]) + p[3]) * (1.f / DM) + RMS_EPS); }
struct EpiScaleBf16 {
  static constexpr bool PERM = true;
  GAS bf16_t* O; int ldo; int ncols; const GAS float* ss;
  __device__ __forceinline__ void prefetch(LAS unsigned char* lds, const Unit& u, int ui, int wid, int lane) const { epi_stage_ss(lds, ss, u, ui, wid, lane); }
  __device__ __forceinline__ void operator()(const f32x4 (&acc)[2][2][4][2], const Unit& u, int wr, int wc, int fr, int fq, LAS unsigned char* lds, int ui) const {
    const int row0 = u.pm * BM + wr * 64 + fr, col0 = u.pn * BM + wc * 32 + 8 * fq;
#pragma unroll
    for (int ai = 0; ai < 2; ++ai)
#pragma unroll
      for (int m = 0; m < 4; ++m) {
        const int row = row0 + ai * HALF + m * 16;
        const float rs = epi_rstd(lds, ui, row - u.pm * BM);
        GAS bf16_t* rowp = O + (size_t)row * ldo + col0;
#pragma unroll
        for (int bj = 0; bj < 2; ++bj) {
          if (col0 + bj * HALF < ncols) {
            const f32x4 v0 = acc[ai][bj][m][0] * rs, v1 = acc[ai][bj][m][1] * rs;
            u32x4 w; w.x = cvt_pk_bf16(v0[0], v0[1]); w.y = cvt_pk_bf16(v0[2], v0[3]); w.z = cvt_pk_bf16(v1[0], v1[1]); w.w = cvt_pk_bf16(v1[2], v1[3]);
            *(GAS u32x4*)(rowp + bj * HALF) = w;
          }
        }
      }
  }
};
struct EpiRes {
  static constexpr bool PERM = true;
  const GAS bf16_t* Xin; GAS bf16_t* Xout; GAS float* ssn; int write_ss; GAS float* slab; int nsl; LAS float* red;
  __device__ __forceinline__ void prefetch(LAS unsigned char*, const Unit&, int, int, int) const {}
  __device__ __forceinline__ void operator()(const f32x4 (&acc)[2][2][4][2], const Unit& u, int wr, int wc, int fr, int fq, LAS unsigned char* lds, int ui) const {
    if (write_ss < 0) return;
    if (u.slice) {
      GAS float* sb = slab + ((size_t)(((u.pm - 64) * 4 + u.pn) * nsl + (u.slice - 1)) * 256 + wr * 64 + fr) * 256 + wc * 32 + 8 * fq;
#pragma unroll
      for (int ai = 0; ai < 2; ++ai)
#pragma unroll
        for (int m = 0; m < 4; ++m)
#pragma unroll
          for (int bj = 0; bj < 2; ++bj)
#pragma unroll
            for (int n = 0; n < 2; ++n) *(GAS f32x4*)(sb + (size_t)(ai * HALF + m * 16) * 256 + bj * HALF + n * 4) = acc[ai][bj][m][n];
      return;
    }
    const int row0 = u.pm * BM + wr * 64 + fr, col0 = u.pn * BM + wc * 32 + 8 * fq;
    u32x4 xin[2][4][2];
#pragma unroll
    for (int ai = 0; ai < 2; ++ai)
#pragma unroll
      for (int m = 0; m < 4; ++m)
#pragma unroll
        for (int bj = 0; bj < 2; ++bj) xin[ai][m][bj] = *(const GAS u32x4*)(Xin + (size_t)(row0 + ai * HALF + m * 16) * DM + col0 + bj * HALF);
    __builtin_amdgcn_sched_barrier(0);
#pragma unroll
    for (int ai = 0; ai < 2; ++ai)
#pragma unroll
      for (int m = 0; m < 4; ++m) {
        const int row = row0 + ai * HALF + m * 16;
        const size_t ro = (size_t)row * DM + col0;
        float sq = 0.f;
#pragma unroll
        for (int bj = 0; bj < 2; ++bj) {
          const u32x4 xi = xin[ai][m][bj];
          const f32x4 x0 = (f32x4){__builtin_bit_cast(float, xi.x << 16), __builtin_bit_cast(float, xi.x & 0xffff0000u), __builtin_bit_cast(float, xi.y << 16), __builtin_bit_cast(float, xi.y & 0xffff0000u)} + acc[ai][bj][m][0];
          const f32x4 x1 = (f32x4){__builtin_bit_cast(float, xi.z << 16), __builtin_bit_cast(float, xi.z & 0xffff0000u), __builtin_bit_cast(float, xi.w << 16), __builtin_bit_cast(float, xi.w & 0xffff0000u)} + acc[ai][bj][m][1];
          u32x4 w; w.x = cvt_pk_bf16(x0[0], x0[1]); w.y = cvt_pk_bf16(x0[2], x0[3]); w.z = cvt_pk_bf16(x1[0], x1[1]); w.w = cvt_pk_bf16(x1[2], x1[3]);
          *(GAS u32x4*)(Xout + ro + bj * HALF) = w;
          sq += x0[0] * x0[0] + x0[1] * x0[1] + x0[2] * x0[2] + x0[3] * x0[3] + x1[0] * x1[0] + x1[1] * x1[1] + x1[2] * x1[2] + x1[3] * x1[3];
        }
        if (write_ss) {
          sq = add_xor32(add_xor16(sq));
          if (fq == 0) red[(ai * HALF + wr * 64 + m * 16 + fr) * 4 + wc] = sq;
        }
      }
    if (write_ss) {
      asm volatile("s_waitcnt lgkmcnt(0)" ::: "memory"); __builtin_amdgcn_s_barrier(); asm volatile("" ::: "memory");
      const int t2 = wr * 256 + wc * 64 + fq * 16 + fr;
      if (t2 < 256) { const f32x4 q = *(const LAS f32x4*)(red + t2 * 4); ssn[(size_t)(u.pm * BM + t2) * 4 + u.pn] = ((q[0] + q[1]) + q[2]) + q[3]; }
    }
  }
};
constexpr size_t FS_G = (size_t)MPAD * DFF;
constexpr size_t FS_UH = FS_G, FS_UD = FS_UH + (size_t)256 * 2 * DFF, FS_GD = FS_UD + (size_t)256 * 2 * DFF, FS_US = FS_GD + (size_t)256 * 2 * DFF, FS_GS = FS_US + (size_t)512 * DFF;
static_assert((FS_GS + (size_t)512 * DFF) * 2 <= (size_t)MPAD * PLD * 2, "FFN side buffers fit in BIG");
__device__ __forceinline__ float dpp_prev(float prv, float cur, int sh) {
  const int pr = __builtin_bit_cast(int, prv), cu = __builtin_bit_cast(int, cur);
  int r;
  if (sh == 1) { const int o = __builtin_amdgcn_update_dpp(0, pr, 0x121, 0xf, 0xf, false); r = __builtin_amdgcn_update_dpp(o, cu, 0x111, 0xf, 0xf, false); }
  else { const int o = __builtin_amdgcn_update_dpp(0, pr, 0x122, 0xf, 0xf, false); r = __builtin_amdgcn_update_dpp(o, cu, 0x112, 0xf, 0xf, false); }
  return __builtin_bit_cast(float, r);
}
struct EpiUpConv {
  static constexpr bool PERM = true;
  GAS bf16_t* G; const GAS float* ss; const GAS float* cw; const GAS float* cb;
  __device__ __forceinline__ void prefetch(LAS unsigned char* lds, const Unit& u, int ui, int wid, int lane) const {
    epi_stage_ss(lds, ss, u, ui, wid, lane);
    const int k = wid >> 1, half = wid & 1;
    const GAS float* src = (k < 3 ? cw + (size_t)k * DFF : cb) + u.pn * 128 + half * 64 + lane;
    __builtin_amdgcn_global_load_lds((const unsigned*)src, (LAS unsigned*)(lds + EPI_LDS + (ui & 1) * EPI_SLOT + 4096 + (k * 128 + half * 64) * 4), 4, 0, 0);
  }
  __device__ __forceinline__ void operator()(const f32x4 (&acc)[2][2][4][2], const Unit& u, int wr, int wc, int fr, int fq, LAS unsigned char* lds, int ui) const {
    const int row0 = u.pm * BM + wr * 64 + fr, ff0 = u.pn * 128 + wc * 32 + 8 * fq;
    const bool spec = u.pm >= 64;
    f32x4 w0[2], w1[2], w2[2], bb[2];
    { const LAS float* cl = (const LAS float*)(lds + EPI_LDS + (ui & 1) * EPI_SLOT + 4096) + wc * 32 + 8 * fq;
#pragma unroll
      for (int n = 0; n < 2; ++n) { w0[n] = *(const LAS f32x4*)(cl + 4 * n); w1[n] = *(const LAS f32x4*)(cl + 128 + 4 * n); w2[n] = *(const LAS f32x4*)(cl + 256 + 4 * n); bb[n] = *(const LAS f32x4*)(cl + 384 + 4 * n); } }
#pragma unroll
    for (int ai = 0; ai < 2; ++ai) {
      f32x4 prv[2] = {(f32x4){0.f, 0.f, 0.f, 0.f}, (f32x4){0.f, 0.f, 0.f, 0.f}};
      const int stripe = u.pm * 4 + ai * 2 + wr;
#pragma unroll
      for (int m = 0; m < 4; ++m) {
        const int row = row0 + ai * HALF + m * 16;
        const float rs = epi_rstd(lds, ui, row - u.pm * BM);
        f32x4 cur[2], gt[2], o[2];
#pragma unroll
        for (int n = 0; n < 2; ++n) {
          cur[n] = acc[ai][0][m][n] * rs; gt[n] = acc[ai][1][m][n] * rs;
#pragma unroll
          for (int uu = 0; uu < 4; ++uu) {
            const float p1 = dpp_prev(prv[n][uu], cur[n][uu], 1), p2 = dpp_prev(prv[n][uu], cur[n][uu], 2);
            const float val = w0[n][uu] * p2 + w1[n][uu] * p1 + w2[n][uu] * cur[n][uu] + bb[n][uu];
            o[n][uu] = val * __builtin_amdgcn_rcpf(1.f + __expf(-val)) * gt[n][uu];
          }
          prv[n] = cur[n];
        }
        u32x4 w; w.x = cvt_pk_bf16(o[0][0], o[0][1]); w.y = cvt_pk_bf16(o[0][2], o[0][3]); w.z = cvt_pk_bf16(o[1][0], o[1][1]); w.w = cvt_pk_bf16(o[1][2], o[1][3]);
        *(GAS u32x4*)(G + (size_t)row * DFF + ff0) = w;
        const bool needu = spec || (m == 0 && fr < 2) || (m == 3 && fr >= 14);
        if (needu) {
          u32x4 wu; wu.x = cvt_pk_bf16(cur[0][0], cur[0][1]); wu.y = cvt_pk_bf16(cur[0][2], cur[0][3]); wu.z = cvt_pk_bf16(cur[1][0], cur[1][1]); wu.w = cvt_pk_bf16(cur[1][2], cur[1][3]);
          u32x4 wg; wg.x = cvt_pk_bf16(gt[0][0], gt[0][1]); wg.y = cvt_pk_bf16(gt[0][2], gt[0][3]); wg.z = cvt_pk_bf16(gt[1][0], gt[1][1]); wg.w = cvt_pk_bf16(gt[1][2], gt[1][3]);
          if (spec) { *(GAS u32x4*)(G + FS_US + (size_t)(row - R_SAMP) * DFF + ff0) = wu; *(GAS u32x4*)(G + FS_GS + (size_t)(row - R_SAMP) * DFF + ff0) = wg; }
          else if (m == 0) { *(GAS u32x4*)(G + FS_UD + ((size_t)stripe * 2 + fr) * DFF + ff0) = wu; *(GAS u32x4*)(G + FS_GD + ((size_t)stripe * 2 + fr) * DFF + ff0) = wg; }
          else *(GAS u32x4*)(G + FS_UH + ((size_t)stripe * 2 + (fr - 14)) * DFF + ff0) = wu;
        }
      }
    }
  }
};
}


#define XB_TMO      128
#define XB_XCNT(j)  (256  + 64 * (j))
#define XB_XSUB(j)  (1280 + 64 * (j))
#define XB_XGEN(j)  (2304 + 64 * (j))
#define XB_TOP      3328
#define XB_TOPGEN   3392
#define XCD_BAR_WORDS 3456
#define XB_SPIN_CAP (1u << 20)
__device__ __forceinline__ unsigned xb_ld(unsigned* p)              { return __hip_atomic_load(p, __ATOMIC_RELAXED, __HIP_MEMORY_SCOPE_AGENT); }
__device__ __forceinline__ unsigned xb_add(unsigned* p, unsigned v) { return __hip_atomic_fetch_add(p, v, __ATOMIC_RELAXED, __HIP_MEMORY_SCOPE_AGENT); }
__device__ __forceinline__ unsigned xb_xcc_id() { return (unsigned)__builtin_amdgcn_s_getreg((3 << 11) | 20) & 0xFu; }
#define XB_SPIN(cond, bar) do { unsigned _sp = 0; while (cond) { __builtin_amdgcn_s_sleep(1); \
    if ((++_sp & 255u) == 0u) { if (xb_ld(&(bar)[XB_TMO])) break; if (_sp > XB_SPIN_CAP) { atomicAdd(&(bar)[XB_TMO], 1u); break; } } } } while (0)
__device__ __forceinline__ void xcd_barrier_complete(unsigned* bar, unsigned x, unsigned& nloc, unsigned& nx) {
  const unsigned G = gridDim.x * gridDim.y * gridDim.z;
  unsigned sum, cnt, mine, sp = 0u;
  for (;;) {
    sum = 0u; cnt = 0u; mine = 0u;
#pragma unroll
    for (unsigned j = 0; j < 16; ++j) { const unsigned c = xb_ld(&bar[XB_XCNT(j)]); sum += c; cnt += (c > 0u) ? 1u : 0u; mine = (j == x) ? c : mine; }
    if (sum == G) break;
    __builtin_amdgcn_s_sleep(1);
    if ((++sp & 255u) == 0u) { if (xb_ld(&bar[XB_TMO])) break; if (sp > XB_SPIN_CAP) { atomicAdd(&bar[XB_TMO], 1u); break; } }
  }
  nloc = mine > 0u ? mine : 1u; nx = cnt > 0u ? cnt : 1u;
}
__device__ __forceinline__ void xcd_barrier(unsigned* bar, volatile LAS unsigned* st, bool tid0) {
  asm volatile("s_waitcnt vmcnt(0)" ::: "memory");
  __syncthreads();
  if (tid0) {
    __builtin_amdgcn_s_waitcnt(0);
    const unsigned x = xb_xcc_id();
    unsigned nloc = st[0], nx = st[1];
    if (nloc == 0u) { xcd_barrier_complete(bar, x, nloc, nx); st[0] = nloc; st[1] = nx; }
    const unsigned old = xb_add(&bar[XB_XSUB(x)], 1u);
    const unsigned gen = old / nloc;
    if (old + 1u == (gen + 1u) * nloc) {
      __builtin_amdgcn_fence(__ATOMIC_RELEASE, "agent");
      asm volatile("s_waitcnt vmcnt(0)" ::: "memory");
      const unsigned og = xb_add(&bar[XB_TOP], 1u);
      const unsigned tg = og / nx;
      asm volatile("buffer_inv sc1" ::: "memory");
      if (og + 1u == (tg + 1u) * nx) xb_add(&bar[XB_TOPGEN], 1u);
      else XB_SPIN(xb_ld(&bar[XB_TOPGEN]) == tg, bar);
      asm volatile("s_waitcnt vmcnt(0)" ::: "memory");
      xb_add(&bar[XB_XGEN(x)], 1u);
      asm volatile("s_waitcnt vmcnt(0)" ::: "memory");
    } else {
      asm volatile("buffer_inv sc1" ::: "memory");
      XB_SPIN(xb_ld(&bar[XB_XGEN(x)]) == gen, bar);
      asm volatile("s_waitcnt vmcnt(0)" ::: "memory");
    }
  }
  __syncthreads();
}

__device__ __forceinline__ void transpose_item(const GAS float* W, int N, int k0, int n0, int nvalid, const GAS float* scale, GAS bf16_t* WT, int ldt, int dst_row0, int dst_k0, LAS float* scr, int lane) {
  (void)scr;
  const int n4 = 4 * (lane & 7), kg = lane >> 3;
  f32x4 v[8];
#pragma unroll
  for (int i = 0; i < 8; ++i) v[i] = (n0 + n4 < nvalid) ? *(const GAS f32x4*)(W + (size_t)(k0 + 8 * kg + i) * N + n0 + n4) : (f32x4){0.f, 0.f, 0.f, 0.f};
  if (scale) {
    const f32x4 s0 = *(const GAS f32x4*)(scale + k0 + 8 * kg), s1 = *(const GAS f32x4*)(scale + k0 + 8 * kg + 4);
#pragma unroll
    for (int i = 0; i < 8; ++i) v[i] = v[i] * (i < 4 ? s0[i & 3] : s1[i & 3]);
  }
#pragma unroll
  for (int j = 0; j < 4; ++j) {
    u32x4 o; o.x = pk2(v[0][j], v[1][j]); o.y = pk2(v[2][j], v[3][j]); o.z = pk2(v[4][j], v[5][j]); o.w = pk2(v[6][j], v[7][j]);
    *(GAS u32x4*)(WT + (size_t)(dst_row0 + n4 + j) * ldt + dst_k0 + 8 * kg) = o;
  }
}

constexpr int WI_IN = 16 * 128, WI_OUT = 16 * 32, WI_UP = 16 * 176, WI_DN = 44 * 32, WI_L = WI_IN + WI_OUT + WI_UP + WI_DN;
constexpr int WI_P0 = WI_OUT + 1664;
struct WItem { const GAS float* W; const GAS float* scale; GAS bf16_t* WT; int N, k0, n0, ldt, drow, dk0; };
__device__ __forceinline__ WItem wi_decode(const GAS float* w_in, const GAS float* nmix, const GAS float* w_out, const GAS float* w_up, const GAS float* nffn, const GAS float* w_dn, GAS unsigned char* ws, int l, int r) {
  WItem t;
  if (r < WI_IN) {
    const int kb = r / 128, nb = r % 128;
    t.W = w_in + (size_t)l * DM * DIN; t.N = DIN; t.k0 = kb * 64; t.n0 = nb * 32; t.scale = nmix + l * DM; t.WT = (GAS bf16_t*)(ws + WS_WIN) + (size_t)l * NINP * DM; t.ldt = DM; t.drow = nb * 32; t.dk0 = kb * 64;
    return t; }
  r -= WI_IN;
  if (r < WI_OUT) {
    const int kb = r / 32, nb = r % 32;
    t.W = w_out + (size_t)l * DM * DM; t.N = DM; t.k0 = kb * 64; t.n0 = nb * 32; t.scale = nullptr; t.WT = (GAS bf16_t*)(ws + WS_WOUT) + (size_t)l * DM * DM; t.ldt = DM; t.drow = nb * 32; t.dk0 = kb * 64;
    return t; }
  r -= WI_OUT;
  if (r < WI_UP) {
    const int kb = r / 176, nb = r % 176;
    const int drow = nb * 32, pn = drow >> 8, j = drow & 255;
    const int src = (j < 128) ? (128 * pn + j) : (DFF + 128 * pn + (j - 128));
    t.W = w_up + (size_t)l * DM * 2 * DFF; t.N = 2 * DFF; t.k0 = kb * 64; t.n0 = src; t.scale = nffn + l * DM; t.WT = (GAS bf16_t*)(ws + WS_WUP) + (size_t)l * 2 * DFF * DM; t.ldt = DM; t.drow = drow; t.dk0 = kb * 64;
    return t; }
  r -= WI_UP;
  {
    const int kb = r / 32, nb = r % 32;
    t.W = w_dn + (size_t)l * DFF * DM; t.N = DM; t.k0 = kb * 64; t.n0 = nb * 32; t.scale = nullptr; t.WT = (GAS bf16_t*)(ws + WS_WDN) + (size_t)l * DM * DFF; t.ldt = DFF; t.drow = nb * 32; t.dk0 = kb * 64;
  }
  return t;
}
__device__ __forceinline__ void wi_load(const WItem& t, bool on, int lane, f32x4 (&v)[8]) {
  const int n4 = 4 * (lane & 7), kg = lane >> 3;
  const bool ok = on && (t.n0 + n4 < t.N);
#pragma unroll
  for (int i = 0; i < 8; ++i) v[i] = ok ? *(const GAS f32x4*)(t.W + (size_t)(t.k0 + 8 * kg + i) * t.N + t.n0 + n4) : (f32x4){0.f, 0.f, 0.f, 0.f};
  if (t.scale) {
    const f32x4 s0 = *(const GAS f32x4*)(t.scale + t.k0 + 8 * kg), s1 = *(const GAS f32x4*)(t.scale + t.k0 + 8 * kg + 4);
#pragma unroll
    for (int i = 0; i < 8; ++i) v[i] = v[i] * (i < 4 ? s0[i & 3] : s1[i & 3]);
  }
}
__device__ __forceinline__ void wi_store(const WItem& t, int lane, const f32x4 (&v)[8]) {
  const int n4 = 4 * (lane & 7), kg = lane >> 3;
#pragma unroll
  for (int j = 0; j < 4; ++j) {
    u32x4 o; o.x = pk2(v[0][j], v[1][j]); o.y = pk2(v[2][j], v[3][j]); o.z = pk2(v[4][j], v[5][j]); o.w = pk2(v[6][j], v[7][j]);
    *(GAS u32x4*)(t.WT + (size_t)(t.drow + n4 + j) * t.ldt + t.dk0 + 8 * kg) = o;
  }
}
__device__ __forceinline__ void convert_weights(const GAS float* w_in, const GAS float* nmix, const GAS float* w_out, const GAS float* w_up, const GAS float* nffn, const GAS float* w_dn,
                                                GAS unsigned char* ws, int l, int r_lo, int r_hi, int widx, int nw, LAS float* scr, int lane) {
  (void)scr;
  for (int r0 = r_lo + widx; r0 < r_hi; r0 += 2 * nw) {
    const bool two = r0 + nw < r_hi;
    const WItem ta = wi_decode(w_in, nmix, w_out, w_up, nffn, w_dn, ws, l, r0);
    const WItem tb = wi_decode(w_in, nmix, w_out, w_up, nffn, w_dn, ws, l, two ? r0 + nw : r0);
    f32x4 va[8], vb[8];
    wi_load(ta, true, lane, va);
    wi_load(tb, two, lane, vb);
    wi_store(ta, lane, va);
    if (two) wi_store(tb, lane, vb);
  }
}

__device__ __forceinline__ void phase_prologue(const Params& p, LAS unsigned char* lds) {
  const int tid = threadIdx.x, lane = tid & 63, wave = tid >> 6;
  const int gw = blockIdx.x * 8 + wave, NGW = gridDim.x * 8;
  LAS float* scr = (LAS float*)(lds + wave * 16384);
  unsigned char* ws = p.ws;
  convert_weights((const GAS float*)p.in[11], (const GAS float*)p.in[10], (const GAS float*)p.in[28], (const GAS float*)p.in[30], (const GAS float*)p.in[29], (const GAS float*)p.in[33], (GAS unsigned char*)ws, 0, 0, WI_IN, gw, NGW, scr, lane);
  convert_weights((const GAS float*)p.in[11], (const GAS float*)p.in[10], (const GAS float*)p.in[28], (const GAS float*)p.in[30], (const GAS float*)p.in[29], (const GAS float*)p.in[33], (GAS unsigned char*)ws, 0, WI_IN + WI_P0, WI_IN + WI_OUT + WI_UP, gw, NGW, scr, lane);
  {
    bf16_t* lo = (bf16_t*)(ws + WS_LORA);
    for (int idx = blockIdx.x * 512 + tid; idx < DEPTH * AH * 16384; idx += gridDim.x * 512) {
      const int l = idx / (AH * 16384), h = (idx / 16384) % AH, e = idx % 16384;
      float v;
      if (e < 4096) v = p.in[14][((size_t)l * 64 + (e & 63)) * AW + h * 64 + (e >> 6)];
      else if (e < 8192) v = p.in[16][((size_t)l * 64 + (e & 63)) * AW + h * 64 + ((e - 4096) >> 6)];
      else v = p.in[17][((size_t)l * 128 + ((e - 8192) & 127)) * AW + h * 64 + ((e - 8192) >> 7)];
      lo[idx] = (bf16_t)f2bf(v);
    }
  }
  {
    bf16_t* zr = (bf16_t*)(ws + WS_ZROW); bf16_t* shb = (bf16_t*)(ws + WS_SHIFTB);
    for (int idx = blockIdx.x * 512 + tid; idx < 4096 + DEPTH * SBN * ACOLS; idx += gridDim.x * 512) {
      if (idx < 4096) zr[idx] = 0; else shb[idx - 4096] = (bf16_t)f2bf(p.in[2][idx - 4096]);
    }
    bf16_t* cvb = (bf16_t*)(ws + WS_CONVB);
    for (int idx = blockIdx.x * 512 + tid; idx < DEPTH * SBN * 3 * 1024; idx += gridDim.x * 512) cvb[idx] = (bf16_t)f2bf(p.in[4][idx]);
  }
  float* ss = (float*)(ws + WS_SS);
  bf16_t* Xb0 = (bf16_t*)(ws + WS_XB0);
  for (int r0 = gw; r0 < MPAD; r0 += 4 * NGW) {
    f32x4 v[4][4];
#pragma unroll
    for (int u = 0; u < 4; ++u) {
      const int r = r0 + u * NGW;
      const float* src = nullptr;
      if (r < R_SAMP) src = p.in[0] + (size_t)r * DM;
      else if (r < R_META) src = p.in[1] + (size_t)(r - R_SAMP) * DM;
      else if (r < R_TOT) src = p.in[9] + (size_t)((r - R_META) & 15) * DM;
#pragma unroll
      for (int j = 0; j < 4; ++j) v[u][j] = src ? *(const GAS f32x4*)((const GAS float*)src + 256 * j + 4 * lane) : (f32x4){0.f, 0.f, 0.f, 0.f};
    }
#pragma unroll
    for (int u = 0; u < 4; ++u) {
      const int r = r0 + u * NGW;
      if (r < MPAD) {
        float s = 0.f;
#pragma unroll
        for (int j = 0; j < 4; ++j) {
          u32x2 w; w.x = pk2(v[u][j][0], v[u][j][1]); w.y = pk2(v[u][j][2], v[u][j][3]);
          *(GAS u32x2*)((GAS bf16_t*)Xb0 + (size_t)r * DM + 256 * j + 4 * lane) = w;
          s += v[u][j][0] * v[u][j][0] + v[u][j][1] * v[u][j][1] + v[u][j][2] * v[u][j][2] + v[u][j][3] * v[u][j][3];
        }
        s = wave_sum(s);
        if (lane == 0) *(GAS f32x4*)((GAS float*)ss + (size_t)r * 4) = (f32x4){s, 0.f, 0.f, 0.f};
      }
    }
  }
}

constexpr int RW_NPROMPT = NB * AH * 65, RW_NITEMS = RW_NPROMPT + SBN * AH;
constexpr int LDB = 72;
constexpr int ARRB = 64 * LDB * 2;
constexpr int LDF = 68;
constexpr int LDT = 68;
constexpr int L_R1 = 0;
constexpr int L_R2 = L_R1 + 8 * ARRB;
constexpr int L_R3 = L_R2 + 4 * ARRB;
constexpr int L_R4 = L_R3 + 2 * 64 * LDF * 4;
constexpr int L_R5 = L_R4 + ARRB;
constexpr int L_RWEND = L_R5 + (8 * 64 + 64 + 64) * 4;
static_assert(2 * 64 * LDT * 4 <= 2 * 64 * LDF * 4, "Tf + Zf fit in R3");
static_assert(L_RWEND <= 163840, "rwkv LDS");

__device__ __forceinline__ void rw_decode(int item, int& seq, int& h, int& chunk) {
  if (item < RW_NPROMPT) { chunk = item % 65; const int sh = item / 65; h = sh & 7; seq = sh >> 3; }
  else { const int r = item - RW_NPROMPT; chunk = 0; h = r & 7; seq = NB + (r >> 3); }
}
__device__ __forceinline__ int rw_row(int seq, int chunk, int t) {
  if (seq < NB) return chunk == 0 ? (R_META + 16 * seq + t) : (SEQ * seq + 64 * (chunk - 1) + t);
  return R_SAMP + 16 * (seq - NB) + t;
}
__device__ __forceinline__ bf16x8 ldfrag(const LAS bf16_t* p) { return *(const LAS bf16x8*)p; }
__device__ __forceinline__ bf16x8 ldfrag(const GAS bf16_t* p) { return *(const GAS bf16x8*)p; }
template <int K, class PX, class PY>
__device__ __forceinline__ f32x4 mma_nt(PX X, int ldx, PY Y, int ldy, int lane, f32x4 acc) {
  const int r = lane & 15, q = lane >> 4;
#pragma unroll
  for (int s = 0; s < K / 32; ++s) {
    const bf16x8 xb = ldfrag(X + r * ldx + 32 * s + 8 * q);
    const bf16x8 ya = ldfrag(Y + r * ldy + 32 * s + 8 * q);
    acc = __builtin_amdgcn_mfma_f32_16x16x32_bf16(ya, xb, acc, 0, 0, 0);
  }
  return acc;
}
template <int K, bool SWX, bool SWY, class PX, class PY>
__device__ __forceinline__ f32x4 mma_sw(PX X, int ldx, int xt, PY Y, int ldy, int yt, int lane, f32x4 acc) {
  const int r = lane & 15, q = lane >> 4;
  const int sx = SWX ? ((2 * xt + (r >> 3)) & 7) : 0, sy = SWY ? ((2 * yt + (r >> 3)) & 7) : 0;
#pragma unroll
  for (int s = 0; s < K / 32; ++s) {
    const bf16x8 xb = ldfrag(X + r * ldx + 8 * ((4 * s + q) ^ sx));
    const bf16x8 ya = ldfrag(Y + r * ldy + 8 * ((4 * s + q) ^ sy));
    acc = __builtin_amdgcn_mfma_f32_16x16x32_bf16(ya, xb, acc, 0, 0, 0);
  }
  return acc;
}
__device__ __forceinline__ u32x2 pack4(f32x4 v) { u32x2 w; w.x = pk2(v[0], v[1]); w.y = pk2(v[2], v[3]); return w; }

__device__ __forceinline__ const GAS bf16_t* rw_prev_row(const Ctx p, int l, int seq, int chunk, int t) {
  const GAS bf16_t* P = (const GAS bf16_t*)(p.ws + WS_BIG);
  if (t > 0) return P + (size_t)rw_row(seq, chunk, t - 1) * PLD;
  if (seq >= NB) return (const GAS bf16_t*)(p.ws + WS_SHIFTB) + ((size_t)l * SBN + (seq - NB)) * ACOLS;
  if (chunk == 0) return (const GAS bf16_t*)(p.ws + WS_ZROW);
  return P + (size_t)(chunk == 1 ? (R_META + 16 * seq + 15) : (rw_row(seq, chunk, 0) - 1)) * PLD;
}
__device__ __forceinline__ GAS bf16_t* rw_trec(GAS unsigned char* ws, int l, int item) {
  const int lo = 1 - l;
  if (item < 1408) return (GAS bf16_t*)(ws + WS_WUP + (size_t)lo * 2 * DFF * DM * 2) + (size_t)item * 4096;
  if (item < 2112) return (GAS bf16_t*)(ws + WS_WDN + (size_t)lo * DM * DFF * 2) + (size_t)(item - 1408) * 4096;
  return (GAS bf16_t*)(ws + WS_WOUT + (size_t)lo * DM * DM * 2) + (size_t)(item - 2112) * 4096;
}
static_assert(DEPTH == 2 && RW_NITEMS == 2208, "T record placement");
constexpr int RW_LC = 62;
constexpr int RW_NLITE = 1984;
static_assert((size_t)MPAD * DM * 2 + (size_t)RW_NLITE * 16384 <= (size_t)NB * SEQ * DM * 4, "Qh / Yhat records fit behind MIX in d_out");
__device__ __forceinline__ GAS bf16_t* rw_qrec(const Ctx p, int l, int seq, int h, int chunk) {
  if (seq < NB && chunk < RW_LC) return (GAS bf16_t*)p.out + (size_t)MPAD * DM + (size_t)((seq * 8 + h) * RW_LC + chunk) * 8192;
  const int hidx = seq < NB ? (seq * 8 + h) * 3 + (chunk - RW_LC) : NB * 8 * 3 + (seq - NB) * 8 + h;
  return (GAS bf16_t*)(p.ws + WS_WUP + (size_t)(1 - l) * 2 * DFF * DM * 2) + (size_t)hidx * 8192;
}
struct RwPref { u32x4 lc[4], lp[4], rc[3], rp[3]; };
template <int LIST>
__device__ __forceinline__ void rw_item_ids(int h, int k, int& seq, int& chunk, int& item) {
  if (LIST == 0) {
    if (k < NB * 65) { seq = k / 65; chunk = k - seq * 65; } else { seq = NB + (k - NB * 65); chunk = 0; }
  } else if (LIST == 1) {
    if (k < NB * 3) { seq = k / 3; chunk = RW_LC + (k - seq * 3); } else { seq = NB + (k - NB * 3); chunk = 0; }
  } else { seq = k / RW_LC; chunk = k - seq * RW_LC; }
  item = seq < NB ? (seq * 8 + h) * 65 + chunk : RW_NPROMPT + (seq - NB) * 8 + h;
}
template <int MODE, int LIST>
__device__ __forceinline__ void rw_prefetch(const Ctx p, int l, int h, int k, int tid, RwPref& pf) {
  int seq, chunk, item; rw_item_ids<LIST>(h, k, seq, chunk, item);
  const int ntok = (chunk == 0) ? 16 : 64;
  const GAS bf16_t* P = (const GAS bf16_t*)(p.ws + WS_BIG);
  const u32x4 z = (u32x4){0u, 0u, 0u, 0u};
  const int grp = MODE == 1 ? (tid & 31) : (tid & 15), colL = 1536 + 8 * grp;
#pragma unroll
  for (int u = 0; u < (MODE == 1 ? 4 : 2); ++u) {
    const int t = MODE == 1 ? ((tid >> 5) + 16 * u) : ((tid >> 4) + 32 * u);
    if (t < ntok) { pf.lc[u] = *(const u32x4*)(P + (size_t)rw_row(seq, chunk, t) * PLD + colL); pf.lp[u] = *(const u32x4*)(rw_prev_row(p, l, seq, chunk, t) + colL); }
    else { pf.lc[u] = z; pf.lp[u] = z; }
  }
  const int t2 = tid >> 3, hc0 = h * 64 + 8 * (tid & 7);
  if (t2 < ntok) {
    const GAS bf16_t* rb = P + (size_t)rw_row(seq, chunk, t2) * PLD; const GAS bf16_t* pb = rw_prev_row(p, l, seq, chunk, t2);
#pragma unroll
    for (int part = 0; part < 3; ++part) { pf.rc[part] = *(const u32x4*)(rb + part * 512 + hc0); pf.rp[part] = *(const u32x4*)(pb + part * 512 + hc0); }
  } else {
#pragma unroll
    for (int part = 0; part < 3; ++part) { pf.rc[part] = z; pf.rp[part] = z; }
  }
}
__device__ __forceinline__ void unpack8(const u32x4 w, float* o) { o[0] = bflo(w.x); o[1] = bfhi(w.x); o[2] = bflo(w.y); o[3] = bfhi(w.y); o[4] = bflo(w.z); o[5] = bfhi(w.z); o[6] = bflo(w.w); o[7] = bfhi(w.w); }

typedef short s16x4_t __attribute__((ext_vector_type(4)));
__device__ __forceinline__ bf16x8 ldfrag_tr(const LAS bf16_t* ARR, int ct, int s, int lane) {
  const int g = lane >> 4, i = lane & 15;
  const LAS bf16_t* p = ARR + (32 * s + 8 * g + (i >> 2)) * LDB + 16 * ct + 4 * (i & 3);
  const s16x4_t lo = __builtin_amdgcn_ds_read_tr16_b64_v4i16((LAS s16x4_t*)p), hi = __builtin_amdgcn_ds_read_tr16_b64_v4i16((LAS s16x4_t*)(p + 4 * LDB));
  u32x4 w; w.x = __builtin_bit_cast(u32x2, lo).x; w.y = __builtin_bit_cast(u32x2, lo).y; w.z = __builtin_bit_cast(u32x2, hi).x; w.w = __builtin_bit_cast(u32x2, hi).y;
  return __builtin_bit_cast(bf16x8, w);
}
template <bool TX, bool TY>
__device__ __forceinline__ f32x4 mma_tt(const LAS bf16_t* X, int xt, const LAS bf16_t* Y, int yt, int lane, f32x4 acc) {
  const int r = lane & 15, q = lane >> 4;
#pragma unroll
  for (int s = 0; s < 2; ++s) {
    const bf16x8 xb = TX ? ldfrag_tr(X, xt, s, lane) : ldfrag(X + (16 * xt + r) * LDB + 32 * s + 8 * q);
    const bf16x8 ya = TY ? ldfrag_tr(Y, yt, s, lane) : ldfrag(Y + (16 * yt + r) * LDB + 32 * s + 8 * q);
    acc = __builtin_amdgcn_mfma_f32_16x16x32_bf16(ya, xb, acc, 0, 0, 0);
  }
  return acc;
}

template <int TY>
__device__ __forceinline__ f32x4 mma_px(const bf16x8 (&xf)[2], const LAS bf16_t* Y, int yt, int lane, f32x4 acc) {
  const int r = lane & 15, q = lane >> 4;
#pragma unroll
  for (int s = 0; s < 2; ++s) {
    const bf16x8 ya = TY == 1 ? ldfrag_tr(Y, yt, s, lane) : ldfrag(Y + (16 * yt + r) * LDB + 32 * s + 8 * q);
    acc = __builtin_amdgcn_mfma_f32_16x16x32_bf16(ya, xf[s], acc, 0, 0, 0);
  }
  return acc;
}
constexpr int L_PRM = L_RWEND;
static_assert(L_PRM + 640 * 4 <= 163824, "rwkv params LDS");

__device__ __forceinline__ void lds8(const LAS float* p, float* o) { const f32x4 a = *(const LAS f32x4*)p, b = *(const LAS f32x4*)(p + 4); o[0] = a[0]; o[1] = a[1]; o[2] = a[2]; o[3] = a[3]; o[4] = b[0]; o[5] = b[1]; o[6] = b[2]; o[7] = b[3]; }
template <int MODE>
__device__ __forceinline__ void rwkv_phase(const Ctx p, int l, LAS unsigned char* lds, int rep) {
  const int tid0 = opaque_tid(p.wv);
  const int h = p.bid & 7, slot = p.bid >> 3, nslot = p.nblk >> 3;
  constexpr int LIST = MODE;
  constexpr int NK = MODE == 0 ? NB * 65 + SBN : NB * 3 + SBN;
  LAS bf16_t* A_row = (LAS bf16_t*)(lds + L_R1);            LAS bf16_t* B_row = A_row + 64 * LDB;  LAS bf16_t* K_row = B_row + 64 * LDB;  LAS bf16_t* R_row = K_row + 64 * LDB;
  LAS bf16_t* AT = R_row + 64 * LDB;  LAS bf16_t* VT = AT + 64 * LDB;  LAS bf16_t* BCT = VT + 64 * LDB;  LAS bf16_t* KCT = BCT + 64 * LDB;
  static_assert(MODE == 0, "only the state pass is kept up to date (token-major operand arrays + transposed reads); the output side is rwkv_phase_lite");
  LAS bf16_t* WT = AT; LAS bf16_t* X1T = B_row; LAS bf16_t* UT = K_row;
  LAS bf16_t* V_row = VT; LAS bf16_t* BC_row = BCT; LAS bf16_t* KC_row = KCT;
  LAS bf16_t* XW = (LAS bf16_t*)(lds + L_R4); LAS bf16_t* XA = (LAS bf16_t*)(lds + L_R2) + 3 * 64 * LDB; LAS bf16_t* XG = (LAS bf16_t*)(lds + L_R2) + 128 * LDB;
  LAS bf16_t* Aak = (LAS bf16_t*)(lds + L_R2); LAS bf16_t* Arb = Aak + 64 * LDB; LAS bf16_t* Ark = Arb + 64 * LDB; LAS bf16_t* Tb = Ark + 64 * LDB;
  LAS float* F0 = (LAS float*)(lds + L_R3); LAS float* F1 = F0 + 64 * LDF;
  LAS float* Tf = (LAS float*)(lds + L_R3); LAS float* Zf = Tf + 64 * LDT;
  LAS bf16_t* Gb = (LAS bf16_t*)(lds + L_R4);
  LAS float* segsum = (LAS float*)(lds + L_R5); LAS float* cumC = segsum + 512; LAS float* bonS = cumC + 64;
  LAS float* prm = (LAS float*)(lds + L_PRM);
  constexpr int LDG = 136;
  const GAS bf16_t* P = (const GAS bf16_t*)(p.ws + WS_BIG);

  if (tid0 < 192) prm[tid0] = p.in[12][(size_t)l * ACOLS + (tid0 >> 6) * 512 + h * 64 + (tid0 & 63)];
  else if (tid0 < 256) {
    const int c = tid0 - 192, hc = l * AW + h * 64 + c;
    prm[192 + c] = p.in[13][hc]; prm[256 + c] = p.in[15][hc]; prm[320 + c] = p.in[18][hc]; prm[384 + c] = p.in[19][hc]; prm[448 + c] = p.in[20][hc];
    prm[512 + c] = p.in[21][hc]; prm[576 + c] = p.in[22][hc];
  }
  float muL[8];
  { const GAS float* mu = p.in[12] + (size_t)l * ACOLS + 1536 + 8 * (MODE == 1 ? (tid0 & 31) : (tid0 & 15));
#pragma unroll
    for (int i = 0; i < 8; ++i) muL[i] = mu[i]; }
  const GAS bf16_t* w2T = (const GAS bf16_t*)(p.ws + WS_LORA) + ((size_t)l * AH + h) * 16384;
  const GAS bf16_t* a2T = w2T + 4096; const GAS bf16_t* g2T = w2T + 8192;

  const bool bal = (MODE == 0) && (nslot == 32);
  int xk = -1;
  if (bal && slot < 26 && (p.bid % 13) >= 9) { int rank = 0; for (int s2 = 0; s2 < slot; ++s2) rank += ((h + 8 * s2) % 13) >= 9 ? 1 : 0; if (rank < 8) xk = 256 + rank; }
  const int nmine = bal ? (slot < 26 ? (xk >= 0 ? 9 : 8) : 10) : (MODE == 1 ? (NK - (nslot - 1 - slot) + nslot - 1) / nslot : (NK - slot + nslot - 1) / nslot);
#define RW_KTH(j) (MODE == 1 ? (nslot - 1 - slot) + (j) * nslot : bal ? ((j) < 8 ? (j) * 32 + slot : (slot < 26 ? xk : 264 + ((j) - 8) * 6 + (slot - 26))) : (slot + (j) * nslot))
  const int lane_h = tid0 & 63, fr = lane_h & 15, fq = lane_h >> 4, jt0_ = ((tid0 >> 6) & 1) * 2;
    bf16x8 fw[2][2], fa[2][2], fg[2][4];
#pragma unroll
    for (int jj = 0; jj < 2; ++jj) {
#pragma unroll
      for (int s = 0; s < 2; ++s) { fw[jj][s] = *(const bf16x8*)(w2T + (16 * (jt0_ + jj) + fr) * 64 + 32 * s + 8 * fq); fa[jj][s] = *(const bf16x8*)(a2T + (16 * (jt0_ + jj) + fr) * 64 + 32 * s + 8 * fq); }
      if (MODE == 1) {
#pragma unroll
        for (int s = 0; s < 4; ++s) fg[jj][s] = *(const bf16x8*)(g2T + (16 * (jt0_ + jj) + fr) * 128 + 32 * s + 8 * fq);
      }
    }
#define RW_STAGE1A(kk, tidx) do { int seq_, chunk_, item_; rw_item_ids<LIST>(h, (kk), seq_, chunk_, item_); const int ntok_ = (chunk_ == 0) ? 16 : 64; const int grp = (tidx) & 15; \
    _Pragma("unroll") for (int u = 0; u < 2; ++u) { const int tt = ((tidx) >> 4) + 32 * u; float cur[8], prv[8], o[8]; unpack8(pf.lc[u], cur); unpack8(pf.lp[u], prv); const bool valid = tt < ntok_; \
      _Pragma("unroll") for (int i = 0; i < 8; ++i) { const float pm = cur[i] + (prv[i] - cur[i]) * muL[i]; const float sg = __builtin_amdgcn_rcpf(1.f + __expf(-2.f * pm)); o[i] = grp < 8 ? 2.f * sg - 1.f : pm; if (!valid) o[i] = 0.f; } \
      u32x4 w; w.x = pk2(o[0], o[1]); w.y = pk2(o[2], o[3]); w.z = pk2(o[4], o[5]); w.w = pk2(o[6], o[7]); \
      if (grp < 8) *(LAS u32x4*)(XW + tt * LDB + 8 * grp) = w; else *(LAS u32x4*)(XA + tt * LDB + 8 * (grp - 8)) = w; } } while (0)
  RwPref pf;
  int jj = 0;
  if (jj < nmine * rep) rw_prefetch<MODE, LIST>(p, l, h, RW_KTH(jj % nmine), tid0, pf);
  if (jj < nmine * rep) RW_STAGE1A(RW_KTH(jj % nmine), tid0);
  __syncthreads();
#pragma unroll 1
  for (; jj < nmine * rep; ++jj) {
    const int k = RW_KTH(jj % nmine);
    int tid = tid0; asm volatile("" : "+v"(tid));
    const int lane = tid & 63, wave = tid >> 6, fr = lane & 15, fq = lane >> 4, t = tid >> 3, cg = tid & 7, c0 = 8 * cg, hc0 = h * 64 + c0;
    int seq, chunk, item; rw_item_ids<LIST>(h, k, seq, chunk, item);
    const bool samp = seq >= NB; const int sb = seq - NB;
    const int ntok = (chunk == 0) ? 16 : 64;
    const int it_ = wave >> 1, jt0_ = (wave & 1) * 2;
    const bool sto = (MODE == 0);
    {
#pragma unroll
      for (int jj = 0; jj < 2; ++jj) {
        const int jt = jt0_ + jj;
        f32x4 aw = (f32x4){0.f, 0.f, 0.f, 0.f}, aa = aw;
#pragma unroll
        for (int s = 0; s < 2; ++s) {
          aw = __builtin_amdgcn_mfma_f32_16x16x32_bf16(fw[jj][s], ldfrag(XW + (16 * it_ + fr) * LDB + 32 * s + 8 * fq), aw, 0, 0, 0);
          aa = __builtin_amdgcn_mfma_f32_16x16x32_bf16(fa[jj][s], ldfrag(XA + (16 * it_ + fr) * LDB + 32 * s + 8 * fq), aa, 0, 0, 0);
        }
        *(LAS f32x4*)(F0 + (16 * it_ + fr) * LDF + 16 * jt + 4 * fq) = aw;
        *(LAS f32x4*)(F1 + (16 * it_ + fr) * LDF + 16 * jt + 4 * fq) = aa;
        if (MODE == 1) {
          f32x4 ag = (f32x4){0.f, 0.f, 0.f, 0.f};
#pragma unroll
          for (int s = 0; s < 4; ++s) ag = __builtin_amdgcn_mfma_f32_16x16x32_bf16(fg[jj][s], ldfrag(XG + (16 * it_ + fr) * LDG + 32 * s + 8 * fq), ag, 0, 0, 0);
          *(LAS u32x2*)(Gb + (16 * it_ + fr) * LDB + 16 * jt + 4 * fq) = pack4(ag);
        }
      }
    }
    __syncthreads();
    float rr[8], kb[8], k2[8], vv[8], lw[8], nk[8];
    {
      const bool valid = t < ntok;
      float kraw[8];
#pragma unroll
      for (int part = 0; part < 3; ++part) {
        float cur[8], prv[8];
        unpack8(pf.rc[part], cur); unpack8(pf.rp[part], prv);
        float mu8[8]; lds8(prm + part * 64 + c0, mu8);
#pragma unroll
        for (int i = 0; i < 8; ++i) { const float pm = cur[i] + (prv[i] - cur[i]) * mu8[i]; if (part == 0) rr[i] = pm; else if (part == 1) kraw[i] = pm; else vv[i] = pm; }
      }
      const f32x4 dw0 = *(const LAS f32x4*)(F0 + t * LDF + c0), dw1 = *(const LAS f32x4*)(F0 + t * LDF + c0 + 4);
      const f32x4 da0 = *(const LAS f32x4*)(F1 + t * LDF + c0), da1 = *(const LAS f32x4*)(F1 + t * LDF + c0 + 4);
      float nrm = 0.f, bon = 0.f, av[8];
      float pw0[8], pa0[8], pkk[8], pka[8], prk[8];
      lds8(prm + 192 + c0, pw0); lds8(prm + 256 + c0, pa0); lds8(prm + 320 + c0, pkk); lds8(prm + 384 + c0, pka); lds8(prm + 448 + c0, prk);
#pragma unroll
      for (int i = 0; i < 8; ++i) {
        const float dwv = i < 4 ? dw0[i & 3] : dw1[i & 3], dav = i < 4 ? da0[i & 3] : da1[i & 3];
        lw[i] = valid ? -0.60653065971263342f * sigmoidf_(pw0[i] + dwv) : 0.f;
        av[i] = sigmoidf_(pa0[i] + dav);
        nk[i] = kraw[i] * pkk[i];
        nrm += nk[i] * nk[i];
        k2[i] = kraw[i] * (1.f + (av[i] - 1.f) * pka[i]);
        bon += rr[i] * k2[i] * prk[i];
      }
      nrm = sum8_all(nrm); bon = sum8_all(bon);
      const float rn = rsqrtf(nrm + 1e-12f);
#pragma unroll
      for (int i = 0; i < 8; ++i) { nk[i] *= rn; kb[i] = nk[i] * av[i]; }
      if (MODE == 1 && cg == 0) bonS[t] = bon;
      if (MODE == 0 && cg == 0) ((GAS float*)(p.ws + WS_BONUS))[(size_t)item * 64 + t] = bon;
      *(LAS f32x4*)(F0 + t * LDF + c0) = (f32x4){lw[0], lw[1], lw[2], lw[3]};
      *(LAS f32x4*)(F0 + t * LDF + c0 + 4) = (f32x4){lw[4], lw[5], lw[6], lw[7]};
    }
    __syncthreads();
    {
      const int c = tid & 63, seg = tid >> 6;
      float s = 0.f;
#pragma unroll
      for (int i = 0; i < 8; ++i) { s += F0[(8 * seg + i) * LDF + c]; F0[(8 * seg + i) * LDF + c] = s; }
      segsum[seg * 64 + c] = s;
      __syncthreads();
      float off = 0.f;
      for (int s2 = 0; s2 < seg; ++s2) off += segsum[s2 * 64 + c];
#pragma unroll
      for (int i = 0; i < 8; ++i) F0[(8 * seg + i) * LDF + c] += off;
      if (seg == 7) cumC[c] = s + off;
    }
    __syncthreads();
    {
      const f32x4 cu0 = *(const LAS f32x4*)(F0 + t * LDF + c0), cu1 = *(const LAS f32x4*)(F0 + t * LDF + c0 + 4);
      float oa[8], ob[8], ok[8], orr[8], obc[8], okc[8];
      float cc8[8]; lds8(cumC + c0, cc8);
#pragma unroll
      for (int i = 0; i < 8; ++i) {
        const float cu = i < 4 ? cu0[i & 3] : cu1[i & 3], cc = cc8[i];
        const float ec = __expf(cu), em1 = __expf(cu - lw[i]), ei = __expf(-cu), eC = __expf(cc - cu);
        oa[i] = -nk[i] * em1; ob[i] = kb[i] * ei; ok[i] = k2[i] * ei; orr[i] = rr[i] * ec; obc[i] = kb[i] * eC; okc[i] = k2[i] * eC;
      }
      u32x4 w;
      w.x = pk2(oa[0], oa[1]); w.y = pk2(oa[2], oa[3]); w.z = pk2(oa[4], oa[5]); w.w = pk2(oa[6], oa[7]); *(LAS u32x4*)(A_row + t * LDB + c0) = w;
      w.x = pk2(ob[0], ob[1]); w.y = pk2(ob[2], ob[3]); w.z = pk2(ob[4], ob[5]); w.w = pk2(ob[6], ob[7]); *(LAS u32x4*)(B_row + t * LDB + c0) = w;
      w.x = pk2(ok[0], ok[1]); w.y = pk2(ok[2], ok[3]); w.z = pk2(ok[4], ok[5]); w.w = pk2(ok[6], ok[7]); *(LAS u32x4*)(K_row + t * LDB + c0) = w;
      if (MODE == 1 || sto) { w.x = pk2(orr[0], orr[1]); w.y = pk2(orr[2], orr[3]); w.z = pk2(orr[4], orr[5]); w.w = pk2(orr[6], orr[7]); *(LAS u32x4*)(R_row + t * LDB + c0) = w; }
      w.x = pk2(vv[0], vv[1]); w.y = pk2(vv[2], vv[3]); w.z = pk2(vv[4], vv[5]); w.w = pk2(vv[6], vv[7]); *(LAS u32x4*)(V_row + t * LDB + c0) = w;
      w.x = pk2(obc[0], obc[1]); w.y = pk2(obc[2], obc[3]); w.z = pk2(obc[4], obc[5]); w.w = pk2(obc[6], obc[7]); *(LAS u32x4*)(BC_row + t * LDB + c0) = w;
      w.x = pk2(okc[0], okc[1]); w.y = pk2(okc[2], okc[3]); w.z = pk2(okc[4], okc[5]); w.w = pk2(okc[6], okc[7]); *(LAS u32x4*)(KC_row + t * LDB + c0) = w;
    }
    if (jj + 1 < nmine * rep) { int tidp = tid; asm volatile("" : "+v"(tidp)); rw_prefetch<MODE, LIST>(p, l, h, RW_KTH((jj + 1) % nmine), tidp, pf); }
    GAS bf16_t* MTg = (GAS bf16_t*)(p.ws + WS_AUX) + (size_t)item * 8192;
    u32x4 trec = (u32x4){0u, 0u, 0u, 0u};
    if (MODE == 1) trec = *(const GAS u32x4*)(rw_trec(p.ws, l, item) + t * 64 + c0);
    GAS bf16_t* Ng = MTg + 4096;
    __syncthreads();
    {
      const int it = wave >> 1, jt0 = (wave & 1) * 2;
      bf16x8 xA[2];
#pragma unroll
      for (int sx = 0; sx < 2; ++sx) xA[sx] = ldfrag(A_row + (16 * it + fr) * LDB + 32 * sx + 8 * fq);
#pragma unroll
      for (int jj = 0; jj < 2; ++jj) {
        const int jt = jt0 + jj, i = 16 * it + fr, j0 = 16 * jt + 4 * fq;
        f32x4 ab = (f32x4){0.f, 0.f, 0.f, 0.f};
        if (jt <= it) ab = mma_px<0>(xA, B_row, jt, lane, ab);
#pragma unroll
        for (int u = 0; u < 4; ++u) if (j0 + u >= i) ab[u] = 0.f;
        *(LAS f32x4*)(Tf + i * LDT + j0) = ab;
      }
    }
    __syncthreads();
    if (wave < 2) {
      if (lane < 32) {
        const int bb = 2 * wave + (lane >> 4), j = lane & 15; LAS float* Ab = Tf + (16 * bb) * LDT + 16 * bb;
        float x[16];
#pragma unroll
        for (int i = 0; i < 16; ++i) {
          float s = (i == j) ? 1.f : 0.f;
#pragma unroll
          for (int m = 0; m < i; ++m) s += Ab[i * LDT + m] * x[m];
          x[i] = (i < j) ? 0.f : s;
        }
#pragma unroll
        for (int i = 0; i < 16; ++i) Ab[i * LDT + j] = x[i];
      }
      asm volatile("s_waitcnt lgkmcnt(0)" ::: "memory");
      const int r0 = 32 * wave + 16, cb = 32 * wave, lm = lane & 15, lk = lane >> 4;
      f32x4 z = (f32x4){0.f, 0.f, 0.f, 0.f};
#pragma unroll
      for (int ks = 0; ks < 4; ++ks) z = __builtin_amdgcn_mfma_f32_16x16x4f32(Tf[(r0 + lm) * LDT + cb + 4 * ks + lk], Tf[(cb + 4 * ks + lk) * LDT + cb + lm], z, 0, 0, 0);
#pragma unroll
      for (int r = 0; r < 4; ++r) Zf[(r0 + 4 * lk + r) * LDT + cb + lm] = z[r];
      asm volatile("s_waitcnt lgkmcnt(0)" ::: "memory");
      f32x4 o = (f32x4){0.f, 0.f, 0.f, 0.f};
#pragma unroll
      for (int ks = 0; ks < 4; ++ks) o = __builtin_amdgcn_mfma_f32_16x16x4f32(Tf[(r0 + lm) * LDT + r0 + 4 * ks + lk], Zf[(r0 + 4 * ks + lk) * LDT + cb + lm], o, 0, 0, 0);
#pragma unroll
      for (int r = 0; r < 4; ++r) Tf[(r0 + 4 * lk + r) * LDT + cb + lm] = o[r];
    } else {
#pragma unroll 1
      for (int pass = (wave == 3 ? 0 : 1); pass < 2; ++pass) {
        const int it = pass == 0 ? 0 : (wave >> 1), jtb = pass == 0 ? 0 : (wave & 1) * 2, jte = pass == 0 ? 4 : jtb + 2;
        bf16x8 xA[2], xR[2];
#pragma unroll
        for (int sx = 0; sx < 2; ++sx) { xA[sx] = ldfrag(A_row + (16 * it + fr) * LDB + 32 * sx + 8 * fq); xR[sx] = ldfrag(R_row + (16 * it + fr) * LDB + 32 * sx + 8 * fq); }
#pragma unroll 1
        for (int jt = jtb; jt < jte; ++jt) {
          const int i = 16 * it + fr, j0 = 16 * jt + 4 * fq;
          f32x4 z = (f32x4){0.f, 0.f, 0.f, 0.f};
          f32x4 ak = z, rb = z, rk = z;
          if (jt <= it) {
#pragma unroll
            for (int sx = 0; sx < 2; ++sx) {
              const bf16x8 yK = ldfrag(K_row + (16 * jt + fr) * LDB + 32 * sx + 8 * fq), yB = ldfrag(B_row + (16 * jt + fr) * LDB + 32 * sx + 8 * fq);
              ak = __builtin_amdgcn_mfma_f32_16x16x32_bf16(yK, xA[sx], ak, 0, 0, 0);
              rb = __builtin_amdgcn_mfma_f32_16x16x32_bf16(yB, xR[sx], rb, 0, 0, 0);
              rk = __builtin_amdgcn_mfma_f32_16x16x32_bf16(yK, xR[sx], rk, 0, 0, 0);
            }
          }
#pragma unroll
          for (int u = 0; u < 4; ++u) { if (j0 + u >= i) ak[u] = 0.f; if (j0 + u > i) { rb[u] = 0.f; rk[u] = 0.f; } }
          *(LAS u32x2*)(Aak + i * LDB + j0) = pack4(ak);
          *(LAS u32x2*)(Arb + i * LDB + j0) = pack4(rb);
          *(LAS u32x2*)(Ark + i * LDB + j0) = pack4(rk);
        }
      }
    }
    __syncthreads();
    {
    if (wave < 4) {
      const int ti = wave >> 1, tj = wave & 1, lm = lane & 15, lk = lane >> 4;
      f32x4 z = (f32x4){0.f, 0.f, 0.f, 0.f};
#pragma unroll
      for (int ks = 0; ks < 8; ++ks) z = __builtin_amdgcn_mfma_f32_16x16x4f32(Tf[(32 + 16 * ti + lm) * LDT + 4 * ks + lk], Tf[(4 * ks + lk) * LDT + 16 * tj + lm], z, 0, 0, 0);
#pragma unroll
      for (int r = 0; r < 4; ++r) Zf[(32 + 16 * ti + 4 * lk + r) * LDT + 16 * tj + lm] = z[r];
    } else {
      const int w4 = tid - 256;
#pragma unroll
      for (int q = 0; q < 2; ++q) {
        const int idx = w4 + 256 * q;
        if (idx < 384) {
          const int row = idx < 256 ? (idx >> 3) : 32 + ((idx - 256) >> 2), ch = idx < 256 ? (idx & 7) : 4 + ((idx - 256) & 3);
          float o[8]; lds8(Tf + row * LDT + 8 * ch, o);
          u32x4 w; w.x = pk2(o[0], o[1]); w.y = pk2(o[2], o[3]); w.z = pk2(o[4], o[5]); w.w = pk2(o[6], o[7]);
          *(LAS u32x4*)(Tb + row * LDB + 8 * ch) = w;
        }
      }
    }
    __syncthreads();
    if (wave < 4) {
      const int ti = wave >> 1, tj = wave & 1, lm = lane & 15, lk = lane >> 4;
      f32x4 o = (f32x4){0.f, 0.f, 0.f, 0.f};
#pragma unroll
      for (int ks = 0; ks < 8; ++ks) o = __builtin_amdgcn_mfma_f32_16x16x4f32(Tf[(32 + 16 * ti + lm) * LDT + 32 + 4 * ks + lk], Zf[(32 + 4 * ks + lk) * LDT + 16 * tj + lm], o, 0, 0, 0);
#pragma unroll
      for (int r = 0; r < 4; ++r) Tb[(32 + 16 * ti + 4 * lk + r) * LDB + 16 * tj + lm] = (bf16_t)f2bf(o[r]);
    } else {
      const int it = wave - 4;
      bf16x8 xv[2];
#pragma unroll
      for (int sx = 0; sx < 2; ++sx) xv[sx] = ldfrag_tr(V_row, it, sx, lane);
#pragma unroll
      for (int jt = 0; jt < 4; ++jt) {
        const f32x4 x1 = mma_px<0>(xv, Aak, jt, lane, (f32x4){0.f, 0.f, 0.f, 0.f});
        *(LAS u32x2*)(X1T + (16 * it + fr) * LDB + 16 * jt + 4 * fq) = pack4(x1);
      }
    }
    __syncthreads();
    }
    bf16x8 s0f[4][2];
    if (MODE == 1 && wave < 4) {
#pragma unroll
      for (int jt = 0; jt < 4; ++jt)
#pragma unroll
        for (int s = 0; s < 2; ++s) s0f[jt][s] = *(const bf16x8*)(Ng + (16 * jt + fr) * 64 + 32 * s + 8 * fq);
    }
    {
      const int it = wave >> 1, jt0 = (wave & 1) * 2;
      bf16x8 xa[2], xx[2];
#pragma unroll
      for (int sx = 0; sx < 2; ++sx) { xa[sx] = ldfrag_tr(A_row, it, sx, lane); xx[sx] = ldfrag(X1T + (16 * it + fr) * LDB + 32 * sx + 8 * fq); }
#pragma unroll
      for (int jj = 0; jj < 2; ++jj) {
        const int jt = jt0 + jj, i = 16 * it + fr, j0 = 16 * jt + 4 * fq;
        f32x4 z = (f32x4){0.f, 0.f, 0.f, 0.f};
        const f32x4 wt = mma_px<0>(xa, Tb, jt, lane, z);
        const f32x4 ut = mma_px<0>(xx, Tb, jt, lane, z);
        *(LAS u32x2*)(WT + i * LDB + j0) = pack4(wt);
        *(LAS u32x2*)(UT + i * LDB + j0) = pack4(ut);
      }
    }
    __syncthreads();
    if (MODE == 0) {
      const int it = wave >> 1, jt0 = (wave & 1) * 2;
      u32x2 recp[4][2];
#pragma unroll
      for (int a_ = 0; a_ < 4; ++a_) { recp[a_][0] = (u32x2){0u, 0u}; recp[a_][1] = (u32x2){0u, 0u}; }
      bf16x8 xbc[2], xut[2], xvt[2], xrb[2], xrk[2];
#pragma unroll
      for (int sx = 0; sx < 2; ++sx) {
        xbc[sx] = ldfrag_tr(BC_row, it, sx, lane); xvt[sx] = ldfrag_tr(V_row, it, sx, lane);
        xut[sx] = ldfrag(UT + (16 * it + fr) * LDB + 32 * sx + 8 * fq); xrb[sx] = ldfrag(Arb + (16 * it + fr) * LDB + 32 * sx + 8 * fq); xrk[sx] = ldfrag(Ark + (16 * it + fr) * LDB + 32 * sx + 8 * fq);
      }
#pragma unroll
      for (int jj = 0; jj < 2; ++jj) {
        const int jt = jt0 + jj, i = 16 * it + fr, j0 = 16 * jt + 4 * fq;
        f32x4 z = (f32x4){0.f, 0.f, 0.f, 0.f};
        f32x4 mt = mma_px<0>(xbc, WT, jt, lane, z);
#pragma unroll
        for (int u = 0; u < 4; ++u) if (j0 + u == i) mt[u] += __expf(cumC[i]);
        recp[0][jj] = pack4(mt);
        f32x4 nn = mma_px<1>(xut, BC_row, jt, lane, z);
        nn = mma_px<1>(xvt, KC_row, jt, lane, nn);
        recp[1][jj] = pack4(nn);
        if (sto) {
          f32x4 qh = mma_px<0>(xrb, WT, jt, lane, z);
          const u32x2 rv = *(const LAS u32x2*)(R_row + i * LDB + j0);
          qh[0] += bflo(rv.x); qh[1] += bfhi(rv.x); qh[2] += bflo(rv.y); qh[3] += bfhi(rv.y);
          recp[2][jj] = pack4(qh);
          f32x4 yh = mma_px<0>(xrb, UT, jt, lane, z);
          yh = mma_px<1>(xrk, V_row, jt, lane, yh);
          recp[3][jj] = pack4(yh);
        }
      }
      {
        const int ro = (16 * it + fr) * 64 + 32 * (jt0 >> 1) + 8 * fq;
        GAS bf16_t* Qg = rw_qrec(p, l, seq, h, chunk);
        u32x4 w;
        w.x = recp[0][0].x; w.y = recp[0][0].y; w.z = recp[0][1].x; w.w = recp[0][1].y; *(GAS u32x4*)(MTg + ro) = w;
        w.x = recp[1][0].x; w.y = recp[1][0].y; w.z = recp[1][1].x; w.w = recp[1][1].y; *(GAS u32x4*)(Ng + ro) = w;
        if (sto) {
          w.x = recp[2][0].x; w.y = recp[2][0].y; w.z = recp[2][1].x; w.w = recp[2][1].y; *(GAS u32x4*)(Qg + ro) = w;
          w.x = recp[3][0].x; w.y = recp[3][0].y; w.z = recp[3][1].x; w.w = recp[3][1].y; *(GAS u32x4*)(Qg + 4096 + ro) = w;
        }
      }
      const bool lastc = samp ? true : (chunk == 64);
      if (h == 0 && lastc) {
        const int lastrow = samp ? (R_SAMP + 16 * sb + 15) : (SEQ * seq + SEQ - 1);
        GAS float* sh = p.out + (samp ? O_SSHIFT : O_PSHIFT) + ((size_t)l * (samp ? SBN : NB) + (samp ? sb : seq)) * ACOLS;
        for (int e = tid; e < ACOLS; e += 512) sh[e] = bf2f(P[(size_t)lastrow * PLD + e]);
      }
    } else {
      {
        const int it = wave >> 1, jt0 = (wave & 1) * 2;
#pragma unroll
        for (int jj = 0; jj < 2; ++jj) {
          const int jt = jt0 + jj, i = 16 * it + fr, j0 = 16 * jt + 4 * fq;
          f32x4 qh = mma_nt<64>(Arb + 16 * it * LDB, LDB, WT + 16 * jt * LDB, LDB, lane, (f32x4){0.f, 0.f, 0.f, 0.f});
          const u32x2 rv = *(const LAS u32x2*)(R_row + i * LDB + j0);
          qh[0] += bflo(rv.x); qh[1] += bfhi(rv.x); qh[2] += bflo(rv.y); qh[3] += bfhi(rv.y);
          *(LAS u32x2*)(R_row + i * LDB + j0) = pack4(qh);
        }
      }
      __syncthreads();
      LAS float* OUTf = F0;
      if (wave < 4) {
        const int it = wave, i = 16 * it + fr;
        f32x4 y[4];
        float s1 = 0.f, s2 = 0.f;
#pragma unroll
        for (int jt = 0; jt < 4; ++jt) {
          f32x4 a = (f32x4){0.f, 0.f, 0.f, 0.f};
#pragma unroll
          for (int s = 0; s < 2; ++s) a = __builtin_amdgcn_mfma_f32_16x16x32_bf16(s0f[jt][s], ldfrag(R_row + (16 * it + fr) * LDB + 32 * s + 8 * fq), a, 0, 0, 0);
          a = mma_nt<64>(Arb + 16 * it * LDB, LDB, UT + 16 * jt * LDB, LDB, lane, a);
          a = mma_sw<64, false, true>(Ark + 16 * it * LDB, LDB, it, VT + 16 * jt * LDB, LDB, jt, lane, a);
          y[jt] = a;
          s1 += a[0] + a[1] + a[2] + a[3];
        }
        s1 = add_xor32(add_xor16(s1));
        const float mean = s1 * (1.f / 64.f);
#pragma unroll
        for (int jt = 0; jt < 4; ++jt) { y[jt] = y[jt] - mean; s2 += y[jt][0] * y[jt][0] + y[jt][1] * y[jt][1] + y[jt][2] * y[jt][2] + y[jt][3] * y[jt][3]; }
        s2 = add_xor32(add_xor16(s2));
        const float rs = rsqrtf(s2 * (1.f / 64.f) + GN_EPS);
#pragma unroll
        for (int jt = 0; jt < 4; ++jt) *(LAS f32x4*)(OUTf + i * LDF + 16 * jt + 4 * fq) = y[jt] * rs;
      }
      __syncthreads();
      if (t < ntok) {
        const f32x4 y0 = *(const LAS f32x4*)(OUTf + t * LDF + c0), y1 = *(const LAS f32x4*)(OUTf + t * LDF + c0 + 4);
        const u32x4 gw = *(const LAS u32x4*)(Gb + t * LDB + c0);
        const float g[8] = {bflo(gw.x), bfhi(gw.x), bflo(gw.y), bfhi(gw.y), bflo(gw.z), bfhi(gw.z), bflo(gw.w), bfhi(gw.w)};
        const float bon = bonS[t];
        float o[8];
#pragma unroll
        for (int i = 0; i < 8; ++i) {
          const float yn = i < 4 ? y0[i & 3] : y1[i & 3];
          o[i] = (yn * prm[512 + c0 + i] + prm[576 + c0 + i] + bon * vv[i]) * g[i];
        }
        u32x4 w; w.x = pk2(o[0], o[1]); w.y = pk2(o[2], o[3]); w.z = pk2(o[4], o[5]); w.w = pk2(o[6], o[7]);
        *(GAS u32x4*)((GAS bf16_t*)p.out + (size_t)rw_row(seq, chunk, t) * DM + hc0) = w;
      }
    }
    if (jj + 1 < nmine * rep) { int tidq = tid; asm volatile("" : "+v"(tidq)); RW_STAGE1A(RW_KTH((jj + 1) % nmine), tidq); }
    __syncthreads();
  }
}

__device__ __forceinline__ void rwkv_phase_lite(const Ctx p, int l, LAS unsigned char* lds) {
  const int tid0 = opaque_tid(p.wv);
  const int h = p.bid & 7, slot = p.bid >> 3, nslot = p.nblk >> 3;
  constexpr int NK = NB * 65 + SBN;
  constexpr int LDG = 136;
  LAS bf16_t* XG = (LAS bf16_t*)(lds + L_R2) + 128 * LDB;
  LAS float* OUTl = (LAS float*)(lds + L_R3);
  LAS bf16_t* Gb = (LAS bf16_t*)(lds + L_R4);
  LAS float* prm = (LAS float*)(lds + L_PRM);
  if (tid0 < 64) prm[128 + tid0] = p.in[12][(size_t)l * ACOLS + 2 * 512 + h * 64 + tid0];
  else if (tid0 < 128) { const int c = tid0 - 64, hc = l * AW + h * 64 + c; prm[512 + c] = p.in[21][hc]; prm[576 + c] = p.in[22][hc]; }
  float muL[8];
  { const GAS float* mu = p.in[12] + (size_t)l * ACOLS + 1536 + 128 + 8 * (tid0 & 15);
#pragma unroll
    for (int i = 0; i < 8; ++i) muL[i] = mu[i]; }
  const GAS bf16_t* g2T = (const GAS bf16_t*)(p.ws + WS_LORA) + ((size_t)l * AH + h) * 16384 + 8192;
  const GAS bf16_t* P = (const GAS bf16_t*)(p.ws + WS_BIG);
  const GAS float* bonG = (const GAS float*)(p.ws + WS_BONUS);
  const int nmine = (NK - slot + nslot - 1) / nslot;
  u32x4 glc[2], glp[2], vc, vp; float bonp;
#define LITE_PREFETCH(kk, tidx) do { int seq_, chunk_, item_; rw_item_ids<0>(h, (kk), seq_, chunk_, item_); const int ntok_ = (chunk_ == 0) ? 16 : 64; const u32x4 z_ = (u32x4){0u, 0u, 0u, 0u}; \
    _Pragma("unroll") for (int u = 0; u < 2; ++u) { const int t_ = ((tidx) >> 4) + 32 * u; \
      if (t_ < ntok_) { glc[u] = *(const GAS u32x4*)(P + (size_t)rw_row(seq_, chunk_, t_) * PLD + 1536 + 128 + 8 * ((tidx) & 15)); glp[u] = *(const GAS u32x4*)(rw_prev_row(p, l, seq_, chunk_, t_) + 1536 + 128 + 8 * ((tidx) & 15)); } \
      else { glc[u] = z_; glp[u] = z_; } } \
    { const int t2_ = (tidx) >> 3, hc0_ = h * 64 + 8 * ((tidx) & 7); \
      if (t2_ < ntok_) { vc = *(const GAS u32x4*)(P + (size_t)rw_row(seq_, chunk_, t2_) * PLD + 1024 + hc0_); vp = *(const GAS u32x4*)(rw_prev_row(p, l, seq_, chunk_, t2_) + 1024 + hc0_); } else { vc = z_; vp = z_; } \
      bonp = bonG[(size_t)item_ * 64 + t2_]; } } while (0)
  glc[0] = glc[1] = glp[0] = glp[1] = vc = vp = (u32x4){0u, 0u, 0u, 0u}; bonp = 0.f;
  if (nmine > 0) LITE_PREFETCH(slot, tid0);
  bf16x8 s0l[4][2], qhl[2]; u32x2 yhl[4];
#define LITE_RECLOAD(kk, tidx) do { int seq_, chunk_, item_; rw_item_ids<0>(h, (kk), seq_, chunk_, item_); const int ln_ = (tidx) & 63, wv_ = (tidx) >> 6, fr_ = ln_ & 15, fq_ = ln_ >> 4; \
    const GAS bf16_t* Qg_ = rw_qrec(p, l, seq_, h, chunk_); const GAS bf16_t* S0g_ = (const GAS bf16_t*)(p.ws + WS_AUX) + (size_t)item_ * 8192 + 4096; \
    _Pragma("unroll") for (int jt = 0; jt < 4; ++jt) { _Pragma("unroll") for (int s2 = 0; s2 < 2; ++s2) s0l[jt][s2] = *(const GAS bf16x8*)(S0g_ + (16 * jt + fr_) * 64 + 32 * s2 + 8 * fq_); } \
    _Pragma("unroll") for (int s2 = 0; s2 < 2; ++s2) qhl[s2] = *(const GAS bf16x8*)(Qg_ + (16 * wv_ + fr_) * 64 + 32 * s2 + 8 * fq_); \
    _Pragma("unroll") for (int s2 = 0; s2 < 2; ++s2) { const u32x4 d = *(const GAS u32x4*)(Qg_ + 4096 + (size_t)(16 * wv_ + fr_) * 64 + 32 * s2 + 8 * fq_); yhl[2 * s2].x = d.x; yhl[2 * s2].y = d.y; yhl[2 * s2 + 1].x = d.z; yhl[2 * s2 + 1].y = d.w; } } while (0)
#pragma unroll
  for (int jt = 0; jt < 4; ++jt) { s0l[jt][0] = s0l[jt][1] = (bf16x8){0, 0, 0, 0, 0, 0, 0, 0}; yhl[jt] = (u32x2){0u, 0u}; }
  qhl[0] = qhl[1] = (bf16x8){0, 0, 0, 0, 0, 0, 0, 0};
  if (nmine > 0 && (tid0 >> 6) < 4) LITE_RECLOAD(slot, tid0);
  bf16x8 fg2[2][4];
  { const int lane0 = tid0 & 63, wave0 = tid0 >> 6, fr0 = lane0 & 15, fq0 = lane0 >> 4, jt00 = (wave0 & 1) * 2;
#pragma unroll
    for (int jj = 0; jj < 2; ++jj)
#pragma unroll
      for (int s2 = 0; s2 < 4; ++s2) fg2[jj][s2] = *(const GAS bf16x8*)(g2T + (16 * (jt00 + jj) + fr0) * 128 + 32 * s2 + 8 * fq0);
  }
#define LITE_STAGE1(kk, tidx, vvdst, bondst) do { int seq_, chunk_, item_; rw_item_ids<0>(h, (kk), seq_, chunk_, item_); const int ntok_ = (chunk_ == 0) ? 16 : 64; \
    _Pragma("unroll") for (int u = 0; u < 2; ++u) { const int tt = ((tidx) >> 4) + 32 * u; float cur[8], prv[8], o[8]; unpack8(glc[u], cur); unpack8(glp[u], prv); \
      _Pragma("unroll") for (int i = 0; i < 8; ++i) { const float pm = cur[i] + (prv[i] - cur[i]) * muL[i]; o[i] = (tt < ntok_) ? sigmoidf_(pm) : 0.f; } \
      u32x4 w; w.x = pk2(o[0], o[1]); w.y = pk2(o[2], o[3]); w.z = pk2(o[4], o[5]); w.w = pk2(o[6], o[7]); *(LAS u32x4*)(XG + tt * LDG + 8 * ((tidx) & 15)) = w; } \
    { float cur[8], prv[8], muv8[8]; unpack8(vc, cur); unpack8(vp, prv); lds8(prm + 128 + 8 * ((tidx) & 7), muv8); \
      _Pragma("unroll") for (int i = 0; i < 8; ++i) vvdst[i] = cur[i] + (prv[i] - cur[i]) * muv8[i]; } \
    bondst = bonp; } while (0)
  float vv2[8], vvn[8]; float bon2 = 0.f, bonn = 0.f;
#pragma unroll
  for (int i = 0; i < 8; ++i) { vv2[i] = 0.f; vvn[i] = 0.f; }
  __syncthreads();
  if (nmine > 0) {
    LITE_STAGE1(slot, tid0, vv2, bon2);
    if (nmine > 1) LITE_PREFETCH(slot + nslot, tid0);
  }
  __syncthreads();
#pragma unroll 1
  for (int jj = 0; jj < nmine; ++jj) {
    const int k = slot + jj * nslot;
    int tid = tid0; asm volatile("" : "+v"(tid));
    const int lane = tid & 63, wave = tid >> 6, fr = lane & 15, fq = lane >> 4, t = tid >> 3, c0 = 8 * (tid & 7), hc0 = h * 64 + c0;
    int seq, chunk, item; rw_item_ids<0>(h, k, seq, chunk, item);
    const int ntok = (chunk == 0) ? 16 : 64;
    const int it_ = wave >> 1, jt0_ = (wave & 1) * 2;
#pragma unroll
    for (int j2 = 0; j2 < 2; ++j2) {
      const int jt = jt0_ + j2;
      f32x4 ag = (f32x4){0.f, 0.f, 0.f, 0.f};
#pragma unroll
      for (int s2 = 0; s2 < 4; ++s2) ag = __builtin_amdgcn_mfma_f32_16x16x32_bf16(fg2[j2][s2], ldfrag(XG + (16 * it_ + fr) * LDG + 32 * s2 + 8 * fq), ag, 0, 0, 0);
      *(LAS u32x2*)(Gb + (16 * it_ + fr) * LDB + 16 * jt + 4 * fq) = pack4(ag);
    }
    if (wave < 4) {
      const int i = 16 * wave + fr;
      f32x4 y[4];
      float s1 = 0.f, s2v = 0.f;
#pragma unroll
      for (int jt = 0; jt < 4; ++jt) {
        const u32x2 yh = yhl[jt];
        f32x4 a = (f32x4){bflo(yh.x), bfhi(yh.x), bflo(yh.y), bfhi(yh.y)};
#pragma unroll
        for (int s2 = 0; s2 < 2; ++s2) a = __builtin_amdgcn_mfma_f32_16x16x32_bf16(s0l[jt][s2], qhl[s2], a, 0, 0, 0);
        y[jt] = a;
        s1 += a[0] + a[1] + a[2] + a[3];
      }
      s1 = add_xor32(add_xor16(s1));
      const float mean = s1 * (1.f / 64.f);
#pragma unroll
      for (int jt = 0; jt < 4; ++jt) { y[jt] = y[jt] - mean; s2v += y[jt][0] * y[jt][0] + y[jt][1] * y[jt][1] + y[jt][2] * y[jt][2] + y[jt][3] * y[jt][3]; }
      s2v = add_xor32(add_xor16(s2v));
      const float rs = rsqrtf(s2v * (1.f / 64.f) + GN_EPS);
#pragma unroll
      for (int jt = 0; jt < 4; ++jt) *(LAS f32x4*)(OUTl + i * LDF + 16 * jt + 4 * fq) = y[jt] * rs;
      if (jj + 1 < nmine) { int tidr = tid; asm volatile("" : "+v"(tidr)); LITE_RECLOAD(slot + (jj + 1) * nslot, tidr); }
    }
    __syncthreads();
    if (t < ntok) {
      const f32x4 y0 = *(const LAS f32x4*)(OUTl + t * LDF + c0), y1 = *(const LAS f32x4*)(OUTl + t * LDF + c0 + 4);
      float g[8]; unpack8(*(const LAS u32x4*)(Gb + t * LDB + c0), g);
      float lnw8[8], lnb8[8]; lds8(prm + 512 + c0, lnw8); lds8(prm + 576 + c0, lnb8);
      float o[8];
#pragma unroll
      for (int i = 0; i < 8; ++i) { const float yn = i < 4 ? y0[i & 3] : y1[i & 3]; o[i] = (yn * lnw8[i] + lnb8[i] + bon2 * vv2[i]) * g[i]; }
      u32x4 w; w.x = pk2(o[0], o[1]); w.y = pk2(o[2], o[3]); w.z = pk2(o[4], o[5]); w.w = pk2(o[6], o[7]);
      *(GAS u32x4*)((GAS bf16_t*)p.out + (size_t)rw_row(seq, chunk, t) * DM + hc0) = w;
    }
    if (jj + 1 < nmine) {
      int tidp = tid; asm volatile("" : "+v"(tidp));
      LITE_STAGE1(slot + (jj + 1) * nslot, tidp, vvn, bonn);
      if (jj + 2 < nmine) LITE_PREFETCH(slot + (jj + 2) * nslot, tidp);
#pragma unroll
      for (int i = 0; i < 8; ++i) vv2[i] = vvn[i];
      bon2 = bonn;
    }
    __syncthreads();
  }
#undef LITE_STAGE1
#undef LITE_PREFETCH
#undef LITE_RECLOAD
}

__device__ __forceinline__ void rwkv_scan_chain(const Ctx p, int l, int chain, int vt, int lane, bool dry) {
  const int fr = lane & 15, fq = lane >> 4;
  const bool samp = chain >= 32;
  const int seq = samp ? NB + ((chain - 32) >> 3) : (chain >> 3), h = samp ? ((chain - 32) & 7) : (chain & 7);
  const int nstep = samp ? 1 : 65, item0 = samp ? (RW_NPROMPT + (chain - 32)) : chain * 65;
  f32x4 acc[2][4];
  if (samp) {
#pragma unroll
    for (int u = 0; u < 2; ++u) {
      const GAS float* s0 = p.in[3] + ((((size_t)l * SBN + (seq - NB)) * AH + h) * 64 + 16 * (2 * vt + u) + fr) * 64;
#pragma unroll
      for (int i = 0; i < 4; ++i) acc[u][i] = *(const GAS f32x4*)(s0 + 16 * i + 4 * fq);
    }
  } else {
#pragma unroll
    for (int u = 0; u < 2; ++u)
#pragma unroll
      for (int i = 0; i < 4; ++i) acc[u][i] = (f32x4){0.f, 0.f, 0.f, 0.f};
  }
  GAS bf16_t* base = (GAS bf16_t*)(p.ws + WS_AUX) + (size_t)item0 * 8192;
  bf16x8 am[4][2]; u32x2 nn[2][4];
#pragma unroll
  for (int i = 0; i < 4; ++i) {
#pragma unroll
    for (int s = 0; s < 2; ++s) am[i][s] = *(const GAS bf16x8*)(base + (16 * i + fr) * 64 + 32 * s + 8 * fq);
  }
#pragma unroll
  for (int u = 0; u < 2; ++u)
#pragma unroll
    for (int s = 0; s < 2; ++s) {
      const u32x4 d = *(const GAS u32x4*)(base + 4096 + (16 * (2 * vt + u) + fr) * 64 + 32 * s + 8 * fq);
      nn[u][2 * s].x = d.x; nn[u][2 * s].y = d.y; nn[u][2 * s + 1].x = d.z; nn[u][2 * s + 1].y = d.w;
    }
#pragma unroll 1
  for (int st = 0; st < nstep; ++st) {
    GAS bf16_t* cur = base + (size_t)st * 8192;
    bf16x8 bfr[2][2];
#pragma unroll
    for (int u = 0; u < 2; ++u) {
      u32x2 sp[4];
#pragma unroll
      for (int i = 0; i < 4; ++i) sp[i] = pack4(acc[u][i]);
#pragma unroll
      for (int s = 0; s < 2; ++s) { u32x4 w; w.x = sp[2 * s].x; w.y = sp[2 * s].y; w.z = sp[2 * s + 1].x; w.w = sp[2 * s + 1].y; bfr[u][s] = __builtin_bit_cast(bf16x8, w);
        if (!dry) *(GAS u32x4*)(cur + 4096 + (16 * (2 * vt + u) + fr) * 64 + 32 * s + 8 * fq) = w; }
    }
    f32x4 na[2][4];
#pragma unroll
    for (int u = 0; u < 2; ++u)
#pragma unroll
      for (int i = 0; i < 4; ++i) {
        na[u][i] = (f32x4){bflo(nn[u][i].x), bfhi(nn[u][i].x), bflo(nn[u][i].y), bfhi(nn[u][i].y)};
#pragma unroll
        for (int s = 0; s < 2; ++s) na[u][i] = __builtin_amdgcn_mfma_f32_16x16x32_bf16(am[i][s], bfr[u][s], na[u][i], 0, 0, 0);
      }
    if (st + 1 < nstep) {
      const GAS bf16_t* nx = cur + 8192;
#pragma unroll
      for (int i = 0; i < 4; ++i) {
#pragma unroll
        for (int s = 0; s < 2; ++s) am[i][s] = *(const GAS bf16x8*)(nx + (16 * i + fr) * 64 + 32 * s + 8 * fq);
      }
#pragma unroll
      for (int u = 0; u < 2; ++u)
#pragma unroll
        for (int s = 0; s < 2; ++s) {
          const u32x4 d = *(const GAS u32x4*)(nx + 4096 + (16 * (2 * vt + u) + fr) * 64 + 32 * s + 8 * fq);
          nn[u][2 * s].x = d.x; nn[u][2 * s].y = d.y; nn[u][2 * s + 1].x = d.z; nn[u][2 * s + 1].y = d.w;
        }
    }
#pragma unroll
    for (int u = 0; u < 2; ++u)
#pragma unroll
      for (int i = 0; i < 4; ++i) acc[u][i] = na[u][i];
  }
#pragma unroll
  for (int u = 0; u < 2; ++u) {
    GAS float* so = p.out + (samp ? O_SWKV : O_PWKV) + ((((size_t)l * (samp ? SBN : NB) + (samp ? seq - NB : seq)) * AH + h) * 64 + 16 * (2 * vt + u) + fr) * 64;
#pragma unroll
    for (int i = 0; i < 4; ++i) *(GAS f32x4*)(so + 16 * i + 4 * fq) = acc[u][i];
  }
}

constexpr int ML_QP = 136;
constexpr int ML_TP = 72;
constexpr int ML_HP = 132;
constexpr int M_Q = 0, M_K = M_Q + 64 * ML_QP * 2, M_KT = M_K + 64 * ML_QP * 2, M_VT = M_KT + 128 * ML_TP * 2, M_VS = M_VT + 128 * ML_TP * 2;
constexpr int M_S = M_VS + 128 * ML_TP * 2, M_H = M_S + 64 * LDB * 2, M_SC = M_H + 64 * ML_HP * 4;
constexpr int M_CW = M_SC + (64 * 6 + 256 + 512 + 128 + 16 + 128) * 4;
constexpr int M_END = M_CW + (5 * 256 + 128) * 4;
static_assert(M_END + 8 * 64 * 4 <= 163824, "mlstm LDS (+ per-wave s_ws scratch after M_END)");
constexpr size_t AGG_BYTES = 128 * 128 * 2 + 128 * 4 + 256;
constexpr int ML_NG = 14;
__device__ __forceinline__ int ml_gstart(int g) { return g == 0 ? 0 : (g < 9 ? 4 + 5 * (g - 1) : 44 + 4 * (g - 9)); }
__device__ __forceinline__ int ml_glen(int g) { return (g >= 1 && g < 9) ? 5 : 4; }
constexpr size_t WS_AGG_OFF = (size_t)2208 * 16384;
static_assert(AGG_BYTES == 33536 && ML_NG == 14, "WS_BONUS assumes 208 aggregate records of 33536 bytes");
constexpr int ML_NP1 = NB * BH * (ML_NG - 1), ML_NP3 = NB * BH * ML_NG + SBN * BH;

__device__ __forceinline__ int ml_row(int seq, int tau) {
  if (seq < NB) return tau < 16 ? (R_META + 16 * seq + tau) : (SEQ * seq + tau - 16);
  return R_SAMP + 16 * (seq - NB) + tau;
}

struct MlPref { u32x4 xr[7]; u32x4 vq[4]; u32x4 og[2]; float gi, gf; };
__device__ __forceinline__ void ml_chunk_range(bool samp, int grp, int ci, int& tau0, int& ntok) {
  if (samp) { tau0 = 0; ntok = 16; }
  else if (grp == 0) { if (ci == 0) { tau0 = 0; ntok = 16; } else { tau0 = 16 + 64 * (ci - 1); ntok = 64; } }
  else { tau0 = 16 + 64 * (ml_gstart(grp) + ci); ntok = 64; }
}
template <int MODE>
__device__ __forceinline__ void ml_prefetch(const Ctx p, int l, int seq, int hd, int grp, int ci, int tid, MlPref& pf) {
  const bool samp = seq >= NB; const int sb = seq - NB;
  int tau0, ntok; ml_chunk_range(samp, grp, ci, tau0, ntok);
  const GAS bf16_t* P = (const GAS bf16_t*)(p.ws + WS_BIG);
  const int MB = ACOLS;
  const u32x4 z = (u32x4){0u, 0u, 0u, 0u};
  const int cgp = tid & 31, run = tid >> 5, part = cgp >> 4, cc = (cgp & 15) * 8;
  if (MODE == 1 || part == 1) {
    const int cwi = part * 512 + hd * 128 + cc, col = MB + cwi;
#pragma unroll
    for (int rr = 0; rr < 7; ++rr) {
      const int tl = 4 * run + rr - 3, tau = tau0 + tl;
      if (tl >= ntok) pf.xr[rr] = z;
      else if (tau >= 0) pf.xr[rr] = *(const u32x4*)(P + (size_t)ml_row(seq, tau) * PLD + col);
      else if (samp) pf.xr[rr] = *(const u32x4*)((const GAS bf16_t*)(p.ws + WS_CONVB) + (((size_t)l * SBN + sb) * 3 + (3 + tau)) * 1024 + cwi);
      else pf.xr[rr] = z;
    }
  }
  if (tid < 256) {
    const int eg = tid & 15, rn = tid >> 4, e0 = eg * 8;
#pragma unroll
    for (int tt = 0; tt < 4; ++tt) { const int tl = 4 * rn + tt; pf.vq[tt] = (tl < ntok) ? *(const u32x4*)(P + (size_t)ml_row(seq, tau0 + tl) * PLD + MB + 1024 + hd * 128 + e0) : z; }
  }
  if (MODE == 1) {
    const int t = tid >> 3, e0 = (tid & 7) * 16;
    if (t < ntok) { const GAS bf16_t* q = P + (size_t)ml_row(seq, tau0 + t) * PLD + MB + 1536 + hd * 128 + e0; pf.og[0] = *(const u32x4*)q; pf.og[1] = *(const u32x4*)(q + 8); }
    else { pf.og[0] = z; pf.og[1] = z; }
  }
  {
    const int t = tid & 63;
    if (t < ntok) { const size_t rb = (size_t)ml_row(seq, tau0 + t) * PLD + MB + 2048; pf.gi = bf2f(P[rb + hd]); pf.gf = bf2f(P[rb + 4 + hd]); }
    else { pf.gi = 0.f; pf.gf = 0.f; }
  }
}

__device__ __forceinline__ int ml_pos(int d) { return (d & ~31) + 8 * ((d & 15) >> 2) + 4 * ((d >> 4) & 1) + (d & 3); }
template <int MODE>
__device__ __forceinline__ void mlstm_group_item(const Ctx p, int l, int item, LAS unsigned char* lds) {
  const int tid0 = opaque_tid(p.wv);
  int seq, hd, grp;
  if (MODE == 0) { grp = item % (ML_NG - 1); const int sh = item / (ML_NG - 1); hd = sh & 3; seq = sh >> 2; }
  else if (item < NB * BH * ML_NG) { grp = item % ML_NG; const int sh = item / ML_NG; hd = sh & 3; seq = sh >> 2; }
  else { const int r = item - NB * BH * ML_NG; grp = 0; hd = r & 3; seq = NB + (r >> 2); }
  const bool samp = seq >= NB; const int sb = seq - NB;
  const GAS bf16_t* P = (const GAS bf16_t*)(p.ws + WS_BIG);
  LAS bf16_t* Qs = (LAS bf16_t*)(lds + M_Q); LAS bf16_t* Ks = (LAS bf16_t*)(lds + M_K); LAS bf16_t* KT = (LAS bf16_t*)(lds + M_KT);
  LAS bf16_t* VT = (LAS bf16_t*)(lds + M_VT); LAS bf16_t* VS = (LAS bf16_t*)(lds + M_VS); LAS bf16_t* Sb = (LAS bf16_t*)(lds + M_S);
  LAS float* Hf = (LAS float*)(lds + M_H);
  LAS float* aj = (LAS float*)(lds + M_SC); LAS float* At = aj + 64; LAS float* wo = At + 64; LAS float* wsv = wo + 64; LAS float* emt = wsv + 64; LAS float* qn = emt + 64;
  LAS float* rsum = qn + 64; LAS float* part = rsum + 256; LAS float* nvec = part + 512;
  LAS float* cwl = (LAS float*)(lds + M_CW);
  GAS unsigned char* agg = p.ws + WS_AUX + WS_AGG_OFF;
  const int MB = ACOLS;
  const float ib = p.in[25][l * BH + hd], fb = p.in[26][l * BH + hd];
  {
    const int wave0 = tid0 >> 6, lane0 = tid0 & 63, fr0 = lane0 & 15, fq0 = lane0 >> 4;
    (void)wave0; (void)fr0; (void)fq0;
    if (tid0 < 256) {
      const int cwi = (tid0 >> 7) * 512 + hd * 128 + (tid0 & 127);
      const GAS float* cw = p.in[23] + (size_t)l * 4 * 1024 + cwi;
      cwl[tid0] = cw[0]; cwl[256 + tid0] = cw[1024]; cwl[512 + tid0] = cw[2048]; cwl[768 + tid0] = cw[3072]; cwl[1024 + tid0] = p.in[24][(size_t)l * 1024 + cwi];
    }
    else if (MODE == 1 && tid0 < 384) cwl[1280 + (tid0 - 256)] = p.in[27][l * 512 + hd * 128 + (tid0 - 256)];
  }
  f32x4 C[8];
#pragma unroll
  for (int i = 0; i < 8; ++i) C[i] = (f32x4){0.f, 0.f, 0.f, 0.f};
  float m = 0.f;
  {
    const int wave = tid0 >> 6, lane = tid0 & 63, fr = lane & 15, fq = lane >> 4;
    if (MODE == 0) { m = -1e30f; if (tid0 < 128) nvec[tid0] = 0.f; }
    else if (samp) {
      const GAS float* c0 = p.in[5] + (((size_t)l * SBN + sb) * BH + hd) * 128 * 128;
#pragma unroll
      for (int i = 0; i < 8; ++i)
#pragma unroll
        for (int r = 0; r < 4; ++r) C[i][r] = c0[(size_t)(16 * i + 4 * fq + r) * 128 + 16 * wave + fr];
      if (tid0 < 128) nvec[ml_pos(tid0)] = p.in[6][(((size_t)l * SBN + sb) * BH + hd) * 128 + tid0];
      m = p.in[7][((size_t)l * SBN + sb) * BH + hd];
    } else {
      float wgt[ML_NG - 1]; float nreg = 0.f;
      {
        float fm = 0.f;
        float am[ML_NG - 1], bmv[ML_NG - 1];
#pragma unroll
        for (int g2 = 0; g2 < ML_NG - 1; ++g2) { const GAS float* sc = (const GAS float*)(agg + ((size_t)((seq * BH + hd) * (ML_NG - 1) + g2)) * AGG_BYTES + 32768 + 512); am[g2] = g2 < grp ? sc[0] : 0.f; bmv[g2] = g2 < grp ? sc[1] : -1e30f; }
#pragma unroll
        for (int g2 = 0; g2 < ML_NG - 1; ++g2) wgt[g2] = 0.f;
#pragma unroll
        for (int g2 = 0; g2 < ML_NG - 1; ++g2) {
          if (g2 < grp) {
            const float me = fmaxf(fm + am[g2], bmv[g2]), f1 = __expf(fm + am[g2] - me), f2 = __expf(bmv[g2] - me);
#pragma unroll
            for (int g3 = 0; g3 < ML_NG - 1; ++g3) if (g3 < g2) wgt[g3] *= f1;
            wgt[g2] = f2; fm = me;
          }
        }
        m = fm;
      }
#pragma unroll
      for (int g2 = 0; g2 < ML_NG - 1; ++g2) {
        if (g2 < grp) {
          const GAS unsigned char* rec = agg + ((size_t)((seq * BH + hd) * (ML_NG - 1) + g2)) * AGG_BYTES;
#pragma unroll
          for (int ip = 0; ip < 4; ++ip) {
            const u32x4 d = *(const GAS u32x4*)((const GAS bf16_t*)rec + (size_t)((wave * 4 + ip) * 64 + lane) * 8);
            C[2 * ip] += (f32x4){bflo(d.x), bfhi(d.x), bflo(d.y), bfhi(d.y)} * wgt[g2];
            C[2 * ip + 1] += (f32x4){bflo(d.z), bfhi(d.z), bflo(d.w), bfhi(d.w)} * wgt[g2];
          }
          if (tid0 < 128) nreg += ((const GAS float*)(rec + 32768))[tid0] * wgt[g2];
        }
      }
      if (tid0 < 128) nvec[ml_pos(tid0)] = nreg;
    }
  }
  float asum = 0.f;
  const int nchunk = samp ? 1 : ((grp == 0) ? 1 + ml_glen(0) : ml_glen(grp));
  MlPref pf;
  ml_prefetch<MODE>(p, l, seq, hd, grp, 0, tid0, pf);
  __syncthreads();
#pragma unroll 1
  for (int ci = 0; ci < nchunk; ++ci) {
    int tid = tid0; asm volatile("" : "+v"(tid));
    const int lane = tid & 63, wave = tid >> 6, fr = lane & 15, fq = lane >> 4;
    int tau0, ntok; ml_chunk_range(samp, grp, ci, tau0, ntok);
    float s_ws, dec, mnew;
    {
      const bool valid = lane < ntok;
      const float li = valid ? pf.gi + ib : -1e30f;
      const float lf = valid ? -softplusf_(-(pf.gf + fb)) : 0.f;
      const float b = wave_scan_add(lf);
      const float a = li - b;
      const float A = wave_scan_max(fmaxf(a, m));
      const float AL = __builtin_bit_cast(float, __builtin_amdgcn_readlane(__builtin_bit_cast(int, A), 63)), bL = __builtin_bit_cast(float, __builtin_amdgcn_readlane(__builtin_bit_cast(int, b), 63));
      s_ws = __expf(a - AL);
      dec = __expf(m - AL); mnew = bL + AL; asum += bL;
      if (wave == 0) { aj[lane] = a; At[lane] = A; wo[lane] = __expf(m - A); wsv[lane] = s_ws; emt[lane] = __expf(-(b + A)); }
    }
    {
      const int cgp = tid & 31, run = tid >> 5, part2 = cgp >> 4, cc = (cgp & 15) * 8;
      if (MODE == 1 || part2 == 1) {
        unsigned wq[4][4];
        float cw8[5][8];
#pragma unroll
        for (int k5 = 0; k5 < 5; ++k5) {
          const f32x4 c0v = *(const LAS f32x4*)(cwl + 256 * k5 + part2 * 128 + cc), c1v = *(const LAS f32x4*)(cwl + 256 * k5 + part2 * 128 + cc + 4);
#pragma unroll
          for (int i = 0; i < 4; ++i) { cw8[k5][i] = c0v[i]; cw8[k5][4 + i] = c1v[i]; }
        }
#pragma unroll
        for (int i2 = 0; i2 < 4; ++i2) {
          float oc[2][4];
#pragma unroll
          for (int hlf = 0; hlf < 2; ++hlf) {
            const int i = 2 * i2 + hlf;
            const float w0 = cw8[0][i], w1 = cw8[1][i], w2 = cw8[2][i], w3 = cw8[3][i], bb = cw8[4][i];
            float xv[7];
#pragma unroll
            for (int rr = 0; rr < 7; ++rr) { const unsigned wd = pf.xr[rr][i2]; xv[rr] = hlf ? bfhi(wd) : bflo(wd); }
#pragma unroll
            for (int tt = 0; tt < 4; ++tt) {
              float val = w0 * xv[tt] + w1 * xv[tt + 1] + w2 * xv[tt + 2] + w3 * xv[tt + 3] + bb;
              val = siluf_(val);
              if (part2 == 1) val *= 0.08838834764831845f;
              if (4 * run + tt >= ntok) val = 0.f;
              oc[hlf][tt] = val;
            }
            if (part2 == 1) { u32x2 w; w.x = pk2(oc[hlf][0], oc[hlf][1]); w.y = pk2(oc[hlf][2], oc[hlf][3]); *(LAS u32x2*)(KT + (cc + i) * ML_TP + ((((run >> 1) ^ (cgp & 7)) << 3) | ((run & 1) << 2))) = w; }
          }
#pragma unroll
          for (int tt = 0; tt < 4; ++tt) wq[tt][i2] = pk2(oc[0][tt], oc[1][tt]);
        }
        const int s32 = cc >> 5, hh = (cc >> 4) & 1, qq = (cc & 15) >> 2;
        LAS bf16_t* dst = (part2 == 0 ? Qs : Ks);
        if (MODE == 1) {
#pragma unroll
        for (int tt = 0; tt < 4; ++tt) {
          u32x2 w0; w0.x = wq[tt][0]; w0.y = wq[tt][1];
          u32x2 w1; w1.x = wq[tt][2]; w1.y = wq[tt][3];
          *(LAS u32x2*)(dst + (4 * run + tt) * ML_QP + 32 * s32 + 8 * qq + 4 * hh) = w0;
          *(LAS u32x2*)(dst + (4 * run + tt) * ML_QP + 32 * s32 + 8 * (qq + 1) + 4 * hh) = w1;
        }
        }
      }
      {
        const int eg = tid & 15, rn = (tid >> 4) & 15, e0 = eg * 8;
        LAS float* wsx = (LAS float*)(lds + M_END) + 64 * wave;
        wsx[lane] = s_ws;
        asm volatile("s_waitcnt lgkmcnt(0)" ::: "memory");
        const f32x4 w4v = *(const LAS f32x4*)(wsx + 4 * rn);
        const float w40 = w4v[0], w41 = w4v[1], w42 = w4v[2], w43 = w4v[3];
        const int vso = (((rn >> 1) ^ (eg & 7)) << 3) | ((rn & 1) << 2);
        if (tid < 256) {
#pragma unroll
          for (int i2 = 0; i2 < 4; ++i2) {
#pragma unroll
            for (int hlf = 0; hlf < 2; ++hlf) {
              const int i = 2 * i2 + hlf;
              float v0 = hlf ? bfhi(pf.vq[0][i2]) : bflo(pf.vq[0][i2]), v1 = hlf ? bfhi(pf.vq[1][i2]) : bflo(pf.vq[1][i2]);
              float v2 = hlf ? bfhi(pf.vq[2][i2]) : bflo(pf.vq[2][i2]), v3 = hlf ? bfhi(pf.vq[3][i2]) : bflo(pf.vq[3][i2]);
              if (MODE == 1) { u32x2 w; w.x = pk2(v0, v1); w.y = pk2(v2, v3); *(LAS u32x2*)(VT + (e0 + i) * ML_TP + vso) = w; }
              u32x2 ws2; ws2.x = pk2(v0 * w40, v1 * w41); ws2.y = pk2(v2 * w42, v3 * w43); *(LAS u32x2*)(VS + (e0 + i) * ML_TP + vso) = ws2;
            }
          }
        }
      }
    }
    const u32x4 og0 = pf.og[0], og1 = pf.og[1];
    if (ci + 1 < nchunk) { int tidp = tid0; asm volatile("" : "+v"(tidp)); ml_prefetch<MODE>(p, l, seq, hd, grp, ci + 1, tidp, pf); }
    __syncthreads();
    if (MODE == 1) {
      {
        const int it = wave >> 1, jt0 = (wave & 1) * 2;
        float rs = 0.f;
#pragma unroll
        for (int jj = 0; jj < 2; ++jj) {
          const int jt = jt0 + jj, i = 16 * it + fr, j0 = 16 * jt + 4 * fq;
          f32x4 sc = (f32x4){0.f, 0.f, 0.f, 0.f};
          if (jt <= it) {
            sc = mma_nt<128>(Qs + 16 * it * ML_QP, ML_QP, Ks + 16 * jt * ML_QP, ML_QP, lane, sc);
            const f32x4 a4 = *(const LAS f32x4*)(aj + j0); const float Ai = At[i];
#pragma unroll
            for (int u = 0; u < 4; ++u) { sc[u] = (j0 + u <= i) ? sc[u] * __expf(a4[u] - Ai) : 0.f; rs += sc[u]; }
          }
          *(LAS u32x2*)(Sb + i * LDB + j0) = pack4(sc);
        }
        rs = add_xor32(add_xor16(rs));
        if (fq == 0) rsum[(wave & 1) * 64 + 16 * it + fr] = rs;
      }
      {
        const int t = tid >> 3, d0 = (tid & 7) * 16;
        float s = 0.f;
#pragma unroll
        for (int u = 0; u < 2; ++u) {
          float qv[8]; unpack8(*(const LAS u32x4*)(Qs + t * ML_QP + d0 + 8 * u), qv);
          { const f32x4 n0 = *(const LAS f32x4*)(nvec + d0 + 8 * u), n1 = *(const LAS f32x4*)(nvec + d0 + 8 * u + 4);
            s += qv[0] * n0[0] + qv[1] * n0[1] + qv[2] * n0[2] + qv[3] * n0[3] + qv[4] * n1[0] + qv[5] * n1[1] + qv[6] * n1[2] + qv[7] * n1[3]; }
        }
        s = sum8_first(s);
        if ((tid & 7) == 0) qn[t] = s;
      }
      __syncthreads();
      {
        bf16x8 cf[4];
#pragma unroll
        for (int s = 0; s < 4; ++s) { const u32x2 lo = pack4(C[2 * s]), hi = pack4(C[2 * s + 1]); u32x4 w; w.x = lo.x; w.y = lo.y; w.z = hi.x; w.w = hi.y; cf[s] = __builtin_bit_cast(bf16x8, w); }
        float p2[4][4];
#pragma unroll
        for (int it = 0; it < 4; ++it) {
          f32x4 acc = (f32x4){0.f, 0.f, 0.f, 0.f};
#pragma unroll
          for (int s = 0; s < 4; ++s) acc = __builtin_amdgcn_mfma_f32_16x16x32_bf16(ldfrag(Qs + (16 * it + fr) * ML_QP + 32 * s + 8 * fq), cf[s], acc, 0, 0, 0);
          const f32x4 w4 = *(const LAS f32x4*)(wo + 16 * it + 4 * fq);
          acc = acc * w4;
#pragma unroll
          for (int s = 0; s < 2; ++s) acc = __builtin_amdgcn_mfma_f32_16x16x32_bf16(ldfrag(Sb + (16 * it + fr) * LDB + 32 * s + 8 * fq), ldfrag(VT + (16 * wave + fr) * ML_TP + 8 * ((4 * s + fq) ^ ((2 * wave + (fr >> 3)) & 7))), acc, 0, 0, 0);
          const f32x4 qn4 = *(const LAS f32x4*)(qn + 16 * it + 4 * fq), em4 = *(const LAS f32x4*)(emt + 16 * it + 4 * fq);
          const f32x4 rs0 = *(const LAS f32x4*)(rsum + 16 * it + 4 * fq), rs1 = *(const LAS f32x4*)(rsum + 64 + 16 * it + 4 * fq);
#pragma unroll
          for (int r = 0; r < 4; ++r) {
            const int t = 16 * it + 4 * fq + r;
            const float den = w4[r] * qn4[r] + rs0[r] + rs1[r];
            const float hv = acc[r] * __builtin_amdgcn_rcpf(fmaxf(fabsf(den), em4[r]));
            Hf[t * ML_HP + 16 * wave + fr] = hv;
            float sq = hv * hv;
            sq = sum16_first(sq);
            p2[it][r] = sq;
          }
        }
        if (fr == 0) {
#pragma unroll
          for (int it = 0; it < 4; ++it)
#pragma unroll
            for (int r = 0; r < 4; ++r) part[(16 * it + 4 * fq + r) * 8 + wave] = p2[it][r];
        }
      }
    }
    {
#pragma unroll
      for (int i = 0; i < 8; ++i) {
        f32x4 acc = C[i] * dec;
#pragma unroll
        for (int s = 0; s < 2; ++s) acc = __builtin_amdgcn_mfma_f32_16x16x32_bf16(ldfrag(KT + (16 * i + fr) * ML_TP + 8 * ((4 * s + fq) ^ ((2 * i + (fr >> 3)) & 7))), ldfrag(VS + (16 * wave + fr) * ML_TP + 8 * ((4 * s + fq) ^ ((2 * wave + (fr >> 3)) & 7))), acc, 0, 0, 0);
        C[i] = acc;
      }
    }
    __syncthreads();
    {
      f32x4 acc = (f32x4){0.f, 0.f, 0.f, 0.f};
#pragma unroll
      for (int s2 = 0; s2 < 2; ++s2) {
        bf16x8 wb;
        { const f32x4 a0 = *(const LAS f32x4*)(wsv + 32 * s2 + 8 * fq), a1 = *(const LAS f32x4*)(wsv + 32 * s2 + 8 * fq + 4);
          u32x4 w; w.x = pk2(a0[0], a0[1]); w.y = pk2(a0[2], a0[3]); w.z = pk2(a1[0], a1[1]); w.w = pk2(a1[2], a1[3]);
          if (fr != 0) w = (u32x4){0u, 0u, 0u, 0u};
          wb = __builtin_bit_cast(bf16x8, w); }
        acc = __builtin_amdgcn_mfma_f32_16x16x32_bf16(ldfrag(KT + (16 * wave + fr) * ML_TP + 8 * ((4 * s2 + fq) ^ ((2 * wave + (fr >> 3)) & 7))), wb, acc, 0, 0, 0);
      }
      if (fr == 0) {
        LAS float* np = nvec + 32 * (wave >> 1) + 8 * fq + 4 * (wave & 1);
        const f32x4 old = *(const LAS f32x4*)np;
        *(LAS f32x4*)np = old * dec + acc;
      }
    }
    if (MODE == 1) {
      const int t = tid >> 3, e0 = (tid & 7) * 16;
      if (t < ntok) {
        float ps;
        { const f32x4 pa = *(const LAS f32x4*)(part + t * 8), pb = *(const LAS f32x4*)(part + t * 8 + 4); ps = ((pa[0] + pa[1]) + (pa[2] + pa[3])) + ((pb[0] + pb[1]) + (pb[2] + pb[3])); }
        const float rs = rsqrtf(ps * (1.f / 128.f) + RMS_EPS);
        const size_t row = (size_t)ml_row(seq, tau0 + t);
        float og[16]; unpack8(og0, og); unpack8(og1, og + 8);
        float o[16];
#pragma unroll
        for (int i4 = 0; i4 < 4; ++i4) {
          const f32x4 hq = *(const LAS f32x4*)(Hf + t * ML_HP + e0 + 4 * i4), nq = *(const LAS f32x4*)(cwl + 1280 + e0 + 4 * i4);
#pragma unroll
          for (int i = 0; i < 4; ++i) o[4 * i4 + i] = hq[i] * rs * nq[i] * sigmoidf_(og[4 * i4 + i]);
        }
        u32x4 w; w.x = pk2(o[0], o[1]); w.y = pk2(o[2], o[3]); w.z = pk2(o[4], o[5]); w.w = pk2(o[6], o[7]);
        GAS bf16_t* mx = (GAS bf16_t*)p.out + row * DM + 512 + hd * 128 + e0;
        *(u32x4*)mx = w;
        w.x = pk2(o[8], o[9]); w.y = pk2(o[10], o[11]); w.z = pk2(o[12], o[13]); w.w = pk2(o[14], o[15]);
        *(u32x4*)(mx + 8) = w;
      }
    }
    m = mnew;
    __syncthreads();
  }
  {
    const int tid = tid0, lane = tid & 63, wave = tid >> 6, fr = lane & 15, fq = lane >> 4;
    if (MODE == 0) {
      GAS unsigned char* rec = agg + ((size_t)((seq * BH + hd) * (ML_NG - 1) + grp)) * AGG_BYTES;
#pragma unroll
      for (int ip = 0; ip < 4; ++ip) { const u32x2 a = pack4(C[2 * ip]), b = pack4(C[2 * ip + 1]); u32x4 w; w.x = a.x; w.y = a.y; w.z = b.x; w.w = b.y; *(GAS u32x4*)((GAS bf16_t*)rec + (size_t)((wave * 4 + ip) * 64 + lane) * 8) = w; }
      if (tid < 128) ((GAS float*)(rec + 32768))[tid] = nvec[ml_pos(tid)];
      if (tid == 0) { ((GAS float*)(rec + 32768 + 512))[0] = asum; ((GAS float*)(rec + 32768 + 512))[1] = m; }
    } else if (samp || grp == ML_NG - 1) {
      const int nb_ = samp ? SBN : NB, bi = samp ? sb : seq;
      GAS float* co = p.out + (samp ? O_SC : O_PC) + (((size_t)l * nb_ + bi) * BH + hd) * 128 * 128;
#pragma unroll
      for (int i = 0; i < 8; ++i)
#pragma unroll
        for (int r = 0; r < 4; ++r) co[(size_t)(16 * i + 4 * fq + r) * 128 + 16 * wave + fr] = C[i][r];
      if (tid < 128) p.out[(samp ? O_SN : O_PN) + (((size_t)l * nb_ + bi) * BH + hd) * 128 + tid] = nvec[ml_pos(tid)];
      if (tid == 0) p.out[(samp ? O_SM : O_PM) + ((size_t)l * nb_ + bi) * BH + hd] = m;
      if (tid < 256) {
        const int cwi = (tid >> 7) * 512 + hd * 128 + (tid & 127);
        GAS float* cvo = p.out + (samp ? O_SCONV : O_PCONV) + ((size_t)l * nb_ + bi) * 3 * 1024;
        const int last = samp ? 15 : (TP - 1);
#pragma unroll
        for (int j = 0; j < 3; ++j) cvo[j * 1024 + cwi] = bf2f(P[(size_t)ml_row(seq, last - 2 + j) * PLD + MB + cwi]);
      }
    }
  }
  __syncthreads();
}


__device__ __forceinline__ void gates_pass(const Ctx p, int l, unsigned* flag, unsigned need, LAS unsigned char* lds) {
  const int tid = opaque_tid(p.wv), lane = tid & 63, wave = tid >> 6, fr = lane & 15, fq = lane >> 4;
  constexpr int NBLK = R_TOT / 16, WP = DM + 8;
  if (p.bid * 8 >= NBLK) return;
  LAS bf16_t* Wl = (LAS bf16_t*)lds;
  {
    const GAS bf16_t* W = (const GAS bf16_t*)(p.ws + WS_WIN) + ((size_t)l * NINP + 3840) * DM;
#pragma unroll
    for (int i = 0; i < 4; ++i) { const int idx = tid + 512 * i, row = idx >> 7, ch = idx & 127; *(LAS u32x4*)(Wl + row * WP + 8 * ch) = *(const GAS u32x4*)(W + (size_t)row * DM + 8 * ch); }
  }
  __syncthreads();
  const int blk = p.bid * 8 + wave;
  if (blk >= NBLK) return;
  if (blk >= R_SAMP / 16 && need) {
    unsigned sp = 0;
    while ((unsigned)__builtin_amdgcn_readfirstlane(__hip_atomic_load(flag, __ATOMIC_RELAXED, __HIP_MEMORY_SCOPE_AGENT)) < need) { __builtin_amdgcn_s_sleep(2); if (++sp > (1u << 22)) break; }
    __builtin_amdgcn_fence(__ATOMIC_ACQUIRE, "agent");
  }
  const GAS bf16_t* X = (const GAS bf16_t*)(p.ws + WS_XB0) + (size_t)(16 * blk + fr) * DM + 8 * fq;
  bf16x8 xa[32];
#pragma unroll
  for (int s = 0; s < 32; ++s) xa[s] = *(const GAS bf16x8*)(X + 32 * s);
  __builtin_amdgcn_sched_barrier(0);
  f32x4 acc = (f32x4){0.f, 0.f, 0.f, 0.f};
#pragma unroll
  for (int s = 0; s < 32; ++s) acc = __builtin_amdgcn_mfma_f32_16x16x32_bf16(*(const LAS bf16x8*)(Wl + fr * WP + 32 * s + 8 * fq), xa[s], acc, 0, 0, 0);
  if (fq < 2) {
    const int row = 16 * blk + fr;
    const float rs = row_rstd((const GAS float*)(p.ws + WS_SS) + (size_t)(2 * l) * MPAD * 4, row);
    *(GAS u32x2*)((GAS bf16_t*)(p.ws + WS_BIG) + (size_t)row * PLD + 3840 + 4 * fq) = pack4(acc * rs);
  }
}


constexpr int XF_FLAG0 = 3520;
template <bool FINAL>
__device__ __forceinline__ void convert_special(const Ctx p, const GAS float* slab, int nsl, const GAS bf16_t* Xin, GAS bf16_t* Xout, GAS float* ssd, unsigned* flag, const GAS float* nf) {
  const int tid = opaque_tid(p.wv), lane = tid & 63, wave = tid >> 6;
  const int w16 = p.bid - (p.nblk - 16);
#pragma unroll 1
  for (int q = 0; q < 4; ++q) {
    const int r2 = 32 * w16 + 4 * wave + q, row = R_SAMP + r2, tm = r2 >> 8, rin = r2 & 255;
    f32x4 v[4]; float s = 0.f;
#pragma unroll
    for (int j = 0; j < 4; ++j) {
      const u32x2 xi = *(const GAS u32x2*)(Xin + (size_t)row * DM + 256 * j + 4 * lane);
      f32x4 a = (f32x4){bflo(xi.x), bfhi(xi.x), bflo(xi.y), bfhi(xi.y)};
      for (int sl = 0; sl < nsl; ++sl) a += *(const GAS f32x4*)(slab + ((size_t)((tm * 4 + j) * nsl + sl) * 256 + rin) * 256 + 4 * lane);
      v[j] = a; s += a[0] * a[0] + a[1] * a[1] + a[2] * a[2] + a[3] * a[3];
    }
    s = wave_sum(s);
    if (FINAL) {
      const float rs = rsqrtf(s * (1.f / DM) + RMS_EPS);
      if (row < R_META) {
        GAS float* y = p.out + (size_t)row * DM;
#pragma unroll
        for (int j = 0; j < 4; ++j) { const f32x4 g = *(const GAS f32x4*)(nf + 256 * j + 4 * lane); *(GAS f32x4*)(y + 256 * j + 4 * lane) = v[j] * rs * g; }
      }
    } else {
#pragma unroll
      for (int j = 0; j < 4; ++j) {
        u32x2 w; w.x = pk2(v[j][0], v[j][1]); w.y = pk2(v[j][2], v[j][3]);
        *(GAS u32x2*)(Xout + (size_t)row * DM + 256 * j + 4 * lane) = w;
      }
      if (lane == 0) *(GAS f32x4*)(ssd + (size_t)row * 4) = (f32x4){s, 0.f, 0.f, 0.f};
    }
  }
  if (!FINAL) {
    asm volatile("s_waitcnt vmcnt(0)" ::: "memory");
    __syncthreads();
    if (tid == 0) {
      __builtin_amdgcn_fence(__ATOMIC_RELEASE, "agent");
      asm volatile("s_waitcnt vmcnt(0)" ::: "memory");
      __hip_atomic_fetch_add(flag, 1u, __ATOMIC_RELAXED, __HIP_MEMORY_SCOPE_AGENT);
    }
  }
}

__device__ __forceinline__ int prev_row(int r, int d) {
  if (r < R_MAIN) { const int t = r & (SEQ - 1), b = r >> 12; return t >= d ? r - d : (R_META + 16 * b + 16 + (t - d)); }
  if (r < R_META) { const int t = (r - R_SAMP) & 15; return t >= d ? r - d : (-2 - (2 + (t - d))); }
  { const int t = (r - R_META) & 15; return t >= d ? r - d : -1; }
}
__device__ __forceinline__ void ffn_conv8(const float* u0, const float* u1, const float* u2, const float* gt, const GAS float* cw, const GAS float* cb, int ff, GAS bf16_t* dst) {
  float o[8];
#pragma unroll
  for (int i = 0; i < 8; ++i) { const float val = cw[ff + i] * u2[i] + cw[DFF + ff + i] * u1[i] + cw[2 * DFF + ff + i] * u0[i] + cb[ff + i]; o[i] = siluf_(val) * gt[i]; }
  u32x4 w; w.x = pk2(o[0], o[1]); w.y = pk2(o[2], o[3]); w.z = pk2(o[4], o[5]); w.w = pk2(o[6], o[7]);
  *(GAS u32x4*)dst = w;
}
__device__ __forceinline__ void phase_ffn_fixup(const Ctx p, int l) {
  GAS bf16_t* G = (GAS bf16_t*)(p.ws + WS_BIG);
  const GAS bf16_t* UH = G + pg8::FS_UH; const GAS bf16_t* UD = G + pg8::FS_UD; const GAS bf16_t* GD = G + pg8::FS_GD; const GAS bf16_t* US = G + pg8::FS_US; const GAS bf16_t* GS = G + pg8::FS_GS;
  const GAS float* cw = p.in[31] + (size_t)l * 3 * DFF; const GAS float* cb = p.in[32] + (size_t)l * DFF;
  constexpr int NA = 256 * 2 * 352, NBS = 320 * 352, NC = (NB + SBN) * 2 * 352;
  for (int idx = p.bid * 512 + opaque_tid(p.wv); idx < NA + NBS + NC; idx += p.nblk * 512) {
    float u0[8], u1[8], u2[8], gt[8];
    if (idx < NA) {
      const int s = idx / 704, rem = idx - s * 704, j = rem / 352, c0 = (rem - j * 352) * 8;
      load8(UD + ((size_t)s * 2 + j) * DFF + c0, u0); load8(GD + ((size_t)s * 2 + j) * DFF + c0, gt);
      const GAS bf16_t* h1; const GAS bf16_t* h2;
      if ((s & 63) == 0) { const int b = s >> 6; h1 = US + (size_t)(256 + 16 * b + 15) * DFF; h2 = US + (size_t)(256 + 16 * b + 14) * DFF; }
      else { h1 = UH + ((size_t)(s - 1) * 2 + 1) * DFF; h2 = UH + ((size_t)(s - 1) * 2) * DFF; }
      if (j == 0) { load8(h1 + c0, u1); load8(h2 + c0, u2); }
      else { load8(UD + ((size_t)s * 2) * DFF + c0, u1); load8(h1 + c0, u2); }
      ffn_conv8(u0, u1, u2, gt, cw, cb, c0, G + (size_t)(64 * s + j) * DFF + c0);
    } else if (idx < NA + NBS) {
      const int k = idx - NA, r2 = k / 352, c0 = (k - r2 * 352) * 8, t = r2 & 15;
      const bool samp = r2 < 256;
      load8(US + (size_t)r2 * DFF + c0, u0); load8(GS + (size_t)r2 * DFF + c0, gt);
#pragma unroll
      for (int d = 1; d <= 2; ++d) {
        float* dstv = d == 1 ? u1 : u2;
        if (t >= d) load8(US + (size_t)(r2 - d) * DFF + c0, dstv);
        else if (samp) { const GAS float* st = p.in[8] + (((size_t)l * SBN + (r2 >> 4)) * 2 + (2 + (t - d))) * DFF + c0;
#pragma unroll
          for (int i = 0; i < 8; ++i) dstv[i] = st[i]; }
        else {
#pragma unroll
          for (int i = 0; i < 8; ++i) dstv[i] = 0.f; }
      }
      ffn_conv8(u0, u1, u2, gt, cw, cb, c0, G + (size_t)(R_SAMP + r2) * DFF + c0);
    } else {
      const int k = idx - NA - NBS, q = k / 352, c0 = (k - q * 352) * 8, sq = q >> 1, j = q & 1;
      const bool samp = sq >= NB;
      const GAS bf16_t* src = samp ? (US + (size_t)(16 * (sq - NB) + 14 + j) * DFF) : (UH + ((size_t)(64 * sq + 63) * 2 + j) * DFF);
      load8(src + c0, u0);
      GAS float* dst = p.out + (samp ? O_SF : O_PF) + (((size_t)l * (samp ? SBN : NB) + (samp ? sq - NB : sq)) * 2 + j) * DFF + c0;
#pragma unroll
      for (int i = 0; i < 8; ++i) dst[i] = u0[i];
    }
  }
}

__device__ __forceinline__ void phase_final(const Ctx p) {
  const int tid = opaque_tid(p.wv), lane = tid & 63, wave = tid >> 6;
  const int gw = p.bid * 8 + wave, NGW = p.nblk * 8;
  const GAS float* nf = p.in[34];
  const GAS bf16_t* X = (const GAS bf16_t*)(p.ws + WS_XB0);
  for (int r = gw; r < R_MAIN; r += NGW) {
    f32x4 v[4]; float s = 0.f;
#pragma unroll
    for (int j = 0; j < 4; ++j) { const u32x2 xi = *(const GAS u32x2*)(X + (size_t)r * DM + 256 * j + 4 * lane); v[j] = (f32x4){bflo(xi.x), bfhi(xi.x), bflo(xi.y), bfhi(xi.y)}; s += v[j][0] * v[j][0] + v[j][1] * v[j][1] + v[j][2] * v[j][2] + v[j][3] * v[j][3]; }
    s = wave_sum(s);
    const float rs = rsqrtf(s * (1.f / DM) + RMS_EPS);
    GAS float* y = p.out + (size_t)r * DM;
#pragma unroll
    for (int j = 0; j < 4; ++j) { const f32x4 g = *(const GAS f32x4*)(nf + 256 * j + 4 * lane); *(GAS f32x4*)(y + 256 * j + 4 * lane) = v[j] * rs * g; }
  }
}

constexpr int kThreads = 512;
constexpr size_t kDynLds = 163840;

__global__ void __launch_bounds__(512, 2) fwd_megakernel(Params p) {
  extern __shared__ __attribute__((aligned(16))) unsigned char shm[];
  LAS unsigned char* lds = (LAS unsigned char*)shm;
  cg::grid_group grid = cg::this_grid();
#define GSYNC() do { xcd_barrier((unsigned*)cx0.ws, xb_st, opaque_tid(cx0.wv) == 0); if (PROBE_SYNC) xcd_barrier((unsigned*)cx0.ws, xb_st, opaque_tid(cx0.wv) == 0); } while (0)
#define PHASE_CTX() const Ctx cx = opaque_ctx(cx0); const int G = cx.nblk, c = cx.bid; (void)G; (void)c; GAS unsigned char* ws = cx.ws; GAS float* ss = (GAS float*)(ws + WS_SS); GAS float* xmeta = (GAS float*)(ws + WS_XMETA); \
    GAS bf16_t* Xb0 = (GAS bf16_t*)(ws + WS_XB0); GAS bf16_t* Xb1 = (GAS bf16_t*)(ws + WS_XB1); GAS bf16_t* BIG = (GAS bf16_t*)(ws + WS_BIG); (void)ss; (void)xmeta; (void)Xb0; (void)Xb1; (void)BIG;

  volatile LAS unsigned* xb_st = (volatile LAS unsigned*)(lds + 163824);
  if (threadIdx.x == 0) { xb_st[0] = 0u; xb_st[1] = 0u; (void)xb_add(&((unsigned*)p.ws)[XB_XCNT(xb_xcc_id())], 1u); }
#ifndef NO_PRO
  for (int rep = 0; rep < 1 + PROBE_PRO; ++rep) { phase_prologue(p, lds); __syncthreads(); }
#endif
  if (threadIdx.x < 35) ((const float**)(p.ws + WS_TAB))[threadIdx.x] = p.in[threadIdx.x];
  Ctx cx0; cx0.out = (GAS float*)p.out; cx0.ws = (GAS unsigned char*)p.ws; cx0.in = (const gcf_t GAS*)(p.ws + WS_TAB); cx0.wv = __builtin_amdgcn_readfirstlane(threadIdx.x >> 6); cx0.bid = blockIdx.x; cx0.nblk = gridDim.x; cx0.pad_ = 0;
  if (p.ph_lo) grid.sync(); else GSYNC();
#pragma unroll 1
  for (int l0 = 0; l0 < DEPTH; ++l0) {
    {
      PHASE_CTX(); int l = l0; asm volatile("" : "+s"(l));
      unsigned* flag = (unsigned*)ws + XF_FLAG0 + 64 * (2 * l);
      const unsigned need = l > 0 ? 16u : 0u;
      if (l > 0 && c >= G - 16) convert_special<false>(cx, (const GAS float*)(ws + WS_SLAB_OUT), 4, Xb1, Xb0, ss + (size_t)(2 * l) * MPAD * 4, flag, nullptr);
      if (l == 0) {
        constexpr int NIN = (MPAD / 256) * (3840 / 256);
        const int lo = NIN % G;
        const int tidq = opaque_tid(cx.wv), waveq = tidq >> 6, laneq = tidq & 63;
        if (lo && c >= lo) {
          convert_weights(cx.in[11], cx.in[10], cx.in[28], cx.in[30], cx.in[29], cx.in[33], ws, 0, WI_IN, WI_IN + WI_P0, (c - lo) * 8 + waveq, (G - lo) * 8, (LAS float*)lds, laneq);
          __syncthreads();
        } else if (!lo) {
          convert_weights(cx.in[11], cx.in[10], cx.in[28], cx.in[30], cx.in[29], cx.in[33], ws, 0, WI_IN, WI_IN + WI_P0, c * 8 + waveq, G * 8, (LAS float*)lds, laneq);
          __syncthreads();
        }
      }
      pg8::Gemm g{(const bf16_t*)Xb0, (const bf16_t*)(ws + WS_WIN) + (size_t)l * NINP * DM, MPAD, 3840, DM, DM};
      pg8::WaitOrder S; S.init(MPAD, 3840, DM, G, c); S.flag = flag; S.need = need; S.wv = cx.wv;
      pg8::EpiScaleBf16 E{BIG, PLD, PLD, ss + (size_t)(2 * l) * MPAD * 4};
      for (int rep = 0; rep < 1 + PROBE_GEMM; ++rep)
      pg8::gemm_phase<pg8::EpiScaleBf16, pg8::WaitOrder>(lds, g, S, E, cx.wv);
      gates_pass(cx, l, flag, need, lds);
    }
    GSYNC();
    {
      PHASE_CTX(); int l = l0; asm volatile("" : "+s"(l));
      if (c < ML_NP1) { for (int rep = 0; rep < 1 + PROBE_P1; ++rep) mlstm_group_item<0>(cx, l, c, lds); }
      rwkv_phase<0>(cx, l, lds, 1 + PROBE_MIXA);
    }
    GSYNC();
    {
      PHASE_CTX(); int l = l0; asm volatile("" : "+s"(l));
      const int tid = opaque_tid(cx.wv), wave = tid >> 6, lane = tid & 63;
      for (int rep = PROBE_SCAN; rep >= 0; --rep) {
        const int chain = c < 32 ? c : 32 + (c - 32) * 2 + (wave >> 2);
        if ((wave & 3) < 2 && (c < 32 ? wave < 2 : c < 96)) rwkv_scan_chain(cx, l, chain, wave & 1, lane, rep > 0);
      }
      if (c >= 32) {
        for (int rep = 0; rep < 1 + PROBE_P3; ++rep) {
          const int it = c - 32;
          const int grp = it % ML_NG, k = (it / ML_NG) * 4 + (grp - 9);
          const int n2 = (it < NB * BH * ML_NG) ? ((grp >= 9 && grp <= 12 && k < SBN * BH) ? 2 : 1) : 0;
          for (int q = 0; q < n2; ++q) mlstm_group_item<1>(cx, l, q == 0 ? it : NB * BH * ML_NG + k, lds);
        }
      }
    }
    GSYNC();
    {
      PHASE_CTX(); int l = l0; asm volatile("" : "+s"(l));
      for (int rep = 0; rep < 1 + PROBE_MIXC; ++rep) rwkv_phase_lite(cx, l, lds);
    }
    GSYNC();
    {
      PHASE_CTX(); int l = l0; asm volatile("" : "+s"(l));
      pg8::Gemm g{(const bf16_t*)cx.out, (const bf16_t*)(ws + WS_WOUT) + (size_t)l * DM * DM, MPAD, DM, DM, DM};
      pg8::TailOrder S; S.init(R_MAIN, DM, DM, G, c); S.nsl = 4;
      pg8::EpiRes E{Xb0, Xb1, ss + (size_t)(2 * l + 1) * MPAD * 4, 1, (GAS float*)(ws + WS_SLAB_OUT), 4, (LAS float*)(lds + 131072)};
      pg8::gemm_phase<pg8::EpiRes, pg8::TailOrder>(lds, g, S, E, cx.wv);
      if (PROBE_OUT) { pg8::EpiRes E2 = E; E2.write_ss = -1; pg8::gemm_phase<pg8::EpiRes, pg8::TailOrder>(lds, g, S, E2, cx.wv); }
    }
    GSYNC();
    {
      PHASE_CTX(); int l = l0; asm volatile("" : "+s"(l));
      unsigned* flag = (unsigned*)ws + XF_FLAG0 + 64 * (2 * l + 1);
      if (c >= G - 16) convert_special<false>(cx, (const GAS float*)(ws + WS_SLAB_OUT), 4, Xb0, Xb1, ss + (size_t)(2 * l + 1) * MPAD * 4, flag, nullptr);
      {
        constexpr int NUP = (MPAD / 256) * (2 * DFF / 256);
        const int lo = NUP % G;
        if (lo && c >= lo) {
          const int tidq = opaque_tid(cx.wv), waveq = tidq >> 6, laneq = tidq & 63, wq = (c - lo) * 8 + waveq, nwq = (G - lo) * 8;
          LAS float* scr = (LAS float*)(lds + waveq * 16384);
          convert_weights(cx.in[11], cx.in[10], cx.in[28], cx.in[30], cx.in[29], cx.in[33], ws, l, WI_IN + WI_OUT + WI_UP, WI_L, wq, nwq, scr, laneq);
          if (l + 1 < DEPTH) convert_weights(cx.in[11], cx.in[10], cx.in[28], cx.in[30], cx.in[29], cx.in[33], ws, l + 1, 0, WI_IN, wq, nwq, scr, laneq);
          __syncthreads();
        } else if (!lo) {
          const int tidq = opaque_tid(cx.wv), waveq = tidq >> 6, laneq = tidq & 63, wq = c * 8 + waveq, nwq = G * 8;
          LAS float* scr = (LAS float*)(lds + waveq * 16384);
          convert_weights(cx.in[11], cx.in[10], cx.in[28], cx.in[30], cx.in[29], cx.in[33], ws, l, WI_IN + WI_OUT + WI_UP, WI_L, wq, nwq, scr, laneq);
          if (l + 1 < DEPTH) convert_weights(cx.in[11], cx.in[10], cx.in[28], cx.in[30], cx.in[29], cx.in[33], ws, l + 1, 0, WI_IN, wq, nwq, scr, laneq);
          __syncthreads();
        }
      }
      pg8::Gemm g{(const bf16_t*)Xb1, (const bf16_t*)(ws + WS_WUP) + (size_t)l * 2 * DFF * DM, MPAD, 2 * DFF, DM, DM};
      pg8::WaitOrder S; S.init(MPAD, 2 * DFF, DM, G, c); S.flag = flag; S.need = 16u; S.wv = cx.wv;
      pg8::EpiUpConv E{BIG, ss + (size_t)(2 * l + 1) * MPAD * 4, cx.in[31] + (size_t)l * 3 * DFF, cx.in[32] + (size_t)l * DFF};
      for (int rep = 0; rep < 1 + PROBE_GEMM; ++rep)
      pg8::gemm_phase<pg8::EpiUpConv, pg8::WaitOrder>(lds, g, S, E, cx.wv);
    }
    GSYNC();
    { PHASE_CTX(); int l = l0; asm volatile("" : "+s"(l)); for (int rep = 0; rep < 1 + PROBE_FIX; ++rep) phase_ffn_fixup(cx, l); }
    GSYNC();
    {
      PHASE_CTX(); int l = l0; asm volatile("" : "+s"(l));
      pg8::Gemm g{(const bf16_t*)BIG, (const bf16_t*)(ws + WS_WDN) + (size_t)l * DM * DFF, MPAD, DM, DFF, DFF};
      pg8::TailOrder S; S.init(R_MAIN, DM, DFF, G, c); S.nsl = 4;
      const int wx = (l + 1 < DEPTH) ? 1 : 0;
      pg8::EpiRes E{Xb1, Xb0, ss + (size_t)(2 * l + 2) * MPAD * 4, wx, (GAS float*)(ws + WS_SLAB_OUT), 4, (LAS float*)(lds + 131072)};
      pg8::gemm_phase<pg8::EpiRes, pg8::TailOrder>(lds, g, S, E, cx.wv);
      if (PROBE_DOWN) { pg8::EpiRes E2 = E; E2.write_ss = -1; pg8::gemm_phase<pg8::EpiRes, pg8::TailOrder>(lds, g, S, E2, cx.wv); }
      if (l + 1 < DEPTH && c >= 32) {
        const int tidq = opaque_tid(cx.wv), waveq = tidq >> 6, laneq = tidq & 63, wq = (c - 32) * 8 + waveq, nwq = (G - 32) * 8;
        LAS float* scr = (LAS float*)(lds + waveq * 16384);
        convert_weights(cx.in[11], cx.in[10], cx.in[28], cx.in[30], cx.in[29], cx.in[33], ws, l + 1, WI_IN, WI_IN + WI_OUT + WI_UP, wq, nwq, scr, laneq);
      }
    }
    GSYNC();
  }
  {
    PHASE_CTX();
    if (c >= G - 16) convert_special<true>(cx, (const GAS float*)(ws + WS_SLAB_OUT), 4, Xb1, nullptr, nullptr, nullptr, cx.in[34]);
  }
  { PHASE_CTX(); phase_final(cx); }
}

extern "C" void kernel_launch(void* const* d_in, const int* in_sizes, int n_in, void* d_out, int out_size, void* d_ws,
                              size_t ws_size, hipStream_t stream) {
  static int grid_blocks = 0;
  if (!grid_blocks) {
    int dev = 0, cus = 0, per_cu = 0;
    (void)hipGetDevice(&dev);
    (void)hipDeviceGetAttribute(&cus, hipDeviceAttributeMultiprocessorCount, dev);
    (void)hipFuncSetAttribute((const void*)fwd_megakernel, hipFuncAttributeMaxDynamicSharedMemorySize, (int)kDynLds);
    (void)hipOccupancyMaxActiveBlocksPerMultiprocessor(&per_cu, fwd_megakernel, kThreads, kDynLds);
    grid_blocks = cus > 0 ? cus : 256;
    if (n_in != 35 || out_size != (int)O_END || ws_size < WS_END) fprintf(stderr, "kernel_launch: unexpected shapes n_in=%d out=%d ws=%zu\n", n_in, out_size, ws_size);
  }
  (void)hipMemsetAsync(d_ws, 0, 16384, stream);
  Params p{};
  for (int i = 0; i < 35; ++i) p.in[i] = (const float*)d_in[i];
  p.out = (float*)d_out;
  p.ws = (unsigned char*)d_ws;
  p.ph_lo = 0; p.ph_hi = 0;
  void* args[] = {&p};
  hipError_t e = hipLaunchCooperativeKernel((void*)fwd_megakernel, dim3(grid_blocks), dim3(kThreads), args, kDynLds, stream);
  if (e != hipSuccess) fprintf(stderr, "cooperative launch failed: %s (grid %d)\n", hipGetErrorString(e), grid_blocks);
}
```
